# Optimizing an MI355X kernel written in HIP

```python
import jax
import jax.numpy as jnp
from jax import lax
import numpy as np

D_MODEL = 2048
BATCH = 4
SEQ = 8192
DEPTH = 1

ATTN_HEAD_DIM = 128
ATTN_WIDTH = D_MODEL // 2
ATTN_HEADS = ATTN_WIDTH // ATTN_HEAD_DIM
RET_HEAD_DIM = 256
RET_WIDTH = D_MODEL - ATTN_WIDTH
RET_HEADS = RET_WIDTH // RET_HEAD_DIM
MIX_WIDTH = ATTN_WIDTH + RET_WIDTH
IN_COLS = 3 * ATTN_WIDTH + 4 * RET_WIDTH
DILATED_PATTERNS = ((128, 1), (512, 4), (2048, 16))
ROPE_THETA = 500000.0
ROPE_DIM = ATTN_HEAD_DIM // 4
RET_THETA = 10000.0
RET_CHUNK = 128
N_GROUPS = 4
EXPERTS_PER_GROUP = 8
N_EXPERTS = N_GROUPS * EXPERTS_PER_GROUP
TOP_K_IN_GROUP = 2
EXPERT_FF = D_MODEL // 4
MOE_BLOCK = 128
DEEPNORM_ALPHA = (2 * DEPTH) ** 0.25
DEEPNORM_BETA = (8 * DEPTH) ** -0.25
LN_EPS = 1e-5
MASK_VALUE = -1e30

kernel_name = 'hybrid_dilated_retention_hmoe_encoder'


def layer_norm(x, g=None, b=None):
    xf = x.astype(jnp.float32)
    mu = jnp.mean(xf, -1, keepdims=True)
    var = jnp.mean(jnp.square(xf - mu), -1, keepdims=True)
    y = (xf - mu) * lax.rsqrt(var + LN_EPS)
    if g is not None:
        y = y * g + b
    return y.astype(x.dtype)


def rotary(x, pos, inv_freq):
    n = inv_freq.shape[0]
    ang = pos.astype(jnp.float32)[:, None, :, None] * inv_freq
    cos, sin = jnp.cos(ang), jnp.sin(ang)
    xf = x.astype(jnp.float32)
    x1, x2, rest = xf[..., :n], xf[..., n:2 * n], xf[..., 2 * n:]
    out = jnp.concatenate([x1 * cos - x2 * sin, x2 * cos + x1 * sin, rest], axis=-1)
    return out.astype(x.dtype)


def banded_softmax_attention(q, k, v, half):
    lead = q.shape[:-2]
    L, hd = q.shape[-2], q.shape[-1]
    W = half
    nb = -(-L // W)
    Lp = nb * W
    nl = len(lead)
    qp = jnp.pad(q, [(0, 0)] * nl + [(0, Lp - L), (0, 0)]).reshape(*lead, nb, W, hd)
    kv_pad = [(0, 0)] * nl + [(W, Lp - L + W), (0, 0)]
    kp = jnp.pad(k, kv_pad)
    vp = jnp.pad(v, kv_pad)

    def key_blocks(t):
        return jnp.concatenate([t[..., o * W:(o + nb) * W, :].reshape(*lead, nb, W, hd) for o in range(3)], axis=-2)

    kb, vb = key_blocks(kp), key_blocks(vp)
    qpos = jnp.arange(Lp).reshape(nb, W, 1)
    kpos = (jnp.arange(nb) * W - W)[:, None, None] + jnp.arange(3 * W)[None, None, :]
    mask = (jnp.abs(qpos - kpos) <= half) & (kpos >= 0) & (kpos < L)
    s = jnp.einsum('...nqd,...nkd->...nqk', qp, kb).astype(jnp.float32)
    s = jnp.where(mask, s, MASK_VALUE)
    m = jnp.max(s, -1, keepdims=True)
    p = jnp.exp(s - m)
    den = jnp.sum(p, -1)
    o = jnp.einsum('...nqk,...nkd->...nqd', p, vb.astype(jnp.float32)) / den[..., None]
    lse = m[..., 0] + jnp.log(den)
    o = o.reshape(*lead, Lp, hd)[..., :L, :]
    lse = lse.reshape(*lead, Lp)[..., :L]
    return o, lse


def dilated_mixture_attention(q, k, v):
    B, H, S, hd = q.shape
    outs, lses = [], []
    for window, dil in DILATED_PATTERNS:
        half = window // (2 * dil)

        def to_res(t):
            return t.reshape(B, H, S // dil, dil, hd).transpose(0, 1, 3, 2, 4)

        o, lse = banded_softmax_attention(to_res(q), to_res(k), to_res(v), half)
        outs.append(o.transpose(0, 1, 3, 2, 4).reshape(B, H, S, hd))
        lses.append(lse.transpose(0, 1, 3, 2).reshape(B, H, S))
    w = jax.nn.softmax(jnp.stack(lses), axis=0)
    out = jnp.einsum('pbhs,pbhsd->bhsd', w, jnp.stack(outs))
    return out.astype(q.dtype)


def retention_one_direction(q, k, v, log_decay, inclusive):
    B, H, S, dh = q.shape
    C = RET_CHUNK
    N = S // C
    lg = log_decay.astype(jnp.float32)
    idx = jnp.arange(C, dtype=jnp.float32)
    diff = idx[:, None] - idx[None, :]
    keep = diff >= 0 if inclusive else diff > 0
    dmat = jnp.where(keep, jnp.exp(lg[:, None, None] * jnp.maximum(diff, 0.0)), 0.0)
    qc, kc, vc = [t.astype(jnp.float32).reshape(B, H, N, C, dh) for t in (q, k, v)]
    scores = jnp.einsum('bhnid,bhnjd->bhnij', qc, kc) * dmat[None, :, None]
    y_intra = jnp.einsum('bhnij,bhnjd->bhnid', scores, vc)
    zeta = jnp.exp(lg[:, None] * (C - 1 - idx))
    xi = jnp.exp(lg[:, None] * (idx + 1))
    chunk_decay = jnp.exp(lg * C)

    def step(state, xs):
        qn, kn, vn = xs
        y = jnp.einsum('bhcd,bhde->bhce', qn, state) * xi[None, :, :, None]
        state = state * chunk_decay[None, :, None, None] + jnp.einsum('bhcd,bhce->bhde', kn * zeta[None, :, :, None], vn)
        return state, y

    xs = tuple(jnp.moveaxis(t, 2, 0) for t in (qc, kc, vc))
    _, y_cross = lax.scan(step, jnp.zeros((B, H, dh, dh), jnp.float32), xs)
    return (y_intra + jnp.moveaxis(y_cross, 0, 2)).reshape(B, H, S, dh)


def bidirectional_retention(q, k, v, log_decay_f, log_decay_b):
    y_f = retention_one_direction(q, k, v, log_decay_f, True)
    flip = lambda t: jnp.flip(t, axis=2)
    y_b = flip(retention_one_direction(flip(q), flip(k), flip(v), log_decay_b, False))
    return layer_norm(y_f + y_b)


def hierarchical_moe(h, w_group, b_group, w_sub, b_sub, w1, w3, w2):
    B, S, D = h.shape
    T = B * S
    A = T * TOP_K_IN_GROUP
    ht = h.reshape(T, D)
    glog = (ht @ w_group + b_group).astype(jnp.float32)
    gprob = jax.nn.softmax(glog, axis=-1)
    gsel = jnp.argmax(glog, axis=-1)
    pg = jnp.take_along_axis(gprob, gsel[:, None], axis=1)[:, 0]
    slog_all = jnp.einsum('td,gde->tge', ht, w_sub) + b_sub
    slog = jnp.take_along_axis(slog_all, gsel[:, None, None], axis=1)[:, 0].astype(jnp.float32)
    top_v, top_i = lax.top_k(slog, TOP_K_IN_GROUP)
    top_w = jax.nn.softmax(top_v, axis=-1) * pg[:, None]
    eid = (gsel[:, None] * EXPERTS_PER_GROUP + top_i).reshape(-1).astype(jnp.int32)
    wt = top_w.reshape(-1)
    tok = jnp.repeat(jnp.arange(T, dtype=jnp.int32), TOP_K_IN_GROUP)
    order = jnp.argsort(eid)
    e_sorted = eid[order]
    counts = jnp.bincount(eid, length=N_EXPERTS)
    padded = (counts + MOE_BLOCK - 1) // MOE_BLOCK * MOE_BLOCK
    pend = jnp.cumsum(padded)
    pstart = pend - padded
    start = jnp.cumsum(counts) - counts
    rank = jnp.arange(A) - start[e_sorted]
    dest = pstart[e_sorted] + rank
    P = A + N_EXPERTS * MOE_BLOCK
    nblk = P // MOE_BLOCK
    buf_tok = jnp.zeros((P,), jnp.int32).at[dest].set(tok[order])
    buf_w = jnp.zeros((P,), jnp.float32).at[dest].set(wt[order])
    blk_e = jnp.minimum(jnp.searchsorted(pend, jnp.arange(nblk) * MOE_BLOCK, side='right'), N_EXPERTS - 1)
    xb = ht[buf_tok].reshape(nblk, MOE_BLOCK, D)

    def expert_block(args):
        xblk, e = args
        return (jax.nn.silu(xblk @ w1[e]) * (xblk @ w3[e])) @ w2[e]

    yb = lax.map(expert_block, (xb, blk_e)).reshape(P, D)
    out = jnp.zeros((T, D), jnp.float32).at[buf_tok].add(yb.astype(jnp.float32) * buf_w[:, None])
    return out.reshape(B, S, D).astype(h.dtype)


def setup_inputs(seed: int = 0) -> dict:
    key = jax.random.key(seed)
    ks = jax.random.split(key, 24)
    f32 = jnp.float32
    D = D_MODEL

    def nrm(k, shape, scale):
        return jax.random.normal(k, shape, f32) * scale

    x = nrm(ks[0], (BATCH, SEQ, D), 1.0)
    c = nrm(ks[1], (BATCH, D), 1.0)
    positions = (jnp.cumsum(jax.random.randint(ks[2], (BATCH, SEQ), 1, 3), axis=1) - 1).astype(jnp.int32)
    ln0_g = 1.0 + nrm(ks[3], (D,), 0.02)
    ln0_b = nrm(ks[4], (D,), 0.02)
    w_ada = nrm(ks[5], (DEPTH, D, 6 * D), 0.2 * D ** -0.5)
    b_ada = nrm(ks[6], (DEPTH, 6 * D), 0.01)
    col_scale = jnp.concatenate([
        jnp.ones((2 * ATTN_WIDTH,), f32), jnp.full((ATTN_WIDTH,), DEEPNORM_BETA, f32),
        jnp.ones((2 * RET_WIDTH,), f32), jnp.full((RET_WIDTH,), DEEPNORM_BETA, f32),
        jnp.ones((RET_WIDTH,), f32)])
    w_in = nrm(ks[7], (DEPTH, D, IN_COLS), D ** -0.5) * col_scale
    w_out = nrm(ks[8], (DEPTH, MIX_WIDTH, D), DEEPNORM_BETA * MIX_WIDTH ** -0.5)
    base = jnp.log(1.0 - 2.0 ** (-5.0 - jnp.arange(RET_HEADS, dtype=f32)))
    ret_log_decay_f = base * jnp.exp(nrm(ks[9], (DEPTH, RET_HEADS), 0.1))
    ret_log_decay_b = base * jnp.exp(nrm(ks[10], (DEPTH, RET_HEADS), 0.1))
    ln1_g = 1.0 + nrm(ks[11], (DEPTH, D), 0.02)
    ln1_b = nrm(ks[12], (DEPTH, D), 0.02)
    w_group = nrm(ks[13], (DEPTH, D, N_GROUPS), D ** -0.5)
    b_group = nrm(ks[14], (DEPTH, N_GROUPS), 0.01)
    w_sub = nrm(ks[15], (DEPTH, N_GROUPS, D, EXPERTS_PER_GROUP), D ** -0.5)
    b_sub = nrm(ks[16], (DEPTH, N_GROUPS, EXPERTS_PER_GROUP), 0.01)
    w1 = nrm(ks[17], (DEPTH, N_EXPERTS, D, EXPERT_FF), D ** -0.5)
    w3 = nrm(ks[18], (DEPTH, N_EXPERTS, D, EXPERT_FF), DEEPNORM_BETA * D ** -0.5)
    w2 = nrm(ks[19], (DEPTH, N_EXPERTS, EXPERT_FF, D), DEEPNORM_BETA * EXPERT_FF ** -0.5)
    ln2_g = 1.0 + nrm(ks[20], (DEPTH, D), 0.02)
    ln2_b = nrm(ks[21], (DEPTH, D), 0.02)
    return {'x': x, 'c': c, 'positions': positions, 'ln0_g': ln0_g, 'ln0_b': ln0_b,
            'w_ada': w_ada, 'b_ada': b_ada, 'w_in': w_in, 'w_out': w_out,
            'ret_log_decay_f': ret_log_decay_f, 'ret_log_decay_b': ret_log_decay_b,
            'ln1_g': ln1_g, 'ln1_b': ln1_b, 'w_group': w_group, 'b_group': b_group,
            'w_sub': w_sub, 'b_sub': b_sub, 'w1': w1, 'w3': w3, 'w2': w2,
            'ln2_g': ln2_g, 'ln2_b': ln2_b}


def reference(x, c, positions, ln0_g, ln0_b, w_ada, b_ada, w_in, w_out, ret_log_decay_f, ret_log_decay_b,
              ln1_g, ln1_b, w_group, b_group, w_sub, b_sub, w1, w3, w2, ln2_g, ln2_b):
    B, S, _ = x.shape
    x = layer_norm(x, ln0_g, ln0_b)
    inv_rope = ROPE_THETA ** (-jnp.arange(0, ROPE_DIM, 2, dtype=jnp.float32) / ROPE_DIM)
    inv_ret = RET_THETA ** (-jnp.linspace(0.0, 1.0, RET_HEAD_DIM // 2, dtype=jnp.float32))
    cs = jax.nn.silu(c)
    A, R = ATTN_WIDTH, RET_WIDTH

    def heads(t, n, d):
        return t.reshape(B, S, n, d).transpose(0, 2, 1, 3)

    for l in range(DEPTH):
        mod = cs @ w_ada[l] + b_ada[l]
        sh1, sc1, g1, sh2, sc2, g2 = [m[:, None, :] for m in jnp.split(mod, 6, axis=-1)]
        h = x * (1.0 + sc1) + sh1
        z = h @ w_in[l]
        aq, ak, av, rq, rk, rv, rg = jnp.split(z, [A, 2 * A, 3 * A, 3 * A + R, 3 * A + 2 * R, 3 * A + 3 * R], axis=-1)
        aq = rotary(heads(aq, ATTN_HEADS, ATTN_HEAD_DIM), positions, inv_rope) * ATTN_HEAD_DIM ** -0.5
        ak = rotary(heads(ak, ATTN_HEADS, ATTN_HEAD_DIM), positions, inv_rope)
        attn = dilated_mixture_attention(aq, ak, heads(av, ATTN_HEADS, ATTN_HEAD_DIM))
        attn = attn.transpose(0, 2, 1, 3).reshape(B, S, A)
        rq = rotary(heads(rq, RET_HEADS, RET_HEAD_DIM), positions, inv_ret)
        rk = rotary(heads(rk, RET_HEADS, RET_HEAD_DIM), positions, inv_ret) * RET_HEAD_DIM ** -0.5
        ret = bidirectional_retention(rq, rk, heads(rv, RET_HEADS, RET_HEAD_DIM), ret_log_decay_f[l], ret_log_decay_b[l])
        ret = jax.nn.silu(rg) * ret.transpose(0, 2, 1, 3).reshape(B, S, R).astype(rg.dtype)
        mix = jnp.concatenate([attn, ret], axis=-1) @ w_out[l]
        x = layer_norm(DEEPNORM_ALPHA * x + (1.0 + g1) * mix, ln1_g[l], ln1_b[l])
        h = x * (1.0 + sc2) + sh2
        ffn = hierarchical_moe(h, w_group[l], b_group[l], w_sub[l], b_sub[l], w1[l], w3[l], w2[l])
        x = layer_norm(DEEPNORM_ALPHA * x + (1.0 + g2) * ffn, ln2_g[l], ln2_b[l])
    return x
```

```cpp
#include <hip/hip_runtime.h>
#include <hip/hip_cooperative_groups.h>
#include <cstdio>
#include <cstdint>
namespace cg = cooperative_groups;

#ifndef MK_PER_PHASE_LAUNCH
#define MK_PER_PHASE_LAUNCH 1
#endif

#define LAS __attribute__((address_space(3)))
#define GAS __attribute__((address_space(1)))
typedef unsigned short bf16_t;
typedef short bf16x8 __attribute__((ext_vector_type(8)));
typedef float f32x4 __attribute__((ext_vector_type(4)));
typedef float f32x2 __attribute__((ext_vector_type(2)));
typedef unsigned u32x4 __attribute__((ext_vector_type(4)));
typedef unsigned u32x2 __attribute__((ext_vector_type(2)));
#define DI __device__ __forceinline__

constexpr int D = 2048, BATCH = 4, SEQ = 8192, T = BATCH * SEQ;
constexpr int AW = 1024, NIN = 7168, AH = 8, RH = 4;
constexpr int NE = 32, FF = 512;
constexpr float LN_EPS = 1e-5f;
constexpr float DN_ALPHA = 1.189207115002721f;
constexpr int NWAVES = 8, NTHREADS = 512;
constexpr int NPHASE = 10;

constexpr size_t MiB = 1u << 20;
constexpr size_t WS_CTL = 0, CTL_ZERO_BYTES = 1 * MiB;
constexpr size_t CTL_MOD = 64 * 1024;
constexpr size_t CTL_CNT = 512 * 1024;
constexpr size_t WS_WIN = 2 * MiB;
constexpr size_t WS_WOUT = 30 * MiB;
constexpr size_t WS_W13 = 38 * MiB;
constexpr size_t WS_W2 = 166 * MiB;
constexpr size_t WS_TAB = 230 * MiB;
constexpr size_t WS_STAT0 = 266 * MiB;
constexpr size_t WS_STAT1 = 267 * MiB;
constexpr size_t WS_SLOT = 275 * MiB;
constexpr size_t WS_WT = WS_SLOT + 256 * 1024;
constexpr size_t WS_LIST = 276 * MiB;
constexpr size_t WS_WR = 284 * MiB;
constexpr size_t WS_A = 288 * MiB;
constexpr size_t WS_B = 416 * MiB;
constexpr size_t WS_T = WS_B, WS_H2 = WS_B + 256 * MiB;
constexpr size_t WS_Y = WS_H2;
constexpr size_t WS_YF = 864 * MiB;
constexpr size_t WS_YB = WS_W13;
constexpr size_t WS_END = 1024 * MiB;

constexpr int LDS_BYTES = 147456;
constexpr int LDS_MISC = 131072;

DI unsigned f2bf(float f) { unsigned u = __float_as_uint(f); return (u + 0x7fffu + ((u >> 16) & 1u)) >> 16; }
DI unsigned pk2(float lo, float hi) { return f2bf(lo) | (f2bf(hi) << 16); }
DI float bf2f(unsigned h) { return __uint_as_float(h << 16); }
DI float bflo(unsigned w) { return __uint_as_float(w << 16); }
DI float bfhi(unsigned w) { return __uint_as_float(w & 0xffff0000u); }
DI float wave_sum(float v) {
#pragma unroll
    for (int o = 1; o < 64; o <<= 1) v += __shfl_xor(v, o);
    return v;
}
DI float wave_max(float v) {
#pragma unroll
    for (int o = 1; o < 64; o <<= 1) v = fmaxf(v, __shfl_xor(v, o));
    return v;
}
#define LDS_WAIT() asm volatile("s_waitcnt lgkmcnt(0)" ::: "memory")

struct Args { const void* in[22]; float* out; unsigned char* ws; int ph_lo, ph_hi; };

struct Ctx {
    LAS unsigned char* lds;
    int tid, lane, wave, G, vcu, gw, NGW;
    const float *x, *c, *ln0_g, *ln0_b, *w_ada, *b_ada, *w_in, *w_out, *ldf, *ldb, *ln1_g, *ln1_b, *w_group, *b_group, *w_sub, *b_sub, *w1, *w3, *w2, *ln2_g, *ln2_b;
    const int* positions;
    float* out; unsigned char* ws;
};

namespace pg8 {
constexpr int BM = 256, BK = 64, HALF = 128, HTB = HALF * BK * 2, STAGE_BYTES = 8 * HTB, NXCD = 8, WGM = 8;
__host__ __device__ __forceinline__ int lds_byte(int r, int c) { const int st = (r >> 4) * 2 + (c >> 5), rr = r & 15, cc = c & 31, ob = rr * 64 + cc * 2; return st * 1024 + (ob ^ (((ob >> 9) & 1) << 5)); }
__host__ __device__ __forceinline__ void stage_rc(int b, int& R, int& C) { const int st = b / 1024, sb = b % 1024, swz = sb ^ (((sb >> 9) & 1) << 5); R = (st >> 1) * 16 + swz / 64; C = (st & 1) * 32 + (swz % 64) / 2; }

struct Unit { const char* A; const char* B; const unsigned* rows; int nrows; int pm, pn, e; };

struct StaticOrder {
    int nM, nN, nwg, G, c; const char* A; const char* B; size_t tstepA, tstepB;
    DI void init(int M, int N, int K, int G_, int c_, const void* A_, const void* B_) { nM = M / BM; nN = N / BM; nwg = nM * nN; G = G_; c = c_; A = (const char*)A_; B = (const char*)B_; tstepA = (size_t)BM * K * 2; tstepB = (size_t)BM * K * 2; }
    DI bool next(int i, Unit& u) const {
        const long L = (long)i * G + c; if (L >= nwg) return false;
        int wgid = (int)L; { const int q = nwg / NXCD, r = nwg % NXCD, xcd = wgid % NXCD, off = wgid / NXCD; wgid = (xcd < r ? xcd * (q + 1) : r * (q + 1) + (xcd - r) * q) + off; }
        const int nig = WGM * nN, gid = wgid / nig, fm = gid * WGM, gsz = (nM - fm) < WGM ? (nM - fm) : WGM;
        u.pm = fm + ((wgid % nig) % gsz); u.pn = (wgid % nig) / gsz; u.e = 0; u.rows = nullptr; u.nrows = 0;
        u.A = A + (size_t)u.pm * tstepA; u.B = B + (size_t)u.pn * tstepB; return true;
    }
};

DI unsigned cvt_pk_bf16(float lo, float hi) { unsigned r; asm volatile("v_cvt_pk_bf16_f32 %0, %1, %2" : "=v"(r) : "v"(lo), "v"(hi)); return r; }

template <class Epi, class Sched, bool GATHER>
DI void gemm_phase(LAS unsigned char* lds, const int K, const Sched& S, const Epi& E) {
    const int tid = threadIdx.x, wid = __builtin_amdgcn_readfirstlane(tid >> 6), lane = tid & 63, wr = wid >> 2, wc = wid & 3, fr = lane & 15, fq = lane >> 4;
    const int nt = K / BK;
    int Rr[2], Cc[2];
    unsigned voffB[2], vA0[2], vA1[2], nA0[2], nA1[2];
#pragma unroll
    for (int i = 0; i < 2; ++i) { stage_rc(tid * 16 + i * 8192, Rr[i], Cc[i]); voffB[i] = (unsigned)(Rr[i] * K + Cc[i]) * 2u; }
    const size_t kstep = (size_t)(BK * 2);
    const size_t hstep = (size_t)HALF * K * 2;
    const unsigned ldsw = (unsigned)wid * 1024u;
    const int aoff = lds_byte(wr * 64 + fr, fq * 8), boff = lds_byte(wc * 32 + fr, fq * 8);
#define PG8_SA(b, h) (((b) * 2 + (h)) * HTB)
#define PG8_SB(b, h) ((4 + (b) * 2 + (h)) * HTB)
#define PG8_STAGE(bufoff, gbase, voff) do { _Pragma("unroll") for (int _i = 0; _i < 2; ++_i) \
        __builtin_amdgcn_global_load_lds((const unsigned*)((const char*)(gbase) + (voff)[_i]), (LAS unsigned*)(lds + (bufoff) + ldsw + _i * 8192), 16, 0, 0); } while (0)
#define PG8_LDA(dst, b, h) do { _Pragma("unroll") for (int m = 0; m < 4; ++m) _Pragma("unroll") for (int k = 0; k < 2; ++k) dst[m][k] = *(const LAS bf16x8*)(lds + PG8_SA(b, h) + aoff + m * 2048 + k * 1024); } while (0)
#define PG8_LDB(dst, b, h) do { _Pragma("unroll") for (int n = 0; n < 2; ++n) _Pragma("unroll") for (int k = 0; k < 2; ++k) dst[n][k] = *(const LAS bf16x8*)(lds + PG8_SB(b, h) + boff + n * 2048 + k * 1024); } while (0)
#define PG8_MMA(ai, bj, At, Bt) do { __builtin_amdgcn_s_setprio(1); _Pragma("unroll") for (int m = 0; m < 4; ++m) _Pragma("unroll") for (int n = 0; n < 2; ++n) _Pragma("unroll") for (int k = 0; k < 2; ++k) \
        acc[ai][bj][m][n] = __builtin_amdgcn_mfma_f32_16x16x32_bf16(Bt[n][k], At[m][k], acc[ai][bj][m][n], 0, 0, 0); __builtin_amdgcn_s_setprio(0); } while (0)
#define PG8_WAIT_V(n) asm volatile("s_waitcnt vmcnt(" #n ")" ::: "memory")
#define PG8_WAIT_L(n) asm volatile("s_waitcnt lgkmcnt(" #n ")" ::: "memory")
#define PG8_BAR __builtin_amdgcn_s_barrier()
#define PG8_SCHED __builtin_amdgcn_sched_barrier(0)
#define PG8_AOFFS(u, o0, o1) do { _Pragma("unroll") for (int _i = 0; _i < 2; ++_i) { \
        if constexpr (GATHER) { const int r0 = Rr[_i], r1 = Rr[_i] + HALF; \
            const unsigned t0 = r0 < (u).nrows ? (u).rows[r0] : 0u, t1 = r1 < (u).nrows ? (u).rows[r1] : 0u; \
            o0[_i] = (t0 * (unsigned)K + (unsigned)Cc[_i]) * 2u; o1[_i] = (t1 * (unsigned)K + (unsigned)Cc[_i]) * 2u; } \
        else { o0[_i] = voffB[_i]; o1[_i] = voffB[_i] + (unsigned)hstep; } } } while (0)
    Unit cur, nxt; int ui = 0;
    if (!S.next(0, cur)) return;
    f32x4 acc[2][2][4][2];
#pragma unroll
    for (int a = 0; a < 2; ++a)
#pragma unroll
        for (int b = 0; b < 2; ++b)
#pragma unroll
            for (int m = 0; m < 4; ++m)
#pragma unroll
                for (int n = 0; n < 2; ++n) acc[a][b][m][n] = (f32x4){0.f, 0.f, 0.f, 0.f};
    bf16x8 At[4][2], B0[2][2], B1[2][2];
    const char* cA = cur.A; const char* cB = cur.B;
    PG8_AOFFS(cur, vA0, vA1);
    PG8_STAGE(PG8_SB(0, 0), cB, voffB); PG8_STAGE(PG8_SB(0, 1), cB + hstep, voffB); PG8_STAGE(PG8_SA(0, 0), cA, vA0); PG8_STAGE(PG8_SA(0, 1), cA, vA1);
    if (wr == 1) PG8_BAR;
    PG8_WAIT_V(2); PG8_BAR;
    PG8_STAGE(PG8_SB(1, 0), cB + kstep, voffB); PG8_STAGE(PG8_SA(1, 0), cA + kstep, vA0); PG8_STAGE(PG8_SB(1, 1), cB + hstep + kstep, voffB);
    PG8_WAIT_V(6); PG8_BAR;
    for (;;) {
        const bool has_next = S.next(ui + 1, nxt);
        const char* nA = has_next ? nxt.A : cA; const char* nB = has_next ? nxt.B : cB;
        if (has_next) { PG8_AOFFS(nxt, nA0, nA1); } else {
#pragma unroll
            for (int i = 0; i < 2; ++i) { nA0[i] = vA0[i]; nA1[i] = vA1[i]; } }
        for (int t = 0; t < nt; t += 2) {
            const bool last = (t == nt - 2);
            const char* a1 = cA + (size_t)(t + 1) * kstep;
            const char* a2 = last ? nA : cA + (size_t)(t + 2) * kstep; const char* b2 = last ? nB : cB + (size_t)(t + 2) * kstep;
            const char* a3 = a2 + kstep; const char* b3 = b2 + kstep;
            unsigned u0[2], u1[2];
#pragma unroll
            for (int i = 0; i < 2; ++i) { u0[i] = last ? nA0[i] : vA0[i]; u1[i] = last ? nA1[i] : vA1[i]; }
            PG8_LDB(B0, 0, 0); PG8_LDB(B1, 0, 1); PG8_SCHED; PG8_LDA(At, 0, 0); PG8_STAGE(PG8_SA(1, 1), a1, vA1);
            PG8_WAIT_V(8); PG8_WAIT_L(0); PG8_BAR; PG8_MMA(0, 0, At, B0); PG8_MMA(0, 1, At, B1); PG8_BAR; PG8_SCHED;
            PG8_LDA(At, 0, 1); PG8_STAGE(PG8_SB(0, 0), b2, voffB); PG8_STAGE(PG8_SB(0, 1), b2 + hstep, voffB); PG8_STAGE(PG8_SA(0, 0), a2, u0);
            PG8_WAIT_V(8); PG8_WAIT_L(0); PG8_BAR; PG8_MMA(1, 0, At, B0); PG8_MMA(1, 1, At, B1); PG8_BAR; PG8_SCHED;
            PG8_LDB(B0, 1, 0); PG8_LDB(B1, 1, 1); PG8_SCHED; PG8_LDA(At, 1, 0); PG8_STAGE(PG8_SA(0, 1), a2, u1);
            PG8_WAIT_V(8); PG8_WAIT_L(0); PG8_BAR; PG8_MMA(0, 0, At, B0); PG8_MMA(0, 1, At, B1); PG8_BAR; PG8_SCHED;
            PG8_LDA(At, 1, 1); PG8_STAGE(PG8_SB(1, 0), b3, voffB); PG8_STAGE(PG8_SB(1, 1), b3 + hstep, voffB); PG8_STAGE(PG8_SA(1, 0), a3, u0);
            PG8_WAIT_V(8); PG8_WAIT_L(0); PG8_BAR; PG8_MMA(1, 0, At, B0); PG8_MMA(1, 1, At, B1); PG8_BAR; PG8_SCHED;
        }
        if (wr == 0) PG8_BAR;
        E(acc, cur, wr, wc, fr, fq);
        if (!has_next) break;
#pragma unroll
        for (int a = 0; a < 2; ++a)
#pragma unroll
            for (int b = 0; b < 2; ++b)
#pragma unroll
                for (int m = 0; m < 4; ++m)
#pragma unroll
                    for (int n = 0; n < 2; ++n) acc[a][b][m][n] = (f32x4){0.f, 0.f, 0.f, 0.f};
        cur = nxt; cA = nA; cB = nB; ++ui;
#pragma unroll
        for (int i = 0; i < 2; ++i) { vA0[i] = nA0[i]; vA1[i] = nA1[i]; }
        if (wr == 1) PG8_BAR;
    }
    PG8_WAIT_V(0);
    PG8_BAR;
#undef PG8_SA
#undef PG8_SB
#undef PG8_STAGE
#undef PG8_LDA
#undef PG8_LDB
#undef PG8_MMA
#undef PG8_WAIT_V
#undef PG8_WAIT_L
#undef PG8_BAR
#undef PG8_SCHED
#undef PG8_AOFFS
}
}

struct EpiInProj {
    bf16_t* z; const float* cosA; const float* sinA; const float* cosR; const float* sinR;
    DI void operator()(const f32x4 (&acc)[2][2][4][2], const pg8::Unit& u, int wr, int wc, int fr, int fq) const {
        const int seg = u.pn >> 2, colt = (u.pn & 3) * 256;
        bf16_t* zs = z + (size_t)seg * T * 1024;
        const float scale = (seg == 0) ? 0.08838834764831845f : (seg == 4 ? 0.0625f : 1.0f);
#pragma unroll
        for (int ai = 0; ai < 2; ++ai)
#pragma unroll
            for (int m = 0; m < 4; ++m) {
                const int row = u.pm * 256 + ai * 128 + wr * 64 + m * 16 + fr;
                f32x4 v[2][2];
#pragma unroll
                for (int bj = 0; bj < 2; ++bj)
#pragma unroll
                    for (int n = 0; n < 2; ++n) v[bj][n] = acc[ai][bj][m][n];
                if (seg == 3 || seg == 4) {
#pragma unroll
                    for (int n = 0; n < 2; ++n) {
                        const int f = wc * 32 + n * 16 + fq * 4;
                        const f32x4 cs = *(const f32x4*)(cosR + (size_t)row * 128 + f), sn = *(const f32x4*)(sinR + (size_t)row * 128 + f);
                        const f32x4 x1 = v[0][n], x2 = v[1][n];
                        v[0][n] = x1 * cs - x2 * sn; v[1][n] = x2 * cs + x1 * sn;
                    }
                } else if (seg <= 1) {
                    if (wc == 0) {
                        const f32x4 cs = *(const f32x4*)(cosA + (size_t)row * 16 + fq * 4), sn = *(const f32x4*)(sinA + (size_t)row * 16 + fq * 4);
#pragma unroll
                        for (int bj = 0; bj < 2; ++bj) { const f32x4 x1 = v[bj][0], x2 = v[bj][1]; v[bj][0] = x1 * cs - x2 * sn; v[bj][1] = x2 * cs + x1 * sn; }
                    }
                }
                bf16_t* rowp = zs + (size_t)row * 1024 + colt + wc * 32 + fq * 4;
#pragma unroll
                for (int bj = 0; bj < 2; ++bj)
#pragma unroll
                    for (int n = 0; n < 2; ++n) { const f32x4 o = v[bj][n] * scale; u32x2 w; w.x = pk2(o[0], o[1]); w.y = pk2(o[2], o[3]); *(u32x2*)(rowp + bj * 128 + n * 16) = w; }
            }
    }
};

struct EpiOutProj {
    const float* x; const float* mu0; const float* rstd0; const float* g0; const float* b0; const float* mod; float* t; float* part;
    DI void operator()(const f32x4 (&acc)[2][2][4][2], const pg8::Unit& u, int wr, int wc, int fr, int fq) const {
        const int col0 = u.pn * 256 + wc * 32 + fq * 4;
        const int b = (u.pm * 256) / SEQ;
        const float* g1 = mod + (size_t)b * 6 * D + 2 * D;
#pragma unroll
        for (int ai = 0; ai < 2; ++ai)
#pragma unroll
            for (int m = 0; m < 4; ++m) {
                const int row = u.pm * 256 + ai * 128 + wr * 64 + m * 16 + fr;
                const float mu = mu0[row], rs = rstd0[row];
                float s = 0.f, q = 0.f;
#pragma unroll
                for (int bj = 0; bj < 2; ++bj)
#pragma unroll
                    for (int n = 0; n < 2; ++n) {
                        const int c = col0 + bj * 128 + n * 16;
                        const f32x4 xv = *(const f32x4*)(x + (size_t)row * D + c);
                        const f32x4 gg = *(const f32x4*)(g0 + c), bb = *(const f32x4*)(b0 + c), g1v = *(const f32x4*)(g1 + c);
                        const f32x4 x0 = (xv - mu) * rs * gg + bb;
                        const f32x4 o = DN_ALPHA * x0 + (1.0f + g1v) * acc[ai][bj][m][n];
                        *(f32x4*)(t + (size_t)row * D + c) = o;
                        s += (o[0] + o[1]) + (o[2] + o[3]); q += (o[0] * o[0] + o[1] * o[1]) + (o[2] * o[2] + o[3] * o[3]);
                    }
                s += __shfl_xor(s, 16); s += __shfl_xor(s, 32); q += __shfl_xor(q, 16); q += __shfl_xor(q, 32);
                if (fq == 0) *(f32x2*)(part + ((size_t)row * 32 + u.pn * 4 + wc) * 2) = (f32x2){s, q};
            }
    }
};

struct EpiMoeUp {
    bf16_t* act;
    DI void operator()(const f32x4 (&acc)[2][2][4][2], const pg8::Unit& u, int wr, int wc, int fr, int fq) const {
#pragma unroll
        for (int ai = 0; ai < 2; ++ai)
#pragma unroll
            for (int m = 0; m < 4; ++m) {
                const int row = u.pm * 256 + ai * 128 + wr * 64 + m * 16 + fr;
                bf16_t* rowp = act + (size_t)row * FF + u.pn * 128 + wc * 32 + fq * 4;
#pragma unroll
                for (int n = 0; n < 2; ++n) {
                    const f32x4 g = acc[ai][0][m][n], up = acc[ai][1][m][n]; f32x4 o;
#pragma unroll
                    for (int j = 0; j < 4; ++j) o[j] = g[j] / (1.0f + __expf(-g[j])) * up[j];
                    u32x2 w; w.x = pk2(o[0], o[1]); w.y = pk2(o[2], o[3]); *(u32x2*)(rowp + n * 16) = w;
                }
            }
    }
};
struct EpiMoeDown {
    bf16_t* Y;
    DI void operator()(const f32x4 (&acc)[2][2][4][2], const pg8::Unit& u, int wr, int wc, int fr, int fq) const {
#pragma unroll
        for (int ai = 0; ai < 2; ++ai)
#pragma unroll
            for (int m = 0; m < 4; ++m) {
                const int row = u.pm * 256 + ai * 128 + wr * 64 + m * 16 + fr;
                bf16_t* rowp = Y + (size_t)row * D + u.pn * 256 + wc * 32 + fq * 4;
#pragma unroll
                for (int bj = 0; bj < 2; ++bj)
#pragma unroll
                    for (int n = 0; n < 2; ++n) { const f32x4 o = acc[ai][bj][m][n]; u32x2 w; w.x = pk2(o[0], o[1]); w.y = pk2(o[2], o[3]); *(u32x2*)(rowp + bj * 128 + n * 16) = w; }
            }
    }
};

struct MoeOrder {
    const LAS int* pre; int NT, G, c, total; const char* A; const char* Bw; size_t bstride_e, tstepB, tstepA; const unsigned* lists; const unsigned* cnt; bool gather;
    DI bool next(int i, pg8::Unit& u) const {
        const long L = (long)i * G + c; if (L >= total) return false;
        const int mt = (int)(L / NT), nt = (int)(L % NT);
        int e = 0;
#pragma unroll 1
        for (int k = 1; k < NE; ++k) e += (pre[k] <= mt) ? 1 : 0;
        const int lm = mt - pre[e];
        u.pm = mt; u.pn = nt; u.e = e;
        u.B = Bw + (size_t)e * bstride_e + (size_t)nt * tstepB;
        if (gather) { u.A = A; u.rows = lists + (size_t)e * 65536 + lm * 256; const int cn = (int)cnt[e] - lm * 256; u.nrows = cn < 256 ? cn : 256; }
        else { u.A = A + (size_t)mt * tstepA; u.rows = nullptr; u.nrows = 0; }
        return true;
    }
};

DI void phase_mod(const Ctx& X) {
    float* mod = (float*)(X.ws + CTL_MOD);
    for (int it = X.gw; it < 48 * 32; it += X.NGW) {
        const int cgp = it % 48, kc = it / 48;
        const float* W = X.w_ada + (size_t)(kc * 64) * (6 * D) + cgp * 256 + X.lane * 4;
        f32x4 acc[4];
#pragma unroll
        for (int b = 0; b < 4; ++b) acc[b] = (f32x4){0.f, 0.f, 0.f, 0.f};
#pragma unroll 8
        for (int kk = 0; kk < 64; ++kk) {
            const f32x4 w = *(const f32x4*)(W + (size_t)kk * (6 * D));
#pragma unroll
            for (int b = 0; b < 4; ++b) { const float cv = X.c[b * D + kc * 64 + kk]; const float s = cv / (1.0f + expf(-cv)); acc[b] += s * w; }
        }
        if (kc == 0) { const f32x4 bb = *(const f32x4*)(X.b_ada + cgp * 256 + X.lane * 4);
#pragma unroll
            for (int b = 0; b < 4; ++b) acc[b] += bb; }
#pragma unroll
        for (int b = 0; b < 4; ++b)
#pragma unroll
            for (int j = 0; j < 4; ++j) atomicAdd(mod + (size_t)b * 6 * D + cgp * 256 + X.lane * 4 + j, acc[b][j]);
    }
}

template <class RowMap>
DI void transpose_item(const float* W, int K, int N, bf16_t* WT, const RowMap& rm, LAS float* scr, int item, int lane) {
    const int nblk = N / 32, kb = item / nblk, nb = item % nblk, k0 = 64 * kb, n0 = 32 * nb;
#pragma unroll 8
    for (int i = 0; i < 32; ++i) { const int kk = 2 * i + (lane >> 5); scr[kk * 33 + (lane & 31)] = W[(size_t)(k0 + kk) * N + n0 + (lane & 31)]; }
    LDS_WAIT();
    const int c = lane & 7;
#pragma unroll
    for (int j = 0; j < 4; ++j) { const int n = (lane >> 3) + 8 * j; const LAS float* s = scr + (8 * c) * 33 + n;
        u32x4 o; o.x = pk2(s[0 * 33], s[1 * 33]); o.y = pk2(s[2 * 33], s[3 * 33]); o.z = pk2(s[4 * 33], s[5 * 33]); o.w = pk2(s[6 * 33], s[7 * 33]);
        *(u32x4*)(WT + (size_t)rm(n0 + n) * K + k0 + 8 * c) = o; }
    LDS_WAIT();
}
struct RowId { DI int operator()(int n) const { return n; } };
struct RowGate { int up; DI int operator()(int n) const { return (n >> 7) * 256 + up * 128 + (n & 127); } };

DI void sincos_d(float angf, float& c, float& s) {
    const double a = (double)angf;
    const double k = rint(a * 0.63661977236758134308);
    double r = a - k * 1.57079632673412561417e+00; r -= k * 6.07710050650619224932e-11;
    const double r2 = r * r;
    double sp = -1.0 / 6227020800.0; sp = sp * r2 + 1.0 / 39916800.0; sp = sp * r2 - 1.0 / 362880.0; sp = sp * r2 + 1.0 / 5040.0; sp = sp * r2 - 1.0 / 120.0; sp = sp * r2 + 1.0 / 6.0;
    const double sn = r - r * r2 * sp;
    double cp = -1.0 / 87178291200.0; cp = cp * r2 + 1.0 / 479001600.0; cp = cp * r2 - 1.0 / 3628800.0; cp = cp * r2 + 1.0 / 40320.0; cp = cp * r2 - 1.0 / 720.0; cp = cp * r2 + 1.0 / 24.0;
    const double cn = 1.0 - 0.5 * r2 + r2 * r2 * cp;
    const long long q = (long long)k; const int qq = (int)(q & 3);
    double so, co;
    if (qq == 0) { so = sn; co = cn; } else if (qq == 1) { so = cn; co = -sn; } else if (qq == 2) { so = -sn; co = -cn; } else { so = -cn; co = sn; }
    c = (float)co; s = (float)so;
}

DI void phase_pre(const Ctx& X) {
    LAS float* scr = (LAS float*)(X.lds + X.wave * 16384);
    bf16_t* WinT = (bf16_t*)(X.ws + WS_WIN); bf16_t* WoutT = (bf16_t*)(X.ws + WS_WOUT);
    constexpr int I_IN = (D / 64) * (NIN / 32), I_OUT = (D / 64) * (D / 32);
    for (int it = X.gw; it < I_IN + I_OUT; it += X.NGW) {
        if (it < I_IN) transpose_item(X.w_in, D, NIN, WinT, RowId{}, scr, it, X.lane);
        else transpose_item(X.w_out, D, D, WoutT, RowId{}, scr, it - I_IN, X.lane);
    }
    float* cosA = (float*)(X.ws + WS_TAB); float* sinA = cosA + (size_t)T * 16; float* cosR = sinA + (size_t)T * 16; float* sinR = cosR + (size_t)T * 128;
    {
        const long gt = (long)X.gw * 64 + X.lane, NGT = (long)X.NGW * 64;
        for (long i = gt; i < (long)T * 144; i += NGT) {
            const int tok = (int)(i / 144), f = (int)(i % 144);
            const float pos = (float)X.positions[tok];
            float inv;
            if (f < 16) inv = (float)exp(-((double)(2 * f) / 32.0) * 13.122363377404328);
            else { const float tt = (float)(f - 16) / 127.0f; inv = (float)exp(-(double)tt * 9.210340371976184); }
            const float ang = pos * inv; float c, s; sincos_d(ang, c, s);
            if (f < 16) { cosA[(size_t)tok * 16 + f] = c; sinA[(size_t)tok * 16 + f] = s; } else { cosR[(size_t)tok * 128 + f - 16] = c; sinR[(size_t)tok * 128 + f - 16] = s; }
        }
        float* WRt = (float*)(X.ws + WS_WR);
        for (long i = gt; i < 36L * D; i += NGT) {
            const int col = (int)(i / D), k = (int)(i % D);
            WRt[i] = col < 32 ? X.w_sub[((size_t)(col >> 3) * D + k) * 8 + (col & 7)] : X.w_group[(size_t)k * 4 + (col - 32)];
        }
    }
    const float* mod = (const float*)(X.ws + CTL_MOD);
    float* mu0 = (float*)(X.ws + WS_STAT0); float* rstd0 = mu0 + T;
    bf16_t* h = (bf16_t*)(X.ws + WS_A);
    for (int row = X.gw; row < T; row += X.NGW) {
        const int b = row / SEQ;
        const f32x4* xr = (const f32x4*)(X.x + (size_t)row * D) + X.lane;
        f32x4 v[8]; float s = 0.f;
#pragma unroll
        for (int j = 0; j < 8; ++j) { v[j] = xr[64 * j]; s += (v[j][0] + v[j][1]) + (v[j][2] + v[j][3]); }
        const float mean = wave_sum(s) * (1.0f / D); float s2 = 0.f;
#pragma unroll
        for (int j = 0; j < 8; ++j) { v[j] = v[j] - mean; s2 += (v[j][0] * v[j][0] + v[j][1] * v[j][1]) + (v[j][2] * v[j][2] + v[j][3] * v[j][3]); }
        const float rstd = 1.0f / sqrtf(wave_sum(s2) * (1.0f / D) + LN_EPS);
        if (X.lane == 0) { mu0[row] = mean; rstd0[row] = rstd; }
        const float* sh1 = mod + (size_t)b * 6 * D; const float* sc1 = sh1 + D;
        u32x2* o8 = (u32x2*)(h + (size_t)row * D) + X.lane;
#pragma unroll
        for (int j = 0; j < 8; ++j) {
            const int c = 4 * X.lane + 256 * j;
            const f32x4 gg = *(const f32x4*)(X.ln0_g + c), bb = *(const f32x4*)(X.ln0_b + c), sc = *(const f32x4*)(sc1 + c), sh = *(const f32x4*)(sh1 + c);
            const f32x4 xn = v[j] * rstd * gg + bb; const f32x4 hv = xn * (1.0f + sc) + sh;
            u32x2 w; w.x = pk2(hv[0], hv[1]); w.y = pk2(hv[2], hv[3]); o8[64 * j] = w;
        }
    }
}

DI void phase_attn_naive(const Ctx& X) {
    const bf16_t* aq = (const bf16_t*)(X.ws + WS_B); const bf16_t* ak = aq + (size_t)T * 1024; const bf16_t* av = ak + (size_t)T * 1024;
    bf16_t* mix = (bf16_t*)(X.ws + WS_A);
    LAS float* qs = (LAS float*)(X.lds + X.wave * 1024);
    for (int it = X.gw; it < T * AH; it += X.NGW) {
        const int row = it >> 3, hh = it & 7, s = row & (SEQ - 1);
        { const unsigned w = *(const unsigned*)(aq + (size_t)row * 1024 + hh * 128 + 2 * X.lane); qs[2 * X.lane] = bflo(w); qs[2 * X.lane + 1] = bfhi(w); }
        LDS_WAIT();
        float sc[9]; bool vd[9];
#pragma unroll
        for (int p = 0; p < 3; ++p) {
            const int dil = p == 0 ? 1 : (p == 1 ? 4 : 16);
#pragma unroll
            for (int ps = 0; ps < 3; ++ps) {
                const int j = ps == 0 ? X.lane - 64 : (ps == 1 ? X.lane : 64);
                const int sp = s + dil * j;
                const bool valid = (ps < 2 || X.lane == 0) && sp >= 0 && sp < SEQ;
                const int spc = valid ? sp : s;
                const u32x4* kr = (const u32x4*)(ak + ((size_t)(row - s + spc)) * 1024 + hh * 128);
                float dot = 0.f;
#pragma unroll 4
                for (int ch = 0; ch < 16; ++ch) {
                    const u32x4 kw = kr[ch]; const f32x4 q0 = *(const LAS f32x4*)(qs + 8 * ch), q1 = *(const LAS f32x4*)(qs + 8 * ch + 4);
                    dot += bflo(kw.x) * q0[0] + bfhi(kw.x) * q0[1] + bflo(kw.y) * q0[2] + bfhi(kw.y) * q0[3] + bflo(kw.z) * q1[0] + bfhi(kw.z) * q1[1] + bflo(kw.w) * q1[2] + bfhi(kw.w) * q1[3];
                }
                sc[p * 3 + ps] = valid ? dot : -1e30f; vd[p * 3 + ps] = valid;
            }
        }
        float m = sc[0];
#pragma unroll
        for (int i = 1; i < 9; ++i) m = fmaxf(m, sc[i]);
        m = wave_max(m);
        float l = 0.f;
#pragma unroll
        for (int i = 0; i < 9; ++i) { sc[i] = vd[i] ? expf(sc[i] - m) : 0.f; l += sc[i]; }
        l = wave_sum(l);
        float a0 = 0.f, a1 = 0.f;
#pragma unroll
        for (int p = 0; p < 3; ++p) {
            const int dil = p == 0 ? 1 : (p == 1 ? 4 : 16);
#pragma unroll
            for (int ps = 0; ps < 3; ++ps) {
                const int nk = ps < 2 ? 64 : 1;
                for (int k = 0; k < nk; ++k) {
                    const float pk = __shfl(sc[p * 3 + ps], k);
                    if (pk != 0.f) {
                        const int j = ps == 0 ? k - 64 : (ps == 1 ? k : 64);
                        const unsigned w = *(const unsigned*)(av + ((size_t)(row + dil * j)) * 1024 + hh * 128 + 2 * X.lane);
                        a0 += pk * bflo(w); a1 += pk * bfhi(w);
                    }
                }
            }
        }
        const float il = 1.0f / l;
        *(unsigned*)(mix + (size_t)row * D + hh * 128 + 2 * X.lane) = pk2(a0 * il, a1 * il);
        LDS_WAIT();
    }
}

DI void phase_ret_naive(const Ctx& X) {
    const bf16_t* rq = (const bf16_t*)(X.ws + WS_B) + (size_t)3 * T * 1024; const bf16_t* rk = rq + (size_t)T * 1024; const bf16_t* rv = rk + (size_t)T * 1024;
    LAS float* qsm = (LAS float*)X.lds;
    LAS float* ksm = qsm + 16 * 256;
    LAS float* vsm = ksm + 16 * 256;
    LAS float* yp = vsm + 16 * 64;
    const int e = X.tid & 63, dq = X.wave;
    for (int it = X.vcu; it < 16 * 2 * 4; it += X.G) {
        const int eq = it & 3, dir = (it >> 2) & 1, bh = it >> 3, b = bh >> 2, hh = bh & 3;
        const float gam = expf(dir ? X.ldb[hh] : X.ldf[hh]);
        float* ybuf = (float*)(X.ws + (dir ? WS_YB : WS_YF));
        float st[32];
#pragma unroll
        for (int i = 0; i < 32; ++i) st[i] = 0.f;
        for (int blk = 0; blk < SEQ / 16; ++blk) {
            const int t0 = dir ? (SEQ - 16 - 16 * blk) : 16 * blk;
            const size_t row0 = (size_t)b * SEQ + t0;
            {
                const int tt = X.tid >> 5, c8 = (X.tid & 31) * 8;
                const u32x4 qw = *(const u32x4*)(rq + (row0 + tt) * 1024 + hh * 256 + c8), kw = *(const u32x4*)(rk + (row0 + tt) * 1024 + hh * 256 + c8);
                LAS float* qd = qsm + tt * 256 + c8; LAS float* kd = ksm + tt * 256 + c8;
                qd[0] = bflo(qw.x); qd[1] = bfhi(qw.x); qd[2] = bflo(qw.y); qd[3] = bfhi(qw.y); qd[4] = bflo(qw.z); qd[5] = bfhi(qw.z); qd[6] = bflo(qw.w); qd[7] = bfhi(qw.w);
                kd[0] = bflo(kw.x); kd[1] = bfhi(kw.x); kd[2] = bflo(kw.y); kd[3] = bfhi(kw.y); kd[4] = bflo(kw.z); kd[5] = bfhi(kw.z); kd[6] = bflo(kw.w); kd[7] = bfhi(kw.w);
                if (X.tid < 256) { const int t2 = X.tid >> 4, c4 = (X.tid & 15) * 4; const u32x2 vw = *(const u32x2*)(rv + (row0 + t2) * 1024 + hh * 256 + eq * 64 + c4);
                    LAS float* vd = vsm + t2 * 64 + c4; vd[0] = bflo(vw.x); vd[1] = bfhi(vw.x); vd[2] = bflo(vw.y); vd[3] = bfhi(vw.y); }
            }
            __syncthreads();
#pragma unroll 1
            for (int i = 0; i < 16; ++i) {
                const int tt = dir ? 15 - i : i;
                const float vv = vsm[tt * 64 + e];
                const LAS float* kq = ksm + tt * 256 + dq * 32; const LAS float* qq = qsm + tt * 256 + dq * 32;
                float y = 0.f;
                if (dir == 0) {
#pragma unroll
                    for (int d = 0; d < 32; ++d) { st[d] = gam * st[d] + kq[d] * vv; y += qq[d] * st[d]; }
                } else {
#pragma unroll
                    for (int d = 0; d < 32; ++d) { y += qq[d] * st[d]; st[d] = gam * st[d] + kq[d] * vv; }
                    y *= gam;
                }
                yp[(dq * 16 + tt) * 64 + e] = y;
            }
            __syncthreads();
            for (int o = X.tid; o < 16 * 64; o += NTHREADS) {
                const int tt = o >> 6, ee = o & 63; float y = 0.f;
#pragma unroll
                for (int q = 0; q < 8; ++q) y += yp[(q * 16 + tt) * 64 + ee];
                ybuf[(row0 + tt) * 1024 + hh * 256 + eq * 64 + ee] = y;
            }
            __syncthreads();
        }
    }
}

DI void phase_ret_fin_naive(const Ctx& X) {
    const float* yf = (const float*)(X.ws + WS_YF); const float* yb = (const float*)(X.ws + WS_YB);
    const bf16_t* rg = (const bf16_t*)(X.ws + WS_B) + (size_t)6 * T * 1024;
    bf16_t* mix = (bf16_t*)(X.ws + WS_A);
    for (int it = X.gw; it < T * RH; it += X.NGW) {
        const int row = it >> 2, hh = it & 3; const size_t off = (size_t)row * 1024 + hh * 256 + 4 * X.lane;
        f32x4 y = *(const f32x4*)(yf + off) + *(const f32x4*)(yb + off);
        const float mean = wave_sum((y[0] + y[1]) + (y[2] + y[3])) * (1.0f / 256.0f);
        y = y - mean;
        const float var = wave_sum((y[0] * y[0] + y[1] * y[1]) + (y[2] * y[2] + y[3] * y[3])) * (1.0f / 256.0f);
        const float rstd = 1.0f / sqrtf(var + LN_EPS);
        const u32x2 gw = *(const u32x2*)(rg + off);
        const float g0 = bflo(gw.x), g1 = bfhi(gw.x), g2 = bflo(gw.y), g3 = bfhi(gw.y);
        f32x4 o; o[0] = g0 / (1.f + expf(-g0)) * y[0] * rstd; o[1] = g1 / (1.f + expf(-g1)) * y[1] * rstd; o[2] = g2 / (1.f + expf(-g2)) * y[2] * rstd; o[3] = g3 / (1.f + expf(-g3)) * y[3] * rstd;
        u32x2 w; w.x = pk2(o[0], o[1]); w.y = pk2(o[2], o[3]);
        *(u32x2*)(mix + (size_t)row * D + 1024 + hh * 256 + 4 * X.lane) = w;
    }
}

DI void phase_route(const Ctx& X) {
    {
        LAS float* scr = (LAS float*)(X.lds + X.wave * 16384);
        bf16_t* W13 = (bf16_t*)(X.ws + WS_W13); bf16_t* W2 = (bf16_t*)(X.ws + WS_W2);
        constexpr int I_1 = (D / 64) * (FF / 32), I_2 = (FF / 64) * (D / 32);
        for (int it = X.gw; it < NE * (2 * I_1 + I_2); it += X.NGW) {
            const int e = it / (2 * I_1 + I_2); int r = it % (2 * I_1 + I_2);
            if (r < I_1) transpose_item(X.w1 + (size_t)e * D * FF, D, FF, W13 + (size_t)e * 1024 * D, RowGate{0}, scr, r, X.lane);
            else if (r < 2 * I_1) transpose_item(X.w3 + (size_t)e * D * FF, D, FF, W13 + (size_t)e * 1024 * D, RowGate{1}, scr, r - I_1, X.lane);
            else transpose_item(X.w2 + (size_t)e * FF * D, FF, D, W2 + (size_t)e * D * FF, RowId{}, scr, r - 2 * I_1, X.lane);
        }
    }
    const float* t = (const float*)(X.ws + WS_T); const float* part = (const float*)(X.ws + WS_STAT1);
    const float* mod = (const float*)(X.ws + CTL_MOD); const float* WRt = (const float*)(X.ws + WS_WR);
    bf16_t* h2 = (bf16_t*)(X.ws + WS_H2);
    unsigned* slot = (unsigned*)(X.ws + WS_SLOT); float* wt = (float*)(X.ws + WS_WT); unsigned* lists = (unsigned*)(X.ws + WS_LIST); unsigned* cnt = (unsigned*)(X.ws + CTL_CNT);
    for (int rg4 = X.gw; rg4 < T / 4; rg4 += X.NGW) {
        const int row0 = rg4 * 4, b = row0 / SEQ;
        const float* sh2 = mod + (size_t)b * 6 * D + 3 * D; const float* sc2 = sh2 + D;
        f32x4 v[4][8];
#pragma unroll
        for (int r = 0; r < 4; ++r) {
            const int row = row0 + r;
            float ps = 0.f, pq = 0.f; if (X.lane < 32) { const f32x2 p = *(const f32x2*)(part + ((size_t)row * 32 + X.lane) * 2); ps = p[0]; pq = p[1]; }
            ps = wave_sum(ps); pq = wave_sum(pq);
            const float mean = ps * (1.0f / D); const float var = fmaxf(pq * (1.0f / D) - mean * mean, 0.f); const float rstd = 1.0f / sqrtf(var + LN_EPS);
            const f32x4* tr = (const f32x4*)(t + (size_t)row * D) + X.lane;
            u32x2* o8 = (u32x2*)(h2 + (size_t)row * D) + X.lane;
#pragma unroll
            for (int j = 0; j < 8; ++j) {
                const int c = 4 * X.lane + 256 * j;
                const f32x4 gg = *(const f32x4*)(X.ln1_g + c), bb = *(const f32x4*)(X.ln1_b + c), sc = *(const f32x4*)(sc2 + c), sh = *(const f32x4*)(sh2 + c);
                const f32x4 x1 = (tr[64 * j] - mean) * rstd * gg + bb; const f32x4 hv = x1 * (1.0f + sc) + sh;
                v[r][j] = hv;
                u32x2 w; w.x = pk2(hv[0], hv[1]); w.y = pk2(hv[2], hv[3]); o8[64 * j] = w;
            }
        }
        LAS float* lgs = (LAS float*)(X.lds + LDS_MISC + 256 + X.wave * 1024);
#pragma unroll 2
        for (int col = 0; col < 36; ++col) {
            const f32x4* wr_ = (const f32x4*)(WRt + (size_t)col * D) + X.lane;
            float a[4] = {0.f, 0.f, 0.f, 0.f};
#pragma unroll
            for (int j = 0; j < 8; ++j) { const f32x4 w = wr_[64 * j];
#pragma unroll
                for (int r = 0; r < 4; ++r) a[r] += (v[r][j][0] * w[0] + v[r][j][1] * w[1]) + (v[r][j][2] * w[2] + v[r][j][3] * w[3]); }
#pragma unroll
            for (int r = 0; r < 4; ++r) { const float sm = wave_sum(a[r]); if (X.lane == 0) lgs[r * 36 + col] = sm; }
        }
        LDS_WAIT();
#pragma unroll
        for (int r = 0; r < 4; ++r) {
            const int row = row0 + r;
            float gl[4];
#pragma unroll
            for (int g = 0; g < 4; ++g) gl[g] = lgs[r * 36 + 32 + g] + X.b_group[g];
            int gs = 0; float gm = gl[0];
#pragma unroll
            for (int g = 1; g < 4; ++g) if (gl[g] > gm) { gm = gl[g]; gs = g; }
            float den = 0.f;
#pragma unroll
            for (int g = 0; g < 4; ++g) den += expf(gl[g] - gm);
            const float pg = 1.0f / den;
            float sl[8];
#pragma unroll
            for (int e = 0; e < 8; ++e) sl[e] = lgs[r * 36 + gs * 8 + e] + X.b_sub[gs * 8 + e];
            int i0 = 0; float v0 = sl[0];
#pragma unroll
            for (int e = 1; e < 8; ++e) if (sl[e] > v0) { v0 = sl[e]; i0 = e; }
            int i1 = -1; float v1 = -3.0e38f;
#pragma unroll
            for (int e = 0; e < 8; ++e) if (e != i0 && sl[e] > v1) { v1 = sl[e]; i1 = e; }
            const float e1 = expf(v1 - v0); const float w0 = pg / (1.0f + e1), w1 = pg * e1 / (1.0f + e1);
            if (X.lane == 0) {
                const int ea = gs * 8 + i0, eb = gs * 8 + i1;
                const unsigned pa = atomicAdd(cnt + ea, 1u), pb = atomicAdd(cnt + eb, 1u);
                lists[(size_t)ea * 65536 + pa] = (unsigned)row; lists[(size_t)eb * 65536 + pb] = (unsigned)row;
                slot[row * 2] = ((unsigned)ea << 20) | pa; slot[row * 2 + 1] = ((unsigned)eb << 20) | pb;
                wt[row * 2] = w0; wt[row * 2 + 1] = w1;
            }
        }
        LDS_WAIT();
    }
}

DI int moe_prefix(const Ctx& X, LAS int* pre) {
    const unsigned* cnt = (const unsigned*)(X.ws + CTL_CNT);
    if (X.tid == 0) { int s = 0; for (int e = 0; e < NE; ++e) { pre[e] = s; s += ((int)__hip_atomic_load(cnt + e, __ATOMIC_RELAXED, __HIP_MEMORY_SCOPE_AGENT) + 255) >> 8; } pre[NE] = s; }
    __syncthreads();
    return pre[NE];
}

DI void phase_final(const Ctx& X) {
    LAS int* pre = (LAS int*)(X.lds + LDS_MISC);
    moe_prefix(X, pre);
    const float* t = (const float*)(X.ws + WS_T); const float* part = (const float*)(X.ws + WS_STAT1);
    const float* mod = (const float*)(X.ws + CTL_MOD);
    const bf16_t* Y = (const bf16_t*)(X.ws + WS_Y);
    const unsigned* slot = (const unsigned*)(X.ws + WS_SLOT); const float* wt = (const float*)(X.ws + WS_WT);
    for (int row = X.gw; row < T; row += X.NGW) {
        const int b = row / SEQ; const float* g2 = mod + (size_t)b * 6 * D + 5 * D;
        float ps = 0.f, pq = 0.f; if (X.lane < 32) { const f32x2 p = *(const f32x2*)(part + ((size_t)row * 32 + X.lane) * 2); ps = p[0]; pq = p[1]; }
        ps = wave_sum(ps); pq = wave_sum(pq);
        const float mean = ps * (1.0f / D); const float var = fmaxf(pq * (1.0f / D) - mean * mean, 0.f); const float rstd = 1.0f / sqrtf(var + LN_EPS);
        const unsigned s0 = slot[row * 2], s1 = slot[row * 2 + 1]; const float w0 = wt[row * 2], w1 = wt[row * 2 + 1];
        const size_t r0 = (size_t)pre[s0 >> 20] * 256 + (s0 & 0xfffffu), r1 = (size_t)pre[s1 >> 20] * 256 + (s1 & 0xfffffu);
        const f32x4* tr = (const f32x4*)(t + (size_t)row * D) + X.lane;
        const u32x2* y0 = (const u32x2*)(Y + r0 * D) + X.lane; const u32x2* y1 = (const u32x2*)(Y + r1 * D) + X.lane;
        f32x4 u[8]; float s = 0.f;
#pragma unroll
        for (int j = 0; j < 8; ++j) {
            const int c = 4 * X.lane + 256 * j;
            const f32x4 gg = *(const f32x4*)(X.ln1_g + c), bb = *(const f32x4*)(X.ln1_b + c), g2v = *(const f32x4*)(g2 + c);
            const f32x4 x1 = (tr[64 * j] - mean) * rstd * gg + bb;
            const u32x2 a = y0[64 * j], bq = y1[64 * j];
            f32x4 f; f[0] = w0 * bflo(a.x) + w1 * bflo(bq.x); f[1] = w0 * bfhi(a.x) + w1 * bfhi(bq.x); f[2] = w0 * bflo(a.y) + w1 * bflo(bq.y); f[3] = w0 * bfhi(a.y) + w1 * bfhi(bq.y);
            u[j] = DN_ALPHA * x1 + (1.0f + g2v) * f;
            s += (u[j][0] + u[j][1]) + (u[j][2] + u[j][3]);
        }
        const float m2 = wave_sum(s) * (1.0f / D); float q = 0.f;
#pragma unroll
        for (int j = 0; j < 8; ++j) { u[j] = u[j] - m2; q += (u[j][0] * u[j][0] + u[j][1] * u[j][1]) + (u[j][2] * u[j][2] + u[j][3] * u[j][3]); }
        const float rs2 = 1.0f / sqrtf(wave_sum(q) * (1.0f / D) + LN_EPS);
        f32x4* orow = (f32x4*)(X.out + (size_t)row * D) + X.lane;
#pragma unroll
        for (int j = 0; j < 8; ++j) { const int c = 4 * X.lane + 256 * j; orow[64 * j] = u[j] * rs2 * *(const f32x4*)(X.ln2_g + c) + *(const f32x4*)(X.ln2_b + c); }
    }
}

__global__ void __launch_bounds__(NTHREADS, 2) fwd_kernel(Args args) {
    extern __shared__ __attribute__((aligned(16))) unsigned char lds_raw[];
    Ctx X;
    X.lds = (LAS unsigned char*)lds_raw;
    X.tid = threadIdx.x; X.lane = X.tid & 63; X.wave = __builtin_amdgcn_readfirstlane(X.tid >> 6);
    X.G = gridDim.x; { const int bx = blockIdx.x; X.vcu = (X.G % 8 == 0) ? (bx % 8) * (X.G / 8) + bx / 8 : bx; }
    X.gw = X.vcu * NWAVES + X.wave; X.NGW = X.G * NWAVES;
    X.x = (const float*)args.in[0]; X.c = (const float*)args.in[1]; X.positions = (const int*)args.in[2];
    X.ln0_g = (const float*)args.in[3]; X.ln0_b = (const float*)args.in[4]; X.w_ada = (const float*)args.in[5]; X.b_ada = (const float*)args.in[6];
    X.w_in = (const float*)args.in[7]; X.w_out = (const float*)args.in[8]; X.ldf = (const float*)args.in[9]; X.ldb = (const float*)args.in[10];
    X.ln1_g = (const float*)args.in[11]; X.ln1_b = (const float*)args.in[12]; X.w_group = (const float*)args.in[13]; X.b_group = (const float*)args.in[14];
    X.w_sub = (const float*)args.in[15]; X.b_sub = (const float*)args.in[16]; X.w1 = (const float*)args.in[17]; X.w3 = (const float*)args.in[18]; X.w2 = (const float*)args.in[19];
    X.ln2_g = (const float*)args.in[20]; X.ln2_b = (const float*)args.in[21];
    X.out = args.out; X.ws = args.ws;
    const int lo = args.ph_lo, hi = args.ph_hi;
#ifndef PH_MASK
#define PH_MASK 0x3ff
#endif
#define IN(k) (((PH_MASK >> (k)) & 1) && lo <= (k) && (k) < hi)
#define SEAM(k) do { if (IN(k) && IN((k) + 1)) { cg::this_grid().sync(); } } while (0)

    if (IN(0)) { phase_mod(X); } SEAM(0);
    if (IN(1)) { phase_pre(X); } SEAM(1);
    if (IN(2)) {
        pg8::StaticOrder S; S.init(T, NIN, D, X.G, (int)blockIdx.x, X.ws + WS_A, X.ws + WS_WIN);
        float* cosA = (float*)(X.ws + WS_TAB); float* sinA = cosA + (size_t)T * 16; float* cosR = sinA + (size_t)T * 16; float* sinR = cosR + (size_t)T * 128;
        EpiInProj E{(bf16_t*)(X.ws + WS_B), cosA, sinA, cosR, sinR};
        pg8::gemm_phase<EpiInProj, pg8::StaticOrder, false>(X.lds, D, S, E);
    } SEAM(2);
    if (IN(3)) { phase_attn_naive(X); __syncthreads(); phase_ret_naive(X); } SEAM(3);
    if (IN(4)) { phase_ret_fin_naive(X); } SEAM(4);
    if (IN(5)) {
        pg8::StaticOrder S; S.init(T, D, D, X.G, (int)blockIdx.x, X.ws + WS_A, X.ws + WS_WOUT);
        float* mu0 = (float*)(X.ws + WS_STAT0);
        EpiOutProj E{X.x, mu0, mu0 + T, X.ln0_g, X.ln0_b, (const float*)(X.ws + CTL_MOD), (float*)(X.ws + WS_T), (float*)(X.ws + WS_STAT1)};
        pg8::gemm_phase<EpiOutProj, pg8::StaticOrder, false>(X.lds, D, S, E);
    } SEAM(5);
    if (IN(6)) { phase_route(X); } SEAM(6);
    if (IN(7)) {
        LAS int* pre = (LAS int*)(X.lds + LDS_MISC);
        const int nmt = moe_prefix(X, pre);
        MoeOrder S{pre, 4, X.G, (int)blockIdx.x, nmt * 4, (const char*)(X.ws + WS_H2), (const char*)(X.ws + WS_W13), (size_t)1024 * D * 2, (size_t)256 * D * 2, 0, (const unsigned*)(X.ws + WS_LIST), (const unsigned*)(X.ws + CTL_CNT), true};
        EpiMoeUp E{(bf16_t*)(X.ws + WS_A)};
        pg8::gemm_phase<EpiMoeUp, MoeOrder, true>(X.lds, D, S, E);
    } SEAM(7);
    if (IN(8)) {
        LAS int* pre = (LAS int*)(X.lds + LDS_MISC);
        const int nmt = moe_prefix(X, pre);
        MoeOrder S{pre, 8, X.G, (int)blockIdx.x, nmt * 8, (const char*)(X.ws + WS_A), (const char*)(X.ws + WS_W2), (size_t)D * FF * 2, (size_t)256 * FF * 2, (size_t)256 * FF * 2, nullptr, (const unsigned*)(X.ws + CTL_CNT), false};
        EpiMoeDown E{(bf16_t*)(X.ws + WS_Y)};
        pg8::gemm_phase<EpiMoeDown, MoeOrder, false>(X.lds, FF, S, E);
    } SEAM(8);
    if (IN(9)) { phase_final(X); }
#undef IN
#undef SEAM
}

extern "C" void kernel_launch(void* const* d_in, const int* in_sizes, int n_in, void* d_out, int out_size, void* d_ws, size_t ws_size, hipStream_t stream) {
    static int grid = 0;
    if (grid == 0) {
        if (n_in != 22 || in_sizes[0] != T * D || out_size != T * D || ws_size < WS_END) { fprintf(stderr, "kernel_launch: unexpected shapes (n_in %d, in0 %d, out %d, ws %zu)\n", n_in, n_in > 0 ? in_sizes[0] : -1, out_size, ws_size); grid = -1; return; }
        int dev = 0, cus = 0, per_cu = 0;
        hipGetDevice(&dev); hipDeviceGetAttribute(&cus, hipDeviceAttributeMultiprocessorCount, dev);
        hipFuncSetAttribute((const void*)fwd_kernel, hipFuncAttributeMaxDynamicSharedMemorySize, LDS_BYTES);
        hipOccupancyMaxActiveBlocksPerMultiprocessor(&per_cu, (const void*)fwd_kernel, NTHREADS, LDS_BYTES);
        if (per_cu < 1) { fprintf(stderr, "kernel_launch: occupancy query says %d blocks per CU\n", per_cu); per_cu = 1; }
        (void)hipGetLastError();
        grid = cus;
    }
    if (grid < 0) return;
    hipMemsetAsync((char*)d_ws + WS_CTL, 0, CTL_ZERO_BYTES, stream);
    Args a{};
    for (int i = 0; i < 22; ++i) a.in[i] = d_in[i];
    a.out = (float*)d_out; a.ws = (unsigned char*)d_ws;
#if MK_PER_PHASE_LAUNCH
    for (int p = 0; p < NPHASE; ++p) {
        a.ph_lo = p; a.ph_hi = p + 1;
        hipLaunchKernelGGL(fwd_kernel, dim3(grid), dim3(NTHREADS), LDS_BYTES, stream, a);
    }
#else
    a.ph_lo = 0; a.ph_hi = NPHASE;
    void* kargs[] = {&a};
    hipError_t e = hipLaunchCooperativeKernel((const void*)fwd_kernel, dim3(grid), dim3(NTHREADS), kargs, LDS_BYTES, stream);
    if (e != hipSuccess) fprintf(stderr, "cooperative launch failed: %s (grid %d)\n", hipGetErrorString(e), grid);
#endif
}
```

```cpp
#include <hip/hip_runtime.h>
#include <hip/hip_cooperative_groups.h>
#include <cstdio>
#include <cstdint>
namespace cg = cooperative_groups;

#ifndef MK_PER_PHASE_LAUNCH
#define MK_PER_PHASE_LAUNCH 0
#endif

#define LAS __attribute__((address_space(3)))
#define GAS __attribute__((address_space(1)))
typedef unsigned short bf16_t;
typedef short bf16x8 __attribute__((ext_vector_type(8)));
typedef float f32x4 __attribute__((ext_vector_type(4)));
typedef float f32x2 __attribute__((ext_vector_type(2)));
typedef unsigned u32x4 __attribute__((ext_vector_type(4)));
typedef unsigned u32x2 __attribute__((ext_vector_type(2)));
#define DI __device__ __forceinline__

constexpr int D = 2048, BATCH = 4, SEQ = 8192, T = BATCH * SEQ;
constexpr int AW = 1024, NIN = 7168, AH = 8, RH = 4;
constexpr int NE = 32, FF = 512;
constexpr float LN_EPS = 1e-5f;
constexpr float DN_ALPHA = 1.189207115002721f;
constexpr int NWAVES = 8, NTHREADS = 512;
constexpr int NPHASE = 10;

constexpr size_t MiB = 1u << 20;
constexpr size_t WS_CTL = 0, CTL_ZERO_BYTES = 1 * MiB;
constexpr size_t CTL_BAR = 16 * 1024;
constexpr size_t CTL_MOD = 64 * 1024;
constexpr size_t CTL_CNT = 512 * 1024;
constexpr size_t CTL_WQ = 544 * 1024;
constexpr size_t WS_WIN = 2 * MiB;
constexpr size_t WS_WOUT = 30 * MiB;
constexpr size_t WS_W13 = 38 * MiB;
constexpr size_t WS_W2 = 166 * MiB;
constexpr size_t WS_TAB = 230 * MiB;
constexpr size_t WS_STAT0 = 266 * MiB;
constexpr size_t WS_STAT1 = 267 * MiB;
constexpr size_t WS_SLOT = 275 * MiB;
constexpr size_t WS_WT = WS_SLOT + 256 * 1024;
constexpr size_t WS_LIST = 276 * MiB;
constexpr size_t WS_WR = 284 * MiB;
constexpr size_t WS_A = 288 * MiB;
constexpr size_t WS_B = 416 * MiB;
constexpr size_t WS_T = WS_B, WS_H2 = WS_B + 256 * MiB;
constexpr size_t WS_Y = WS_H2;
constexpr size_t WS_YF = 864 * MiB;
constexpr size_t WS_YB = WS_W13;
constexpr size_t WS_END = 1024 * MiB;

constexpr int LDS_BYTES = 155648;
constexpr int LDS_MISC = 131072;

DI unsigned f2bf(float f) { unsigned u = __float_as_uint(f); return (u + 0x7fffu + ((u >> 16) & 1u)) >> 16; }
typedef __bf16 bf16x2_t __attribute__((ext_vector_type(2)));
DI unsigned cvtpk(float lo, float hi) { f32x2 v = {lo, hi}; bf16x2_t b = __builtin_convertvector(v, bf16x2_t); return __builtin_bit_cast(unsigned, b); }
DI unsigned pk2(float lo, float hi) { return cvtpk(lo, hi); }
DI float bf2f(unsigned h) { return __uint_as_float(h << 16); }
DI float bflo(unsigned w) { return __uint_as_float(w << 16); }
DI float bfhi(unsigned w) { return __uint_as_float(w & 0xffff0000u); }
#define dpp_f(v, ctrl) __int_as_float(__builtin_amdgcn_update_dpp(0, __float_as_int(v), (ctrl), 0xF, 0xF, true))
#define DPP_QP1 0xB1
#define DPP_QP2 0x4E
#define DPP_RHM 0x141
#define DPP_RM  0x140
DI float wave_sum(float v) {
    v += dpp_f(v, DPP_QP1); v += dpp_f(v, DPP_QP2); v += dpp_f(v, DPP_RHM); v += dpp_f(v, DPP_RM);
    const float a = __int_as_float(__builtin_amdgcn_readlane(__float_as_int(v), 0)), b = __int_as_float(__builtin_amdgcn_readlane(__float_as_int(v), 16));
    const float c = __int_as_float(__builtin_amdgcn_readlane(__float_as_int(v), 32)), d = __int_as_float(__builtin_amdgcn_readlane(__float_as_int(v), 48));
    return (a + b) + (c + d);
}
DI float wave_max(float v) {
    v = fmaxf(v, dpp_f(v, DPP_QP1)); v = fmaxf(v, dpp_f(v, DPP_QP2)); v = fmaxf(v, dpp_f(v, DPP_RHM)); v = fmaxf(v, dpp_f(v, DPP_RM));
    const float a = __int_as_float(__builtin_amdgcn_readlane(__float_as_int(v), 0)), b = __int_as_float(__builtin_amdgcn_readlane(__float_as_int(v), 16));
    const float c = __int_as_float(__builtin_amdgcn_readlane(__float_as_int(v), 32)), d = __int_as_float(__builtin_amdgcn_readlane(__float_as_int(v), 48));
    return fmaxf(fmaxf(a, b), fmaxf(c, d));
}
#define LDS_WAIT() asm volatile("s_waitcnt lgkmcnt(0)" ::: "memory")

struct Args { const void* in[22]; float* out; unsigned char* ws; int ph_lo, ph_hi; };

struct Ctx {
    LAS unsigned char* lds;
    int wave, G, vcu, gw, NGW;
    const void* const* kin;
    DI int lane_f() const { int l; asm volatile("v_mbcnt_lo_u32_b32 %0, -1, 0\n\tv_mbcnt_hi_u32_b32 %0, -1, %0" : "=v"(l)); return l; }
    DI int tid_f() const { return wave * 64 + lane_f(); }
    float* out; unsigned char* ws;
    DI const float* x() const { return (const float*)kin[0]; }
    DI const float* c() const { return (const float*)kin[1]; }
    DI const int* positions() const { return (const int*)kin[2]; }
    DI const float* ln0_g() const { return (const float*)kin[3]; }
    DI const float* ln0_b() const { return (const float*)kin[4]; }
    DI const float* w_ada() const { return (const float*)kin[5]; }
    DI const float* b_ada() const { return (const float*)kin[6]; }
    DI const float* w_in() const { return (const float*)kin[7]; }
    DI const float* w_out() const { return (const float*)kin[8]; }
    DI const float* ldf() const { return (const float*)kin[9]; }
    DI const float* ldb() const { return (const float*)kin[10]; }
    DI const float* ln1_g() const { return (const float*)kin[11]; }
    DI const float* ln1_b() const { return (const float*)kin[12]; }
    DI const float* w_group() const { return (const float*)kin[13]; }
    DI const float* b_group() const { return (const float*)kin[14]; }
    DI const float* w_sub() const { return (const float*)kin[15]; }
    DI const float* b_sub() const { return (const float*)kin[16]; }
    DI const float* w1() const { return (const float*)kin[17]; }
    DI const float* w3() const { return (const float*)kin[18]; }
    DI const float* w2() const { return (const float*)kin[19]; }
    DI const float* ln2_g() const { return (const float*)kin[20]; }
    DI const float* ln2_b() const { return (const float*)kin[21]; }
};

namespace pg8 {
constexpr int BM = 256, BK = 64, HALF = 128, HTB = HALF * BK * 2, STAGE_BYTES = 8 * HTB, NXCD = 8, WGM = 8;
__host__ __device__ __forceinline__ int lds_byte(int r, int c) { const int st = (r >> 4) * 2 + (c >> 5), rr = r & 15, cc = c & 31, ob = rr * 64 + cc * 2; return st * 1024 + (ob ^ (((ob >> 9) & 1) << 5)); }
__host__ __device__ __forceinline__ void stage_rc(int b, int& R, int& C) { const int st = b / 1024, sb = b % 1024, swz = sb ^ (((sb >> 9) & 1) << 5); R = (st >> 1) * 16 + swz / 64; C = (st & 1) * 32 + (swz % 64) / 2; }

struct Unit { const char* A; const char* B; const unsigned* rows; int nrows; int pm, pn, e; };

struct StaticOrder {
    int nM, nN, nwg, G, c; const char* A; const char* B; size_t tstepA, tstepB;
    DI void init(int M, int N, int K, int G_, int c_, const void* A_, const void* B_) { nM = M / BM; nN = N / BM; nwg = nM * nN; G = G_; c = c_; A = (const char*)A_; B = (const char*)B_; tstepA = (size_t)BM * K * 2; tstepB = (size_t)BM * K * 2; }
    DI bool next(int i, Unit& u) const {
        const long L = (long)i * G + c; if (L >= nwg) return false;
        int wgid = (int)L; { const int q = nwg / NXCD, r = nwg % NXCD, xcd = wgid % NXCD, off = wgid / NXCD; wgid = (xcd < r ? xcd * (q + 1) : r * (q + 1) + (xcd - r) * q) + off; }
        const int nig = WGM * nN, gid = wgid / nig, fm = gid * WGM, gsz = (nM - fm) < WGM ? (nM - fm) : WGM;
        u.pm = fm + ((wgid % nig) % gsz); u.pn = (wgid % nig) / gsz; u.e = 0; u.rows = nullptr; u.nrows = 0;
        u.A = A + (size_t)u.pm * tstepA; u.B = B + (size_t)u.pn * tstepB; return true;
    }
};

DI unsigned cvt_pk_bf16(float lo, float hi) { unsigned r; asm volatile("v_cvt_pk_bf16_f32 %0, %1, %2" : "=v"(r) : "v"(lo), "v"(hi)); return r; }

__host__ __device__ __forceinline__ int perm32(int rho) { const int n = rho >> 4, i = rho & 15; return 8 * (i >> 2) + 4 * n + (i & 3); }
template <class Epi, class Sched, bool GATHER, bool PERM = false>
DI void gemm_phase(LAS unsigned char* lds, const int K, const Sched& S, const Epi& E, const int wid) {
    int lane; asm volatile("v_mbcnt_lo_u32_b32 %0, -1, 0\n\tv_mbcnt_hi_u32_b32 %0, -1, %0" : "=v"(lane));
    const int tid = wid * 64 + lane, wr = wid >> 2, wc = wid & 3, fr = lane & 15, fq = lane >> 4;
    const int nt = K / BK;
    int Rr[2], Cc[2];
    unsigned voffB[2], voffN[2], vA0[2], vA1[2], nA0[2], nA1[2];
#pragma unroll
    for (int i = 0; i < 2; ++i) { stage_rc(tid * 16 + i * 8192, Rr[i], Cc[i]); voffN[i] = (unsigned)(Rr[i] * K + Cc[i]) * 2u; const int Rb = PERM ? ((Rr[i] & ~31) + perm32(Rr[i] & 31)) : Rr[i]; voffB[i] = (unsigned)(Rb * K + Cc[i]) * 2u; }
    const size_t kstep = (size_t)(BK * 2);
    const size_t hstep = (size_t)HALF * K * 2;
    const unsigned ldsw = (unsigned)wid * 1024u;
    const int aoff = lds_byte(wr * 64 + fr, fq * 8), boff = lds_byte(wc * 32 + fr, fq * 8);
#define PG8_SA(b, h) (((b) * 2 + (h)) * HTB)
#define PG8_SB(b, h) ((4 + (b) * 2 + (h)) * HTB)
#define PG8_STAGE(bufoff, gbase, voff) do { _Pragma("unroll") for (int _i = 0; _i < 2; ++_i) \
        __builtin_amdgcn_global_load_lds((const unsigned*)((const char*)(gbase) + (voff)[_i]), (LAS unsigned*)(lds + (bufoff) + ldsw + _i * 8192), 16, 0, 0); } while (0)
#define PG8_LDA(dst, b, h) do { _Pragma("unroll") for (int m = 0; m < 4; ++m) _Pragma("unroll") for (int k = 0; k < 2; ++k) dst[m][k] = *(const LAS bf16x8*)(lds + PG8_SA(b, h) + aoff + m * 2048 + k * 1024); } while (0)
#define PG8_LDB(dst, b, h) do { _Pragma("unroll") for (int n = 0; n < 2; ++n) _Pragma("unroll") for (int k = 0; k < 2; ++k) dst[n][k] = *(const LAS bf16x8*)(lds + PG8_SB(b, h) + boff + n * 2048 + k * 1024); } while (0)
#define PG8_MMA(ai, bj, At, Bt) do { __builtin_amdgcn_s_setprio(1); _Pragma("unroll") for (int m = 0; m < 4; ++m) _Pragma("unroll") for (int n = 0; n < 2; ++n) _Pragma("unroll") for (int k = 0; k < 2; ++k) \
        acc[ai][bj][m][n] = __builtin_amdgcn_mfma_f32_16x16x32_bf16(Bt[n][k], At[m][k], acc[ai][bj][m][n], 0, 0, 0); __builtin_amdgcn_s_setprio(0); } while (0)
#define PG8_STAGE_A(bufoff, gbase, half_, vo0, vo1) do { if constexpr (GATHER) { if ((half_) == 0) PG8_STAGE(bufoff, gbase, vo0); else PG8_STAGE(bufoff, gbase, vo1); } else { PG8_STAGE(bufoff, (gbase) + ((half_) ? hstep : 0), voffN); } } while (0)
#define PG8_WAIT_V(n) asm volatile("s_waitcnt vmcnt(" #n ")" ::: "memory")
#define PG8_WAIT_L(n) asm volatile("s_waitcnt lgkmcnt(" #n ")" ::: "memory")
#define PG8_BAR __builtin_amdgcn_s_barrier()
#define PG8_SCHED __builtin_amdgcn_sched_barrier(0)
#define PG8_AOFFS(u, o0, o1) do { _Pragma("unroll") for (int _i = 0; _i < 2; ++_i) { \
        if constexpr (GATHER) { const int r0 = Rr[_i], r1 = Rr[_i] + HALF; \
            const unsigned t0 = r0 < (u).nrows ? (u).rows[r0] : 0u, t1 = r1 < (u).nrows ? (u).rows[r1] : 0u; \
            o0[_i] = (t0 * (unsigned)K + (unsigned)Cc[_i]) * 2u; o1[_i] = (t1 * (unsigned)K + (unsigned)Cc[_i]) * 2u; } \
        else { o0[_i] = voffN[_i]; o1[_i] = voffN[_i] + (unsigned)hstep; } } } while (0)
    Unit cur, nxt; int ui = 0;
    if (!S.next(0, cur)) return;
    f32x4 acc[2][2][4][2];
#pragma unroll
    for (int a = 0; a < 2; ++a)
#pragma unroll
        for (int b = 0; b < 2; ++b)
#pragma unroll
            for (int m = 0; m < 4; ++m)
#pragma unroll
                for (int n = 0; n < 2; ++n) acc[a][b][m][n] = (f32x4){0.f, 0.f, 0.f, 0.f};
    bf16x8 At[4][2], B0[2][2], B1[2][2];
    const char* cA = cur.A; const char* cB = cur.B;
    if constexpr (GATHER) { PG8_AOFFS(cur, vA0, vA1); }
    PG8_STAGE(PG8_SB(0, 0), cB, voffB); PG8_STAGE(PG8_SB(0, 1), cB + hstep, voffB); PG8_STAGE_A(PG8_SA(0, 0), cA, 0, vA0, vA1); PG8_STAGE_A(PG8_SA(0, 1), cA, 1, vA0, vA1);
    if (wr == 1) PG8_BAR;
    PG8_WAIT_V(2); PG8_BAR;
    PG8_STAGE(PG8_SB(1, 0), cB + kstep, voffB); PG8_STAGE_A(PG8_SA(1, 0), cA + kstep, 0, vA0, vA1); PG8_STAGE(PG8_SB(1, 1), cB + hstep + kstep, voffB);
    PG8_WAIT_V(6); PG8_BAR;
    for (;;) {
        const bool has_next = S.next(ui + 1, nxt);
        const char* nA = has_next ? nxt.A : cA; const char* nB = has_next ? nxt.B : cB;
        if constexpr (GATHER) { if (has_next) { PG8_AOFFS(nxt, nA0, nA1); } else {
#pragma unroll
            for (int i = 0; i < 2; ++i) { nA0[i] = vA0[i]; nA1[i] = vA1[i]; } } }
        for (int t = 0; t < nt; t += 2) {
            const bool last = (t == nt - 2);
            const char* a1 = cA + (size_t)(t + 1) * kstep;
            const char* a2 = last ? nA : cA + (size_t)(t + 2) * kstep; const char* b2 = last ? nB : cB + (size_t)(t + 2) * kstep;
            const char* a3 = a2 + kstep; const char* b3 = b2 + kstep;
            unsigned u0[2], u1[2];
            if constexpr (GATHER) {
#pragma unroll
            for (int i = 0; i < 2; ++i) { u0[i] = last ? nA0[i] : vA0[i]; u1[i] = last ? nA1[i] : vA1[i]; } }
            PG8_LDB(B0, 0, 0); PG8_LDB(B1, 0, 1); PG8_SCHED; PG8_LDA(At, 0, 0); PG8_STAGE_A(PG8_SA(1, 1), a1, 1, vA0, vA1);
            PG8_WAIT_V(8); PG8_WAIT_L(0); PG8_BAR; PG8_MMA(0, 0, At, B0); PG8_MMA(0, 1, At, B1); PG8_BAR; PG8_SCHED;
            PG8_LDA(At, 0, 1); PG8_STAGE(PG8_SB(0, 0), b2, voffB); PG8_STAGE(PG8_SB(0, 1), b2 + hstep, voffB); PG8_STAGE_A(PG8_SA(0, 0), a2, 0, u0, u1);
            PG8_WAIT_V(8); PG8_WAIT_L(0); PG8_BAR; PG8_MMA(1, 0, At, B0); PG8_MMA(1, 1, At, B1); PG8_BAR; PG8_SCHED;
            PG8_LDB(B0, 1, 0); PG8_LDB(B1, 1, 1); PG8_SCHED; PG8_LDA(At, 1, 0); PG8_STAGE_A(PG8_SA(0, 1), a2, 1, u0, u1);
            PG8_WAIT_V(8); PG8_WAIT_L(0); PG8_BAR; PG8_MMA(0, 0, At, B0); PG8_MMA(0, 1, At, B1); PG8_BAR; PG8_SCHED;
            PG8_LDA(At, 1, 1); PG8_STAGE(PG8_SB(1, 0), b3, voffB); PG8_STAGE(PG8_SB(1, 1), b3 + hstep, voffB); PG8_STAGE_A(PG8_SA(1, 0), a3, 0, u0, u1);
            PG8_WAIT_V(8); PG8_WAIT_L(0); PG8_BAR; PG8_MMA(1, 0, At, B0); PG8_MMA(1, 1, At, B1); PG8_BAR; PG8_SCHED;
        }
        if (wr == 0) PG8_BAR;
        E(acc, cur, wr, wc, fr, fq, lds, lane);
        if (!has_next) break;
#pragma unroll
        for (int a = 0; a < 2; ++a)
#pragma unroll
            for (int b = 0; b < 2; ++b)
#pragma unroll
                for (int m = 0; m < 4; ++m)
#pragma unroll
                    for (int n = 0; n < 2; ++n) acc[a][b][m][n] = (f32x4){0.f, 0.f, 0.f, 0.f};
        cur = nxt; cA = nA; cB = nB; ++ui;
        if constexpr (GATHER) {
#pragma unroll
        for (int i = 0; i < 2; ++i) { vA0[i] = nA0[i]; vA1[i] = nA1[i]; } }
        if (wr == 1) PG8_BAR;
    }
    PG8_WAIT_V(0);
    PG8_BAR;
#undef PG8_SA
#undef PG8_SB
#undef PG8_STAGE
#undef PG8_STAGE_A
#undef PG8_LDA
#undef PG8_LDB
#undef PG8_MMA
#undef PG8_WAIT_V
#undef PG8_WAIT_L
#undef PG8_BAR
#undef PG8_SCHED
#undef PG8_AOFFS
}
}

constexpr int EPI_STG = 3 * 16384;
constexpr int EPI_STG2 = 131072 + 1024;
#define EPI_BAR() do { asm volatile("s_waitcnt lgkmcnt(0)" ::: "memory"); __builtin_amdgcn_s_barrier(); asm volatile("" ::: "memory"); } while (0)
DI void stg_rows_out(LAS unsigned char* R, unsigned char* grow0, size_t row_bytes, int wc, int lane) {
#pragma unroll
    for (int i = 0; i < 2; ++i) { const int row = 4 * wc + 2 * i + (lane >> 5), ch = lane & 31;
        const u32x4 v = *(const LAS u32x4*)(R + row * 512 + ((ch ^ (row & 7)) << 4));
        __builtin_nontemporal_store(v, (u32x4*)(grow0 + (size_t)row * row_bytes + ch * 16)); }
}
DI float h2f_lo(unsigned w) { return (float)__builtin_bit_cast(_Float16, (unsigned short)(w & 0xffffu)); }
DI float h2f_hi(unsigned w) { return (float)__builtin_bit_cast(_Float16, (unsigned short)(w >> 16)); }
DI unsigned pack_h2(float lo, float hi) { return (unsigned)__builtin_bit_cast(unsigned short, (_Float16)lo) | ((unsigned)__builtin_bit_cast(unsigned short, (_Float16)hi) << 16); }
struct EpiInProj {
    bf16_t* z; const unsigned* tabA; const unsigned* tabR; int dbg;
    DI void operator()(f32x4 (&acc)[2][2][4][2], const pg8::Unit& u, int wr, int wc, int fr, int fq, LAS unsigned char* lds, int lane) const {
        if (dbg == 2) {
#pragma unroll
            for (int a = 0; a < 2; ++a)
#pragma unroll
                for (int b = 0; b < 2; ++b)
#pragma unroll
                    for (int m = 0; m < 4; ++m)
#pragma unroll
                        for (int n = 0; n < 2; ++n) asm volatile("" :: "v"(acc[a][b][m][n]));
            return; }
        const int seg = (u.pn >> 2), colt = (u.pn & 3) * 256;
        bf16_t* zs = z + (size_t)seg * T * 1024;
        const float scale = (seg == 0) ? 0.08838834764831845f : (seg == 4 ? 0.0625f : 1.0f);
        const int row0 = u.pm * 256 + wr * 64 + fr;
        bf16_t* zp = zs + (size_t)row0 * 1024 + colt + wc * 32 + fq * 4;
        LAS unsigned char* R = lds + EPI_STG + wr * 8192;
#define EIP_STORE(ai_, m_, v00, v01, v10, v11) do { unsigned imo = (((ai_) * 4 + (m_)) & 1) ? (unsigned)(EPI_STG2 - EPI_STG) : 0u; asm volatile("" : "+s"(imo));     \
            LAS unsigned char* Rg = R + imo; \
            { const f32x4 o = (v00) * scale; u32x2 w; w.x = pk2(o[0], o[1]); w.y = pk2(o[2], o[3]); *(LAS u32x2*)(Rg + fr * 512 + (((wc * 4 + (fq >> 1)) ^ (fr & 7)) << 4) + (fq & 1) * 8) = w; } \
            { const f32x4 o = (v01) * scale; u32x2 w; w.x = pk2(o[0], o[1]); w.y = pk2(o[2], o[3]); *(LAS u32x2*)(Rg + fr * 512 + (((wc * 4 + 2 + (fq >> 1)) ^ (fr & 7)) << 4) + (fq & 1) * 8) = w; } \
            { const f32x4 o = (v10) * scale; u32x2 w; w.x = pk2(o[0], o[1]); w.y = pk2(o[2], o[3]); *(LAS u32x2*)(Rg + fr * 512 + (((16 + wc * 4 + (fq >> 1)) ^ (fr & 7)) << 4) + (fq & 1) * 8) = w; } \
            { const f32x4 o = (v11) * scale; u32x2 w; w.x = pk2(o[0], o[1]); w.y = pk2(o[2], o[3]); *(LAS u32x2*)(Rg + fr * 512 + (((16 + wc * 4 + 2 + (fq >> 1)) ^ (fr & 7)) << 4) + (fq & 1) * 8) = w; } \
            EPI_BAR(); \
            stg_rows_out(Rg, (unsigned char*)(zs + (size_t)(u.pm * 256 + wr * 64 + (ai_) * 128 + (m_) * 16) * 1024 + colt), 2048, wc, lane); } while (0)
        if (seg == 3 || seg == 4) {
            const unsigned* tp = tabR + (size_t)row0 * 128 + wc * 32 + fq * 4;
            u32x4 tv[2][2];
            tv[0][0] = *(const u32x4*)(tp); tv[0][1] = *(const u32x4*)(tp + 16);
#pragma unroll
            for (int g = 0; g < 8; ++g) { const int ai = g >> 2, m = g & 3;
                if (g < 7) { const unsigned* tn = tp + (size_t)(((g + 1) >> 2) * 128 + ((g + 1) & 3) * 16) * 128; tv[(g + 1) & 1][0] = *(const u32x4*)(tn); tv[(g + 1) & 1][1] = *(const u32x4*)(tn + 16); }
                f32x4 r0[2], r1[2];
#pragma unroll
                for (int n = 0; n < 2; ++n) { const u32x4 tw = tv[g & 1][n];
                    const f32x4 cs = {h2f_lo(tw.x), h2f_lo(tw.y), h2f_lo(tw.z), h2f_lo(tw.w)}, sn = {h2f_hi(tw.x), h2f_hi(tw.y), h2f_hi(tw.z), h2f_hi(tw.w)};
                    const f32x4 x1 = acc[ai][0][m][n], x2 = acc[ai][1][m][n]; r0[n] = x1 * cs - x2 * sn; r1[n] = x2 * cs + x1 * sn; }
                if (dbg != 3) EIP_STORE(ai, m, r0[0], r0[1], r1[0], r1[1]);
            }
        } else if (seg <= 1 && wc == 0) {
            const unsigned* tp = tabA + (size_t)row0 * 16 + fq * 4;
            u32x4 tv[8];
#pragma unroll
            for (int g = 0; g < 8; ++g) tv[g] = *(const u32x4*)(tp + (size_t)((g >> 2) * 128 + (g & 3) * 16) * 16);
#pragma unroll
            for (int g = 0; g < 8; ++g) { const int ai = g >> 2, m = g & 3; const u32x4 tw = tv[g];
                const f32x4 cs = {h2f_lo(tw.x), h2f_lo(tw.y), h2f_lo(tw.z), h2f_lo(tw.w)}, sn = {h2f_hi(tw.x), h2f_hi(tw.y), h2f_hi(tw.z), h2f_hi(tw.w)};
                const f32x4 a1 = acc[ai][0][m][0], a2 = acc[ai][0][m][1], b1 = acc[ai][1][m][0], b2 = acc[ai][1][m][1];
                if (dbg != 3) EIP_STORE(ai, m, a1 * cs - a2 * sn, a2 * cs + a1 * sn, b1 * cs - b2 * sn, b2 * cs + b1 * sn);
            }
        } else {
#pragma unroll
            for (int g = 0; g < 8; ++g) { const int ai = g >> 2, m = g & 3;
                if (dbg != 3) EIP_STORE(ai, m, acc[ai][0][m][0], acc[ai][0][m][1], acc[ai][1][m][0], acc[ai][1][m][1]); }
        }
#undef EIP_STORE
        EPI_BAR();
    }
};

struct EpiOutProj {
    const float* x; const float* mu0; const float* rstd0; const float* g0; const float* b0; const float* mod; float* t; float* part;
    DI void operator()(f32x4 (&acc)[2][2][4][2], const pg8::Unit& u, int wr, int wc, int fr, int fq, LAS unsigned char* lds, int lane) const {
        const int col0 = u.pn * 256 + wc * 32 + fq * 8;
        const int b = (u.pm * 256) / SEQ;
        const float* g1 = mod + (size_t)b * 6 * D + 2 * D;
        const int row0 = u.pm * 256 + wr * 64 + fr;
        f32x4 pa[2][2];
#pragma unroll
        for (int bj = 0; bj < 2; ++bj)
#pragma unroll
            for (int n = 0; n < 2; ++n) { const int c = col0 + bj * 128 + n * 4;
                pa[bj][n] = DN_ALPHA * *(const f32x4*)(g0 + c); const f32x4 pb = DN_ALPHA * *(const f32x4*)(b0 + c); const f32x4 pc = 1.0f + *(const f32x4*)(g1 + c);
#pragma unroll
                for (int ai = 0; ai < 2; ++ai)
#pragma unroll
                    for (int m = 0; m < 4; ++m) acc[ai][bj][m][n] = acc[ai][bj][m][n] * pc + pb; }
        f32x4 xv[3][2]; float mu[2], rs[2], ss = 0.f, qq = 0.f;
#define EOP_LD(k_) do { const int gn = (k_) >> 1, bn = (k_) & 1; const int rn = row0 + (gn >> 2) * 128 + (gn & 3) * 16; const float* xp = (const float*)((const char*)x + (unsigned)(rn * D + col0 + bn * 128) * 4u); \
            if (bn == 0) { mu[gn & 1] = mu0[rn]; rs[gn & 1] = rstd0[rn]; } \
            xv[(k_) % 3][0] = *(const f32x4*)(xp); xv[(k_) % 3][1] = *(const f32x4*)(xp + 4); } while (0)
        EOP_LD(0); EOP_LD(1);
#pragma unroll
        for (int k = 0; k < 16; ++k) { const int g = k >> 1, bj = k & 1, ai = g >> 2, m = g & 3; const int row = row0 + ai * 128 + m * 16;
            if (k < 14) EOP_LD(k + 2);
            bf16_t* tp = (bf16_t*)((char*)t + (unsigned)(row * D + col0 + bj * 128) * 2u);
            u32x4 w;
#pragma unroll
            for (int n = 0; n < 2; ++n) {
                const f32x4 o = (xv[k % 3][n] - mu[g & 1]) * rs[g & 1] * pa[bj][n] + acc[ai][bj][m][n];
                if (n == 0) { w.x = pk2(o[0], o[1]); w.y = pk2(o[2], o[3]); } else { w.z = pk2(o[0], o[1]); w.w = pk2(o[2], o[3]); }
                ss += (o[0] + o[1]) + (o[2] + o[3]); qq += (o[0] * o[0] + o[1] * o[1]) + (o[2] * o[2] + o[3] * o[3]); }
            __builtin_nontemporal_store(w, (u32x4*)tp);
            if (bj == 1) {
                ss += __shfl_xor(ss, 16); ss += __shfl_xor(ss, 32); qq += __shfl_xor(qq, 16); qq += __shfl_xor(qq, 32);
                if (fq == 0) *(f32x2*)((char*)part + (unsigned)(row * 32 + u.pn * 4 + wc) * 8u) = (f32x2){ss, qq};
                ss = 0.f; qq = 0.f; }
        }
#undef EOP_LD
    }
};

struct EpiMoeUp {
    bf16_t* act;
    DI void operator()(f32x4 (&acc)[2][2][4][2], const pg8::Unit& u, int wr, int wc, int fr, int fq, LAS unsigned char* lds, int lane) const {
#pragma unroll
        for (int ai = 0; ai < 2; ++ai)
#pragma unroll
            for (int mh = 0; mh < 2; ++mh) {
                LAS unsigned char* R = lds + (mh ? EPI_STG2 : EPI_STG) + wr * 8192;
#pragma unroll
                for (int mm = 0; mm < 2; ++mm) { const int m = 2 * mh + mm, r = mm * 16 + fr;
                    f32x4 o[2];
#pragma unroll
                    for (int n = 0; n < 2; ++n) { const f32x4 g = acc[ai][0][m][n], up = acc[ai][1][m][n];
#pragma unroll
                        for (int j = 0; j < 4; ++j) o[n][j] = g[j] / (1.0f + __expf(-g[j])) * up[j]; }
                    u32x4 w; w.x = pk2(o[0][0], o[0][1]); w.y = pk2(o[0][2], o[0][3]); w.z = pk2(o[1][0], o[1][1]); w.w = pk2(o[1][2], o[1][3]);
                    *(LAS u32x4*)(R + r * 256 + (((wc * 4 + fq) ^ (r & 15)) << 4)) = w; }
                EPI_BAR();
#pragma unroll
                for (int i = 0; i < 2; ++i) { const int r = 8 * wc + 4 * i + (lane >> 4), ch = lane & 15;
                    const u32x4 v = *(const LAS u32x4*)(R + r * 256 + ((ch ^ (r & 15)) << 4));
                    const int grow = u.pm * 256 + wr * 64 + ai * 128 + mh * 32 + r;
                    __builtin_nontemporal_store(v, (u32x4*)(act + (size_t)grow * FF + u.pn * 128 + ch * 8)); }
            }
        EPI_BAR();
    }
};
struct EpiMoeDown {
    bf16_t* Y;
    DI void operator()(f32x4 (&acc)[2][2][4][2], const pg8::Unit& u, int wr, int wc, int fr, int fq, LAS unsigned char* lds, int lane) const {
#pragma unroll
        for (int ai = 0; ai < 2; ++ai)
#pragma unroll
            for (int m = 0; m < 4; ++m) {
                LAS unsigned char* R = lds + ((m & 1) ? EPI_STG2 : EPI_STG) + wr * 8192;
#pragma unroll
                for (int bj = 0; bj < 2; ++bj) { const f32x4 a = acc[ai][bj][m][0], b = acc[ai][bj][m][1];
                    u32x4 w; w.x = pk2(a[0], a[1]); w.y = pk2(a[2], a[3]); w.z = pk2(b[0], b[1]); w.w = pk2(b[2], b[3]);
                    *(LAS u32x4*)(R + fr * 512 + (((bj * 16 + wc * 4 + fq) ^ (fr & 7)) << 4)) = w; }
                EPI_BAR();
                stg_rows_out(R, (unsigned char*)(Y + (size_t)(u.pm * 256 + wr * 64 + ai * 128 + m * 16) * D + u.pn * 256), (size_t)D * 2, wc, lane);
            }
        EPI_BAR();
    }
};

struct MoeOrder {
    const LAS int* pre; int NT, G, c, total; const char* A; const char* Bw; size_t bstride_e, tstepB, tstepA; const unsigned* lists; const unsigned* cnt; bool gather;
    DI bool next(int i, pg8::Unit& u) const {
        const long L = (long)i * G + c; if (L >= total) return false;
        const int mt = (int)(L / NT), nt = (int)(L % NT);
        int e = 0;
#pragma unroll 1
        for (int k = 1; k < NE; ++k) e += (pre[k] <= mt) ? 1 : 0;
        const int lm = mt - pre[e];
        u.pm = mt; u.pn = nt; u.e = e;
        u.B = Bw + (size_t)e * bstride_e + (size_t)nt * tstepB;
        if (gather) { u.A = A; u.rows = lists + (size_t)e * 65536 + lm * 256; const int cn = (int)cnt[e * 64] - lm * 256; u.nrows = cn < 256 ? cn : 256; }
        else { u.A = A + (size_t)mt * tstepA; u.rows = nullptr; u.nrows = 0; }
        return true;
    }
};

DI void phase_mod(const Ctx& X) {
    float* mod = (float*)(X.ws + CTL_MOD);
    LAS float* ps = (LAS float*)X.lds;
    LAS float* cs = (LAS float*)(X.lds + 16384);
    const int lane = X.lane_f();
    for (int i = X.tid_f(); i < 4 * D; i += NTHREADS) { const float cv = X.c()[i]; cs[i] = cv / (1.0f + expf(-cv)); }
    __syncthreads();
    for (int cgp = X.vcu; cgp < 96; cgp += X.G) {
        const float* W = X.w_ada() + (size_t)(X.wave * 256) * (6 * D) + cgp * 128 + lane * 2;
        f32x2 acc[4];
#pragma unroll
        for (int b = 0; b < 4; ++b) acc[b] = (f32x2){0.f, 0.f};
#pragma unroll 1
        for (int k0 = 0; k0 < 256; k0 += 16) {
            f32x2 wv[16];
#pragma unroll
            for (int kk = 0; kk < 16; ++kk) wv[kk] = *(const f32x2*)(W + (size_t)(k0 + kk) * (6 * D));
#pragma unroll
            for (int kk = 0; kk < 16; ++kk)
#pragma unroll
                for (int b = 0; b < 4; ++b) acc[b] += cs[b * D + X.wave * 256 + k0 + kk] * wv[kk];
        }
#pragma unroll
        for (int b = 0; b < 4; ++b) *(LAS f32x2*)(ps + (X.wave * 4 + b) * 128 + lane * 2) = acc[b];
        __syncthreads();
        { const int o = X.tid_f();
          float sum = X.b_ada()[cgp * 128 + (o & 127)];
#pragma unroll
          for (int w8 = 0; w8 < 8; ++w8) sum += ps[(w8 * 4 + (o >> 7)) * 128 + (o & 127)];
          mod[(size_t)(o >> 7) * 6 * D + cgp * 128 + (o & 127)] = sum; }
        __syncthreads();
    }
}

constexpr int TR_SCR = 16896;
template <class RowMap>
DI void transpose_item(const float* W, int K, int N, bf16_t* WT, const RowMap& rm, LAS float* scr, int item, int lane) {
    const int nblk = N / 64, kb = item / nblk, nb = item % nblk, k0 = 64 * kb, n0 = 64 * nb;
    f32x4 v[16];
#pragma unroll
    for (int r = 0; r < 16; ++r) v[r] = *(const f32x4*)(W + (size_t)(k0 + 4 * r + (lane >> 4)) * N + n0 + 4 * (lane & 15));
#pragma unroll
    for (int r = 0; r < 16; ++r) { LAS float* d = scr + (4 * r + (lane >> 4)) * 65 + 4 * (lane & 15); d[0] = v[r][0]; d[1] = v[r][1]; d[2] = v[r][2]; d[3] = v[r][3]; }
    LDS_WAIT();
    const int c = lane & 7;
#pragma unroll
    for (int j = 0; j < 8; ++j) { const int n = (lane >> 3) + 8 * j; const LAS float* sp = scr + (8 * c) * 65 + n;
        u32x4 o; o.x = pk2(sp[0 * 65], sp[1 * 65]); o.y = pk2(sp[2 * 65], sp[3 * 65]); o.z = pk2(sp[4 * 65], sp[5 * 65]); o.w = pk2(sp[6 * 65], sp[7 * 65]);
        *(u32x4*)(WT + (size_t)rm(n0 + n) * K + k0 + 8 * c) = o; }
    LDS_WAIT();
}
struct RowId { DI int operator()(int n) const { return n; } };
struct RowPerm32 { DI int operator()(int n) const { return (n & ~31) + 16 * ((n >> 2) & 1) + 4 * ((n >> 3) & 3) + (n & 3); } };
struct RowGate { int up; DI int operator()(int n) const { return (n >> 7) * 256 + up * 128 + (n & 127); } };

DI void sincos_f(float a, float& c, float& s) {
    const float k = rintf(a * 0.636619772f);
    float r = fmaf(-k, 1.5707855225e+00f, a); r = fmaf(-k, 1.0804334124e-05f, r);
    const float r2 = r * r;
    const float sn = fmaf(r * r2, fmaf(r2, fmaf(r2, fmaf(r2, 2.7557319e-6f, -1.9841270e-4f), 8.3333333e-3f), -1.6666667e-1f), r);
    const float cn = fmaf(r2 * r2, fmaf(r2, fmaf(r2, 2.4801587e-5f, -1.3888889e-3f), 4.1666667e-2f), fmaf(r2, -0.5f, 1.0f));
    const int qq = ((int)k) & 3;
    float so, co;
    if (qq == 0) { so = sn; co = cn; } else if (qq == 1) { so = cn; co = -sn; } else if (qq == 2) { so = -sn; co = -cn; } else { so = -cn; co = sn; }
    c = co; s = so;
}
DI void sincos_d(float angf, float& c, float& s) {
    const double a = (double)angf;
    const double k = rint(a * 0.63661977236758134308);
    double r = a - k * 1.57079632673412561417e+00; r -= k * 6.07710050650619224932e-11;
    const double r2 = r * r;
    double sp = -1.0 / 6227020800.0; sp = sp * r2 + 1.0 / 39916800.0; sp = sp * r2 - 1.0 / 362880.0; sp = sp * r2 + 1.0 / 5040.0; sp = sp * r2 - 1.0 / 120.0; sp = sp * r2 + 1.0 / 6.0;
    const double sn = r - r * r2 * sp;
    double cp = -1.0 / 87178291200.0; cp = cp * r2 + 1.0 / 479001600.0; cp = cp * r2 - 1.0 / 3628800.0; cp = cp * r2 + 1.0 / 40320.0; cp = cp * r2 - 1.0 / 720.0; cp = cp * r2 + 1.0 / 24.0;
    const double cn = 1.0 - 0.5 * r2 + r2 * r2 * cp;
    const long long q = (long long)k; const int qq = (int)(q & 3);
    double so, co;
    if (qq == 0) { so = sn; co = cn; } else if (qq == 1) { so = cn; co = -sn; } else if (qq == 2) { so = -sn; co = -cn; } else { so = -cn; co = sn; }
    c = (float)co; s = (float)so;
}

DI void phase_pre(const Ctx& X, const int parts = 7) {
    LAS float* scr = (LAS float*)(X.lds + X.wave * TR_SCR);
    bf16_t* WinT = (bf16_t*)(X.ws + WS_WIN); bf16_t* WoutT = (bf16_t*)(X.ws + WS_WOUT);
    constexpr int I_IN = (D / 64) * (NIN / 64), I_OUT = (D / 64) * (D / 64);
    if (parts & 1) for (int it = X.gw; it < I_IN + I_OUT; it += X.NGW) {
        if (it < I_IN) transpose_item(X.w_in(), D, NIN, WinT, RowId{}, scr, it, X.lane_f());
        else transpose_item(X.w_out(), D, D, WoutT, RowPerm32{}, scr, it - I_IN, X.lane_f());
    }
    unsigned* tabA = (unsigned*)(X.ws + WS_TAB); unsigned* tabR = tabA + (size_t)T * 16;
    {
        const long gt = (long)X.gw * 64 + X.lane_f(), NGT = (long)X.NGW * 64;
        LAS float* invs = (LAS float*)(X.lds + 8 * TR_SCR);
        __syncthreads();
        if (X.tid_f() < 144) { const int f = X.tid_f(); float inv;
            if (f < 16) inv = (float)exp(-((double)(2 * f) / 32.0) * 13.122363377404328);
            else { const float tt = (float)(f - 16) / 127.0f; inv = (float)exp(-(double)tt * 9.210340371976184); }
            invs[f] = inv; }
        __syncthreads();
        if (parts & 2) for (int i = (int)gt; i < T * 144; i += (int)NGT) {
            const int tok = i / 144, f = i - tok * 144;
            const float pos = (float)X.positions()[tok];
            const float inv = invs[f];
            const float ang = pos * inv; float c, s; sincos_f(ang, c, s);
            if (f < 16) tabA[(size_t)tok * 16 + f] = pack_h2(c, s); else tabR[(size_t)tok * 128 + f - 16] = pack_h2(c, s);
        }
        bf16_t* WRh = (bf16_t*)(X.ws + WS_WR + 512 * 1024); bf16_t* WRl = (bf16_t*)(X.ws + WS_WR + 768 * 1024);
        for (long i = gt; i < 48L * D; i += NGT) {
            const int col = (int)(i / D), k = (int)(i % D);
            const float wv = col < 32 ? X.w_sub()[((size_t)(col >> 3) * D + k) * 8 + (col & 7)] : (col < 36 ? X.w_group()[(size_t)k * 4 + (col - 32)] : 0.f);
            const unsigned hi = f2bf(wv); WRh[i] = (bf16_t)hi; WRl[i] = (bf16_t)f2bf(wv - bf2f(hi));
        }
        float* PP = (float*)(X.ws + WS_WR + 1024 * 1024); const float* modp = (const float*)(X.ws + CTL_MOD);
        for (long i = gt; i < 4L * D; i += NGT) {
            const int bb_ = (int)(i / D), k = (int)(i % D);
            const float sc = modp[(size_t)bb_ * 6 * D + 4 * D + k], sh = modp[(size_t)bb_ * 6 * D + 3 * D + k];
            PP[((size_t)bb_ * 2) * D + k] = X.ln1_g()[k] * (1.0f + sc); PP[((size_t)bb_ * 2 + 1) * D + k] = X.ln1_b()[k] * (1.0f + sc) + sh;
        }
    }
    const float* mod = (const float*)(X.ws + CTL_MOD);
    float* mu0 = (float*)(X.ws + WS_STAT0); float* rstd0 = mu0 + T;
    bf16_t* h = (bf16_t*)(X.ws + WS_A);
    if (parts & 4) {
        const int lane = X.lane_f();
        const int rowb = X.gw * 16; const int b = rowb / SEQ;
        LAS float* prm = (LAS float*)X.lds;
        { const float* sh1p = mod + (size_t)b * 6 * D; const float* sc1p = sh1p + D;
          __syncthreads();
          for (int i = X.tid_f(); i < D; i += NTHREADS) { prm[i] = X.ln0_g()[i]; prm[D + i] = X.ln0_b()[i]; prm[2 * D + i] = 1.0f + sc1p[i]; prm[3 * D + i] = sh1p[i]; }
          __syncthreads(); }
        f32x4 v[2][8], vn[2][8];
#pragma unroll
        for (int rr = 0; rr < 2; ++rr) { const f32x4* xr = (const f32x4*)(X.x() + (size_t)(rowb + rr) * D) + lane;
#pragma unroll
            for (int j = 0; j < 8; ++j) vn[rr][j] = xr[64 * j]; }
#pragma unroll 1
        for (int k8 = 0; k8 < 8; ++k8) {
            const int rowa = rowb + 2 * k8;
#pragma unroll
            for (int rr = 0; rr < 2; ++rr)
#pragma unroll
                for (int j = 0; j < 8; ++j) v[rr][j] = vn[rr][j];
            float mean[2], rstd[2];
#pragma unroll
            for (int rr = 0; rr < 2; ++rr) { float s_ = 0.f;
#pragma unroll
                for (int j = 0; j < 8; ++j) s_ += (v[rr][j][0] + v[rr][j][1]) + (v[rr][j][2] + v[rr][j][3]);
                mean[rr] = wave_sum(s_) * (1.0f / D); float s2 = 0.f;
#pragma unroll
                for (int j = 0; j < 8; ++j) { v[rr][j] = v[rr][j] - mean[rr]; s2 += (v[rr][j][0] * v[rr][j][0] + v[rr][j][1] * v[rr][j][1]) + (v[rr][j][2] * v[rr][j][2] + v[rr][j][3] * v[rr][j][3]); }
                rstd[rr] = 1.0f / sqrtf(wave_sum(s2) * (1.0f / D) + LN_EPS); }
            if (k8 < 7) {
#pragma unroll
                for (int rr = 0; rr < 2; ++rr) { const f32x4* xr = (const f32x4*)(X.x() + (size_t)(rowa + 2 + rr) * D) + lane;
#pragma unroll
                    for (int j = 0; j < 8; ++j) vn[rr][j] = xr[64 * j]; } }
            asm volatile("" ::: "memory");
            if (lane == 0) { mu0[rowa] = mean[0]; rstd0[rowa] = rstd[0]; mu0[rowa + 1] = mean[1]; rstd0[rowa + 1] = rstd[1]; }
#pragma unroll
            for (int j = 0; j < 8; ++j) { const int c = 4 * lane + 256 * j;
                const f32x4 gg = *(const LAS f32x4*)(prm + c), bb = *(const LAS f32x4*)(prm + D + c), sc = *(const LAS f32x4*)(prm + 2 * D + c), sh = *(const LAS f32x4*)(prm + 3 * D + c);
#pragma unroll
                for (int rr = 0; rr < 2; ++rr) { const f32x4 xn = v[rr][j] * rstd[rr] * gg + bb; const f32x4 hv = xn * sc + sh;
                    u32x2 w; w.x = pk2(hv[0], hv[1]); w.y = pk2(hv[2], hv[3]); ((u32x2*)(h + (size_t)(rowa + rr) * D) + lane)[64 * j] = w; } }
        }
    }
}

DI void phase_attn_naive(const Ctx& X) {
    const bf16_t* aq = (const bf16_t*)(X.ws + WS_B); const bf16_t* ak = aq + (size_t)T * 1024; const bf16_t* av = ak + (size_t)T * 1024;
    bf16_t* mix = (bf16_t*)(X.ws + WS_A);
    LAS float* qs = (LAS float*)(X.lds + X.wave * 1024);
    for (int it = X.gw; it < T * AH; it += X.NGW) {
        const int row = it >> 3, hh = it & 7, s = row & (SEQ - 1);
        { const unsigned w = *(const unsigned*)(aq + (size_t)row * 1024 + hh * 128 + 2 * X.lane_f()); qs[2 * X.lane_f()] = bflo(w); qs[2 * X.lane_f() + 1] = bfhi(w); }
        LDS_WAIT();
        float sc[9]; bool vd[9];
#pragma unroll
        for (int p = 0; p < 3; ++p) {
            const int dil = p == 0 ? 1 : (p == 1 ? 4 : 16);
#pragma unroll
            for (int ps = 0; ps < 3; ++ps) {
                const int j = ps == 0 ? X.lane_f() - 64 : (ps == 1 ? X.lane_f() : 64);
                const int sp = s + dil * j;
                const bool valid = (ps < 2 || X.lane_f() == 0) && sp >= 0 && sp < SEQ;
                const int spc = valid ? sp : s;
                const u32x4* kr = (const u32x4*)(ak + ((size_t)(row - s + spc)) * 1024 + hh * 128);
                float dot = 0.f;
#pragma unroll 4
                for (int ch = 0; ch < 16; ++ch) {
                    const u32x4 kw = kr[ch]; const f32x4 q0 = *(const LAS f32x4*)(qs + 8 * ch), q1 = *(const LAS f32x4*)(qs + 8 * ch + 4);
                    dot += bflo(kw.x) * q0[0] + bfhi(kw.x) * q0[1] + bflo(kw.y) * q0[2] + bfhi(kw.y) * q0[3] + bflo(kw.z) * q1[0] + bfhi(kw.z) * q1[1] + bflo(kw.w) * q1[2] + bfhi(kw.w) * q1[3];
                }
                sc[p * 3 + ps] = valid ? dot : -1e30f; vd[p * 3 + ps] = valid;
            }
        }
        float m = sc[0];
#pragma unroll
        for (int i = 1; i < 9; ++i) m = fmaxf(m, sc[i]);
        m = wave_max(m);
        float l = 0.f;
#pragma unroll
        for (int i = 0; i < 9; ++i) { sc[i] = vd[i] ? expf(sc[i] - m) : 0.f; l += sc[i]; }
        l = wave_sum(l);
        float a0 = 0.f, a1 = 0.f;
#pragma unroll
        for (int p = 0; p < 3; ++p) {
            const int dil = p == 0 ? 1 : (p == 1 ? 4 : 16);
#pragma unroll
            for (int ps = 0; ps < 3; ++ps) {
                const int nk = ps < 2 ? 64 : 1;
                for (int k = 0; k < nk; ++k) {
                    const float pk = __shfl(sc[p * 3 + ps], k);
                    if (pk != 0.f) {
                        const int j = ps == 0 ? k - 64 : (ps == 1 ? k : 64);
                        const unsigned w = *(const unsigned*)(av + ((size_t)(row + dil * j)) * 1024 + hh * 128 + 2 * X.lane_f());
                        a0 += pk * bflo(w); a1 += pk * bfhi(w);
                    }
                }
            }
        }
        const float il = 1.0f / l;
        *(unsigned*)(mix + (size_t)row * D + hh * 128 + 2 * X.lane_f()) = pk2(a0 * il, a1 * il);
        LDS_WAIT();
    }
}


typedef float f32x16 __attribute__((ext_vector_type(16)));
typedef short s16x4 __attribute__((ext_vector_type(4)));
typedef short v4i16_t __attribute__((ext_vector_type(4)));
DI s16x4 vtr(const LAS unsigned char* p) { return __builtin_bit_cast(s16x4, __builtin_amdgcn_ds_read_tr16_b64_v4i16((LAS v4i16_t*)p)); }
#define MFMA32(a, b, c) __builtin_amdgcn_mfma_f32_32x32x16_bf16((a), (b), (c), 0, 0, 0)
DI bf16x8 cat8(s16x4 lo, s16x4 hi) { return (bf16x8){lo[0], lo[1], lo[2], lo[3], hi[0], hi[1], hi[2], hi[3]}; }

DI unsigned offb(unsigned row, unsigned ch) { return 256u * row + 16u * (ch ^ (((row & 3u) << 2) | ((row >> 2) & 3u))); }
DI void dma16(const void* gsrc, unsigned lds_dst) { unsigned keep; asm volatile("s_mov_b32 %0, m0\n\ts_mov_b32 m0, %2\n\ts_nop 0\n\tglobal_load_lds_dwordx4 %1, off\n\ts_mov_b32 m0, %0" : "=&s"(keep) : "v"(gsrc), "s"(lds_dst) : "memory"); }
template <int IMM> DI void dma16s(unsigned voff, const void* sbase, unsigned lds_base) { unsigned keep; asm volatile("s_mov_b32 %0, m0\n\ts_add_u32 m0, %3, %4\n\ts_nop 0\n\tglobal_load_lds_dwordx4 %1, %2\n\ts_mov_b32 m0, %0" : "=&s"(keep) : "v"(voff), "s"(sbase), "s"(lds_base), "i"(IMM) : "memory", "scc"); }
constexpr int ATT_XROW = 264, ATT_MOFF = 131072, ATT_LOFF = ATT_MOFF + 1024;
static_assert(256 * ATT_XROW <= 131072 && ATT_LOFF + 1024 <= LDS_BYTES - 16, "attention LDS map");
DI void phase_attn(const Ctx& X, const int dbg = 0, const int split = 0) {
    const bf16_t* aq = (const bf16_t*)(X.ws + WS_B); const bf16_t* ak = aq + (size_t)T * 1024; const bf16_t* av = ak + (size_t)T * 1024;
    bf16_t* mix = (dbg & 4) ? (bf16_t*)(X.ws + WS_WIN) : (bf16_t*)(X.ws + WS_A);
    const int w = X.wave;
    LAS unsigned char* vbase = X.lds + w * 16384;
    LAS unsigned char* xbuf = X.lds; LAS float* mS = (LAS float*)(X.lds + ATT_MOFF); LAS float* lS = (LAS float*)(X.lds + ATT_LOFF);
    const float LOG2E = 1.4426950408889634f;
    const int nit = split ? ((X.vcu & 1) ? 5 : 3) : (BATCH * AH * (SEQ / 256) - X.vcu + X.G - 1) / X.G;
    for (int iti = 0; iti < nit; ++iti) {
        int item;
        if (split) { const int k = ((X.vcu & 1) ? 0 : 5) + iti, xq = X.vcu >> 5, jq = (X.vcu & 31) >> 1; item = (4 * xq + (k >> 1)) * 32 + 16 * (k & 1) + jq; }
        else item = X.vcu + iti * X.G;
        int lane = X.lane_f(); asm volatile("" : "+v"(lane));
        const int c = lane & 31, hh = lane >> 5, trq = (lane & 15) >> 2, trp = lane & 3, trblk = (lane >> 4) & 1;
        const int qb = item & 31, head = (item >> 5) & 7, b = item >> 8;
        const int t0 = qb * 256; const size_t rowbase = (size_t)b * SEQ;
        const char* akh0 = (const char*)ak + (rowbase * 1024 + head * 128) * 2;
        const char* avh = (const char*)av + (rowbase * 1024 + head * 128) * 2;
        f32x16 o[4];
#pragma unroll
        for (int dt = 0; dt < 4; ++dt)
#pragma unroll
            for (int i = 0; i < 16; ++i) o[dt][i] = 0.f;
        float m = -1e30f, l = 0.f;
        int offq = 0;
#pragma unroll 1
        for (int p = 0; p < 3; ++p) {
            const int sh = 2 * p, dil = 1 << sh;
            offq = p == 0 ? 32 * w + c : (p == 1 ? 128 * (w >> 2) + 4 * c + (w & 3) : (c < 16 ? 16 * c + 2 * w : 16 * (c - 16) + 2 * w + 1));
            if (p > 0) {
#pragma unroll
                for (int dt = 0; dt < 4; ++dt)
#pragma unroll
                    for (int g = 0; g < 4; ++g) { const u32x2 wv = *(const LAS u32x2*)(xbuf + offq * ATT_XROW + (32 * dt + 8 * g + 4 * hh) * 2);
                        o[dt][4 * g] = bflo(wv.x); o[dt][4 * g + 1] = bfhi(wv.x); o[dt][4 * g + 2] = bflo(wv.y); o[dt][4 * g + 3] = bfhi(wv.y); }
                m = mS[offq]; l = lS[offq];
                __syncthreads();
            }
            const int pq = t0 + offq;
            bf16x8 qf[8];
            { const char* qp = (const char*)aq + ((rowbase + pq) * 1024 + head * 128) * 2 + hh * 16;
#pragma unroll
              for (int s = 0; s < 8; ++s) qf[s] = *(const bf16x8*)(qp + 32 * s); }
            asm volatile("s_waitcnt vmcnt(0)" ::: "memory");
#pragma unroll
            for (int s = 0; s < 8; ++s) asm volatile("" : "+v"(qf[s]));
            const int ntile = p == 2 ? 10 : 5;
#define ATT_KB(ti_) (p == 0 ? t0 + 32 * w - 64 + 32 * ((ti_) % 5) : (p == 1 ? t0 + 4 * (32 * (w >> 2) - 64 + 32 * ((ti_) % 5)) + (w & 3) : t0 + 16 * (-64 + 32 * ((ti_) % 5)) + 2 * w + (ti_) / 5))
#define ATT_DMA(ti_, gbase_, buf_, KSWZ_) do { const int kb_ = (dbg & 1) ? 4096 : ATT_KB(ti_); int lane = X.lane_f(); asm volatile("" : "+v"(lane)); \
                _Pragma("unroll") for (int i = 0; i < 8; ++i) { const int r_ = (KSWZ_) ? 4 * i + (lane >> 4) : 8 * (i >> 1) + ((lane >> 2) & 7); int pk_ = kb_ + (r_ << sh); pk_ = pk_ < 0 ? 0 : (pk_ > SEQ - 1 ? SEQ - 1 : pk_); \
                    const int ch_ = (KSWZ_) ? ((lane & 15) ^ (r_ & 15)) : (4 * (2 * (i & 1) + (lane >> 5)) + ((lane & 3) ^ ((2 * ((i >> 1) & 1) + ((lane >> 4) & 1)) & 3))); \
                    dma16((gbase_) + (size_t)pk_ * 2048 + ch_ * 16, (unsigned)__builtin_amdgcn_readfirstlane((int)(unsigned)(size_t)((buf_) + i * 1024))); } } while (0)
            LAS unsigned char* kbuf = vbase; LAS unsigned char* vbuf = vbase + 8192;
            const unsigned kbuf_u = (unsigned)__builtin_amdgcn_readfirstlane((int)(unsigned)(size_t)kbuf), vbuf_u = kbuf_u + 8192u;
            const unsigned offK0 = (unsigned)(((lane >> 4) << sh) * 2048) + (unsigned)(((lane & 15) ^ (lane >> 4)) << 4);
            const unsigned offV0 = (unsigned)((((lane >> 2) & 7) << sh) * 2048) + (unsigned)((4 * (lane >> 5) + ((lane & 3) ^ ((lane >> 4) & 1))) << 4);
#define ATT_OFFK(q_) (offK0 ^ (unsigned)(64 * (q_)))
#define ATT_OFFV(q_) ((offV0 + (unsigned)(128 * ((q_) & 1))) ^ (unsigned)(32 * ((q_) >> 1)))
#define ATT_INR(kb_) (((kb_) >= 0) && ((kb_) + (31 << sh) < SEQ))
#define ATT_DMA2(ti_, gbase_, bufu_, KSWZ_) do { const int kbn_ = ATT_KB(ti_); \
                if (ATT_INR(kbn_) && !(dbg & 1)) { const char* sb_ = (gbase_) + (size_t)kbn_ * 2048; const size_t st_ = (size_t)(4 << sh) * 2048; \
                    dma16s<0>((KSWZ_) ? ATT_OFFK(0) : ATT_OFFV(0), sb_, bufu_); dma16s<1024>((KSWZ_) ? ATT_OFFK(1) : ATT_OFFV(1), sb_ + st_ * ((KSWZ_) ? 1 : 0), bufu_); \
                    dma16s<2048>((KSWZ_) ? ATT_OFFK(2) : ATT_OFFV(2), sb_ + st_ * 2, bufu_); dma16s<3072>((KSWZ_) ? ATT_OFFK(3) : ATT_OFFV(3), sb_ + st_ * ((KSWZ_) ? 3 : 2), bufu_); \
                    dma16s<4096>((KSWZ_) ? ATT_OFFK(0) : ATT_OFFV(0), sb_ + st_ * 4, bufu_); dma16s<5120>((KSWZ_) ? ATT_OFFK(1) : ATT_OFFV(1), sb_ + st_ * ((KSWZ_) ? 5 : 4), bufu_); \
                    dma16s<6144>((KSWZ_) ? ATT_OFFK(2) : ATT_OFFV(2), sb_ + st_ * 6, bufu_); dma16s<7168>((KSWZ_) ? ATT_OFFK(3) : ATT_OFFV(3), sb_ + st_ * ((KSWZ_) ? 7 : 6), bufu_); } \
                else ATT_DMA(ti_, gbase_, (LAS unsigned char*)nullptr + (bufu_), KSWZ_); } while (0)
            ATT_DMA2(0, akh0, kbuf_u, 1); ATT_DMA2(0, avh, vbuf_u, 0);
            const LAS unsigned char* kfa = kbuf + c * 256;
            const LAS unsigned char* vt0 = vbuf + 64 * (4 * hh + trq) + 16 * ((2 * trblk + (trp >> 1)) ^ (hh & 3)) + 8 * (trp & 1);
            const LAS unsigned char* vt1 = vbuf + 2048 + 64 * (4 * hh + trq) + 16 * ((2 * trblk + (trp >> 1)) ^ ((2 + hh) & 3)) + 8 * (trp & 1);
#pragma unroll 1
            for (int ti = 0; ti < ntile; ++ti) {
                const int kb = ATT_KB(ti), tau = ti % 5;
                const bool more = ti + 1 < ntile;
                asm volatile("s_waitcnt vmcnt(8)" ::: "memory");
                bf16x8 kf[8];
#pragma unroll
                for (int s = 0; s < 8; ++s) kf[s] = *(const LAS bf16x8*)(kfa + (((2 * s + hh) ^ (c & 15)) << 4));
                f32x16 sa;
#pragma unroll
                for (int i = 0; i < 16; ++i) sa[i] = 0.f;
                if (dbg & 8) { sa[0] = __builtin_bit_cast(float, (int)kf[0][0]) * 1e-30f; } else
#pragma unroll
                for (int s = 0; s < 8; ++s) sa = MFMA32(kf[s], qf[s], sa);
                __builtin_amdgcn_sched_barrier(0);
                if (more) ATT_DMA2(ti + 1, akh0, kbuf_u, 1);
                __builtin_amdgcn_sched_barrier(0);
                const bool cm = ((kb - pq) & (dil - 1)) == 0;
                const bool fullt = (tau >= 1) && (tau <= 3) && ATT_INR(kb);
                bf16x8 pf[2];
                if (dbg & 8) { l += sa[0]; } else
                if (fullt) {
                    float tmax = fmaxf(fmaxf(sa[0], sa[1]), fmaxf(sa[2], sa[3]));
#pragma unroll
                    for (int r = 4; r < 16; r += 4) tmax = fmaxf(tmax, fmaxf(fmaxf(sa[r], sa[r + 1]), fmaxf(sa[r + 2], sa[r + 3])));
                    tmax *= LOG2E;
                    tmax = fmaxf(tmax, __shfl_xor(tmax, 32));
                    tmax = cm ? tmax : -1e30f;
                    const float mn = fmaxf(m, tmax);
                    if (__any(mn > m)) { const float alpha = __builtin_amdgcn_exp2f(m - mn); l *= alpha;
#pragma unroll
                        for (int dt = 0; dt < 4; ++dt) o[dt] = o[dt] * alpha; }
                    m = mn;
                    const float mneg = cm ? -mn : -1e30f;
                    float ps = 0.f;
#pragma unroll
                    for (int r = 0; r < 16; ++r) { sa[r] = __builtin_amdgcn_exp2f(__builtin_fmaf(sa[r], LOG2E, mneg)); ps += sa[r]; }
                    ps += __shfl_xor(ps, 32);
                    l += ps;
                } else {
                    float tmax = -1e30f;
#pragma unroll
                    for (int r = 0; r < 16; ++r) { const int kr = (r & 3) + 8 * (r >> 2) + 4 * hh; const int pk = kb + (kr << sh); const int df = pk - pq; const int ad = df < 0 ? -df : df;
                        const bool vdr = cm && (pk >= 0) && (pk < SEQ) && (ad <= (64 << sh));
                        sa[r] = vdr ? sa[r] * LOG2E : -1e30f; tmax = fmaxf(tmax, sa[r]); }
                    tmax = fmaxf(tmax, __shfl_xor(tmax, 32));
                    const float mn = fmaxf(m, tmax);
                    if (__any(mn > m)) { const float alpha = __builtin_amdgcn_exp2f(m - mn); l *= alpha;
#pragma unroll
                        for (int dt = 0; dt < 4; ++dt) o[dt] = o[dt] * alpha; }
                    m = mn;
                    float ps = 0.f;
#pragma unroll
                    for (int r = 0; r < 16; ++r) { sa[r] = sa[r] > -1e29f ? __builtin_amdgcn_exp2f(sa[r] - mn) : 0.f; ps += sa[r]; }
                    ps += __shfl_xor(ps, 32);
                    l += ps;
                }
#pragma unroll
                for (int s = 0; s < 2; ++s) { u32x4 pw; pw.x = cvtpk(sa[8 * s], sa[8 * s + 1]); pw.y = cvtpk(sa[8 * s + 2], sa[8 * s + 3]); pw.z = cvtpk(sa[8 * s + 4], sa[8 * s + 5]); pw.w = cvtpk(sa[8 * s + 6], sa[8 * s + 7]); pf[s] = __builtin_bit_cast(bf16x8, pw); }
                if (more) asm volatile("s_waitcnt vmcnt(8)" ::: "memory"); else asm volatile("s_waitcnt vmcnt(0)" ::: "memory");
#pragma unroll
                for (int dt = 0; dt < ((dbg & 8) ? 0 : 4); ++dt)
#pragma unroll
                    for (int s = 0; s < 2; ++s) { const s16x4 lo = vtr(vt0 + 4096 * s + 512 * dt), hi = vtr(vt1 + 4096 * s + 512 * dt);
                        o[dt] = MFMA32(cat8(lo, hi), pf[s], o[dt]); }
                asm volatile("s_waitcnt lgkmcnt(0)" ::: "memory");
                __builtin_amdgcn_sched_barrier(0);
                if (more) ATT_DMA2(ti + 1, avh, vbuf_u, 0);
                __builtin_amdgcn_sched_barrier(0);
            }
#undef ATT_DMA2
#undef ATT_INR
#undef ATT_OFFK
#undef ATT_OFFV
#undef ATT_KB
#undef ATT_DMA
            if (p < 2) {
                __syncthreads();
#pragma unroll
                for (int dt = 0; dt < 4; ++dt)
#pragma unroll
                    for (int g = 0; g < 4; ++g) { u32x2 wv; wv.x = cvtpk(o[dt][4 * g], o[dt][4 * g + 1]); wv.y = cvtpk(o[dt][4 * g + 2], o[dt][4 * g + 3]);
                        *(LAS u32x2*)(xbuf + offq * ATT_XROW + (32 * dt + 8 * g + 4 * hh) * 2) = wv; }
                if (hh == 0) { mS[offq] = m; lS[offq] = l; }
                __syncthreads();
            }
        }
        const float il = 1.0f / l;
        bf16_t* orow = mix + ((dbg & 4) ? ((rowbase + t0 + offq) & 4095) : (rowbase + t0 + offq)) * D + head * 128;
        if (!(dbg & 3))
#pragma unroll
        for (int dt = 0; dt < 4; ++dt)
#pragma unroll
            for (int g = 0; g < 4; ++g) { u32x2 wv; wv.x = cvtpk(o[dt][4 * g] * il, o[dt][4 * g + 1] * il); wv.y = cvtpk(o[dt][4 * g + 2] * il, o[dt][4 * g + 3] * il);
                *(u32x2*)(orow + 32 * dt + 8 * g + 4 * hh) = wv; }
    }
}

constexpr float LOG2E_F = 1.4426950408889634f;
constexpr size_t ST_CHUNK = 65536;

DI void phase_ret_states(const Ctx& X, const int dbg = 0) {
    const bf16_t* rk = (const bf16_t*)(X.ws + WS_B) + (size_t)4 * T * 1024; const bf16_t* rv = rk + (size_t)T * 1024;
    bf16_t* STf = (bf16_t*)(X.ws + WS_YF); bf16_t* STb = (bf16_t*)(X.ws + WS_YB);
    const int lane = X.lane_f(), c = lane & 31, hh = lane >> 5, w = X.wave, tid = X.tid_f();
    const int trq = (lane & 15) >> 2, trp = lane & 3, trblk = (lane >> 4) & 1;
    constexpr int BUF = 65536 + 8192;
    for (int item = X.vcu; item < 256; item += X.G) {
        const int es = item & 7, dir = (item >> 3) & 1, bh = item >> 4, b = bh >> 2, head = bh & 3;
        const float lg2 = (dir ? X.ldb()[head] : X.ldf()[head]) * LOG2E_F; const float gC = exp2f(128.0f * lg2);
        bf16_t* ST = (dir ? STb : STf) + (size_t)bh * 64 * ST_CHUNK;
        f32x16 acc;
#pragma unroll
        for (int i = 0; i < 16; ++i) acc[i] = 0.f;
        u32x4 kregA[8], kregB[8], vregA, vregB;
        const int vj = tid >> 2, vp = tid & 3;
        const float zeta = exp2f((float)(dir ? vj : 127 - vj) * lg2);
#define RS_LOADG(n_, kreg, vreg4) do { const size_t rowc = (size_t)b * SEQ + 128 * (n_); \
            _Pragma("unroll") for (int i = 0; i < 8; ++i) { const int idx = tid + 512 * i, j = idx >> 5, cc = idx & 31; kreg[i] = *(const u32x4*)(rk + (rowc + j) * 1024 + head * 256 + cc * 8); } \
            vreg4 = *(const u32x4*)(rv + (rowc + vj) * 1024 + head * 256 + 32 * es + 8 * vp); } while (0)
#define RS_STORE(buf_, kreg, vreg4) do { LAS unsigned char* kimg = X.lds + (buf_) * BUF; LAS unsigned char* vimg = kimg + 65536; \
            _Pragma("unroll") for (int i = 0; i < 8; ++i) { const int idx = tid + 512 * i, j = idx >> 5, cc = idx & 31; *(LAS u32x4*)(kimg + (cc >> 4) * 32768 + offb(j, cc & 15)) = kreg[i]; } \
            u32x4 sv; sv.x = cvtpk(bflo(vreg4.x) * zeta, bfhi(vreg4.x) * zeta); sv.y = cvtpk(bflo(vreg4.y) * zeta, bfhi(vreg4.y) * zeta); sv.z = cvtpk(bflo(vreg4.z) * zeta, bfhi(vreg4.z) * zeta); sv.w = cvtpk(bflo(vreg4.w) * zeta, bfhi(vreg4.w) * zeta); \
            *(LAS u32x4*)(vimg + vj * 64 + vp * 16) = sv; } while (0)
#define RS_CHUNK(step_) (dir ? 63 - (step_) : (step_))
        RS_LOADG(RS_CHUNK(0), kregA, vregA); RS_STORE(0, kregA, vregA);
        RS_LOADG(RS_CHUNK(1), kregB, vregB);
        __syncthreads();
#define RS_STEP(step_, kregNext, vregNext, kregLoad, vregLoad) do { const int step = (step_); const int n = RS_CHUNK(step), buf = step & 1; \
            if (step + 2 < 64) RS_LOADG(RS_CHUNK(step + 2), kregLoad, vregLoad); \
            if (!(dbg & 1)) {   \
              _Pragma("unroll") for (int gp = 0; gp < 2; ++gp) { const int ga = 2 * gp, gb = 2 * gp + 1; \
                const unsigned a0 = cvtpk(acc[4 * ga], acc[4 * ga + 1]), a1 = cvtpk(acc[4 * ga + 2], acc[4 * ga + 3]), b0 = cvtpk(acc[4 * gb], acc[4 * gb + 1]), b1 = cvtpk(acc[4 * gb + 2], acc[4 * gb + 3]); \
                const unsigned r0 = __shfl_xor(hh ? a0 : b0, 32), r1 = __shfl_xor(hh ? a1 : b1, 32); \
                u32x4 wv; if (hh == 0) { wv.x = a0; wv.y = a1; wv.z = r0; wv.w = r1; } else { wv.x = r0; wv.y = r1; wv.z = b0; wv.w = b1; } \
                *(u32x4*)(ST + (size_t)n * ST_CHUNK + ((size_t)(4 * w + (hh ? gb : ga)) * 256 + 32 * es + c) * 8) = wv; } } \
            acc = acc * gC; \
            const LAS unsigned char* kimg = X.lds + buf * BUF + (w >> 2) * 32768; const LAS unsigned char* vimg = X.lds + buf * BUF + 65536; \
            if (!(dbg & 2)) _Pragma("unroll") for (int ks = 0; ks < 8; ++ks) { \
                const unsigned r0 = 16 * ks + 8 * hh + trq, r1 = r0 + 4, ch = 4 * (w & 3) + 2 * trblk + (trp >> 1); \
                const s16x4 a0 = vtr(kimg + offb(r0, ch) + 8 * (trp & 1)), a1 = vtr(kimg + offb(r1, ch) + 8 * (trp & 1)); \
                const s16x4 b0 = vtr(vimg + r0 * 64 + 32 * trblk + 8 * trp), b1 = vtr(vimg + r1 * 64 + 32 * trblk + 8 * trp); \
                acc = MFMA32(cat8(a0, a1), cat8(b0, b1), acc); } \
            if (step + 1 < 64 && !(dbg & 4)) RS_STORE(buf ^ 1, kregNext, vregNext); \
            __syncthreads(); } while (0)
#pragma unroll 1
        for (int s2 = 0; s2 < 64; s2 += 2) {
            RS_STEP(s2, kregB, vregB, kregA, vregA);
            RS_STEP(s2 + 1, kregA, vregA, kregB, vregB);
        }
#undef RS_STEP
#undef RS_CHUNK
#undef RS_LOADG
#undef RS_STORE
    }
}

DI void phase_ret_states64(const Ctx& X, const int q) {
    const bf16_t* rk = (const bf16_t*)(X.ws + WS_B) + (size_t)4 * T * 1024; const bf16_t* rv = rk + (size_t)T * 1024;
    bf16_t* STf = (bf16_t*)(X.ws + WS_YF); bf16_t* STb = (bf16_t*)(X.ws + WS_YB);
    const int lane = X.lane_f(), c = lane & 31, hh = lane >> 5, w = X.wave, tid = X.tid_f();
    const int trq = (lane & 15) >> 2, trp = lane & 3, trblk = (lane >> 4) & 1;
    const int es4 = q & 3, dir = (q >> 2) & 1, bh = q >> 3, b = bh >> 2, head = bh & 3;
    const float lg2 = (dir ? X.ldb()[head] : X.ldf()[head]) * LOG2E_F; const float gC = exp2f(128.0f * lg2);
    bf16_t* ST = (dir ? STb : STf) + (size_t)bh * 64 * ST_CHUNK;
    f32x16 acc[2];
#pragma unroll
    for (int et = 0; et < 2; ++et)
#pragma unroll
        for (int i = 0; i < 16; ++i) acc[et][i] = 0.f;
    u32x4 kregA[8], vregA[2];
    const int vj0 = tid >> 3, vj1 = (tid + 512) >> 3, vp = tid & 7;
    const float zeta0 = exp2f((float)(dir ? vj0 : 127 - vj0) * lg2), zeta1 = exp2f((float)(dir ? vj1 : 127 - vj1) * lg2);
    LAS unsigned char* vimg = X.lds + 131072;
#define R6_LOADG(n_, kreg, vreg) do { const size_t rowc = (size_t)b * SEQ + 128 * (n_); \
        _Pragma("unroll") for (int i = 0; i < 8; ++i) { const int idx = tid + 512 * i, j = idx >> 5, cc = idx & 31; kreg[i] = *(const u32x4*)(rk + (rowc + j) * 1024 + head * 256 + cc * 8); } \
        vreg[0] = *(const u32x4*)(rv + (rowc + vj0) * 1024 + head * 256 + 64 * es4 + 8 * vp); vreg[1] = *(const u32x4*)(rv + (rowc + vj1) * 1024 + head * 256 + 64 * es4 + 8 * vp); } while (0)
#define R6_STOREK(buf_, kreg) do { LAS unsigned char* kimg = X.lds + (buf_) * 65536; \
        _Pragma("unroll") for (int i = 0; i < 8; ++i) { const int idx = tid + 512 * i, j = idx >> 5, cc = idx & 31; *(LAS u32x4*)(kimg + (cc >> 4) * 32768 + offb(j, cc & 15)) = kreg[i]; } } while (0)
#define R6_SCALE(v_, z_) ({ u32x4 sv_; sv_.x = cvtpk(bflo((v_).x) * (z_), bfhi((v_).x) * (z_)); sv_.y = cvtpk(bflo((v_).y) * (z_), bfhi((v_).y) * (z_)); sv_.z = cvtpk(bflo((v_).z) * (z_), bfhi((v_).z) * (z_)); sv_.w = cvtpk(bflo((v_).w) * (z_), bfhi((v_).w) * (z_)); sv_; })
#define R6_STOREV(vreg) do { *(LAS u32x4*)(vimg + vj0 * 128 + vp * 16) = R6_SCALE(vreg[0], zeta0); *(LAS u32x4*)(vimg + vj1 * 128 + vp * 16) = R6_SCALE(vreg[1], zeta1); } while (0)
#define R6_CHUNK(step_) (dir ? 63 - (step_) : (step_))
    R6_LOADG(R6_CHUNK(0), kregA, vregA); R6_STOREK(0, kregA); R6_STOREV(vregA);
    __syncthreads();
#define R6_STEP(step_, kregNext, vregNext, kregLoad, vregLoad) do { const int step = (step_); const int n = R6_CHUNK(step), buf = step & 1; \
        if (step + 1 < 64) R6_LOADG(R6_CHUNK(step + 1), kregLoad, vregLoad); \
        _Pragma("unroll") for (int et = 0; et < 2; ++et) _Pragma("unroll") for (int gp = 0; gp < 2; ++gp) { const int ga = 2 * gp, gb = 2 * gp + 1; \
            const unsigned a0 = cvtpk(acc[et][4 * ga], acc[et][4 * ga + 1]), a1 = cvtpk(acc[et][4 * ga + 2], acc[et][4 * ga + 3]), b0 = cvtpk(acc[et][4 * gb], acc[et][4 * gb + 1]), b1 = cvtpk(acc[et][4 * gb + 2], acc[et][4 * gb + 3]); \
            const unsigned r0 = __shfl_xor(hh ? a0 : b0, 32), r1 = __shfl_xor(hh ? a1 : b1, 32); \
            u32x4 wv; if (hh == 0) { wv.x = a0; wv.y = a1; wv.z = r0; wv.w = r1; } else { wv.x = r0; wv.y = r1; wv.z = b0; wv.w = b1; } \
            *(u32x4*)(ST + (size_t)n * ST_CHUNK + ((size_t)(4 * w + (hh ? gb : ga)) * 256 + 64 * es4 + 32 * et + c) * 8) = wv; } \
        acc[0] = acc[0] * gC; acc[1] = acc[1] * gC; \
        const LAS unsigned char* kimg = X.lds + buf * 65536 + (w >> 2) * 32768; \
        _Pragma("unroll") for (int ks = 0; ks < 8; ++ks) { \
            const unsigned r0 = 16 * ks + 8 * hh + trq, r1 = r0 + 4, ch = 4 * (w & 3) + 2 * trblk + (trp >> 1); \
            const bf16x8 a = cat8(vtr(kimg + offb(r0, ch) + 8 * (trp & 1)), vtr(kimg + offb(r1, ch) + 8 * (trp & 1))); \
            _Pragma("unroll") for (int et = 0; et < 2; ++et) { \
                const s16x4 b0 = vtr(vimg + r0 * 128 + 64 * et + 32 * trblk + 8 * trp), b1 = vtr(vimg + r1 * 128 + 64 * et + 32 * trblk + 8 * trp); \
                acc[et] = MFMA32(a, cat8(b0, b1), acc[et]); } } \
        if (step + 1 < 64) R6_STOREK(buf ^ 1, kregNext); \
        __syncthreads();                                     \
        if (step + 1 < 64) R6_STOREV(vregNext); \
        __syncthreads(); } while (0)
#pragma unroll 1
    for (int s2 = 0; s2 < 64; ++s2) {
        R6_STEP(s2, kregA, vregA, kregA, vregA);
    }
#undef R6_STEP
#undef R6_CHUNK
#undef R6_LOADG
#undef R6_STOREK
#undef R6_STOREV
#undef R6_SCALE
}

DI void phase_ret_out(const Ctx& X, const int dbg = 0) {
    const bf16_t* rq = (const bf16_t*)(X.ws + WS_B) + (size_t)3 * T * 1024; const bf16_t* rk = rq + (size_t)T * 1024; const bf16_t* rv = rk + (size_t)T * 1024; const bf16_t* rg = rv + (size_t)T * 1024;
    const bf16_t* STf = (const bf16_t*)(X.ws + WS_YF); const bf16_t* STb = (const bf16_t*)(X.ws + WS_YB);
    bf16_t* mix = dbg ? (bf16_t*)(X.ws + WS_Y) : (bf16_t*)(X.ws + WS_A);
    const int w = X.wave;
    LAS unsigned char* qimg = X.lds; LAS unsigned char* kimg = X.lds + 65536; LAS unsigned char* pimg = kimg; LAS unsigned char* vimg = X.lds;
    LAS float* part = (LAS float*)(X.lds + 131072);
    for (int item = X.vcu; item < 1024; item += X.G) {
        int lane_o = X.lane_f(); asm volatile("" : "+v"(lane_o));
        int tid = X.tid_f(); asm volatile("" : "+v"(tid));
        const int c = lane_o & 31, hh = lane_o >> 5, trq = (lane_o & 15) >> 2, trp = lane_o & 3, trblk = (lane_o >> 4) & 1;
        const int n = item & 63, bh = item >> 6, b = bh >> 2, head = bh & 3; const size_t rowc = (size_t)b * SEQ + 128 * n;
        const float lg2f = X.ldf()[head] * LOG2E_F, lg2b = X.ldb()[head] * LOG2E_F;
#pragma unroll
        for (int i = 0; i < 8; ++i) { const int idx = tid + 512 * i, j = idx >> 5, cc = idx & 31;
            const u32x4 qv = *(const u32x4*)(rq + (rowc + j) * 1024 + head * 256 + cc * 8), kv = *(const u32x4*)(rk + (rowc + j) * 1024 + head * 256 + cc * 8);
            *(LAS u32x4*)(qimg + j * 512 + ((cc ^ (j & 15)) << 4)) = qv; *(LAS u32x4*)(kimg + j * 512 + ((cc ^ (j & 15)) << 4)) = kv; }
        __syncthreads();
        f32x16 acc[4];
#pragma unroll
        for (int it = 0; it < 4; ++it)
#pragma unroll
            for (int i = 0; i < 16; ++i) acc[it][i] = 0.f;
        {
            const bf16_t* spf = STf + ((size_t)bh * 64 + n) * ST_CHUNK + ((size_t)hh * 256 + 32 * w + c) * 8;
            const bf16_t* spb = STb + ((size_t)bh * 64 + n) * ST_CHUNK + ((size_t)hh * 256 + 32 * w + c) * 8;
            bf16x8 afA[8], afB[8];
#define RO_LOAD(dst, sp_, sh_) do { _Pragma("unroll") for (int s = 0; s < 8; ++s) dst[s] = *(const bf16x8*)((sp_) + (size_t)(8 * (sh_) + s) * 2 * 256 * 8); } while (0)
#define RO_MMA(src, sh_) do { _Pragma("unroll") for (int it = 0; it < 4; ++it) { const int i = 32 * it + c; const LAS unsigned char* qrow = qimg + i * 512; \
                _Pragma("unroll") for (int s = 0; s < 8; ++s) acc[it] = MFMA32(src[s], *(const LAS bf16x8*)(qrow + (((2 * (8 * (sh_) + s) + hh) ^ (i & 15)) << 4)), acc[it]); \
                asm volatile("" ::: "memory"); } } while (0)
            if (!(dbg & 2)) {
            RO_LOAD(afA, spf, 0); RO_LOAD(afB, spf, 1);
            RO_MMA(afA, 0); RO_LOAD(afA, spb, 0);
            RO_MMA(afB, 1); RO_LOAD(afB, spb, 1);
#pragma unroll
            for (int it = 0; it < 4; ++it) { const int i = 32 * it + c; acc[it] = acc[it] * __builtin_amdgcn_exp2f((float)(i + 1) * lg2f - (float)(128 - i) * lg2b); }
            RO_MMA(afA, 0);
            RO_MMA(afB, 1);
            }
#pragma unroll
            for (int it = 0; it < 4; ++it) { const int i = 32 * it + c; acc[it] = acc[it] * __builtin_amdgcn_exp2f((float)(128 - i) * lg2b); }
#undef RO_LOAD
#undef RO_MMA
        }
        float pvv[2][16];
        {
            const int it = w & 3, i = 32 * it + c; const LAS unsigned char* qrow = qimg + i * 512;
#pragma unroll
            for (int jj = 0; jj < 2; ++jj) {
                const int jt = 2 * (w >> 2) + jj, j = 32 * jt + c; const LAS unsigned char* krow = kimg + j * 512;
                f32x16 sa;
#pragma unroll
                for (int r = 0; r < 16; ++r) sa[r] = 0.f;
#pragma unroll
                for (int s = 0; s < ((dbg & 4) ? 0 : 16); ++s) { sa = MFMA32(*(const LAS bf16x8*)(krow + (((2 * s + hh) ^ (j & 15)) << 4)), *(const LAS bf16x8*)(qrow + (((2 * s + hh) ^ (i & 15)) << 4)), sa);
                    if ((s & 3) == 3) asm volatile("" ::: "memory"); }
#pragma unroll
                for (int r = 0; r < 16; ++r) { const int jr = 32 * jt + (r & 3) + 8 * (r >> 2) + 4 * hh; const int df = i - jr;
                    const float dm = __builtin_amdgcn_exp2f(df >= 0 ? (float)df * lg2f : (float)(-df) * lg2b); pvv[jj][r] = sa[r] * dm; }
            }
        }
        __syncthreads();
        {
            const int it = w & 3, i = 32 * it + c;
#pragma unroll
            for (int jj = 0; jj < 2; ++jj) { const int jt = 2 * (w >> 2) + jj;
#pragma unroll
                for (int g = 0; g < 4; ++g) { u32x2 wv; wv.x = cvtpk(pvv[jj][4 * g], pvv[jj][4 * g + 1]); wv.y = cvtpk(pvv[jj][4 * g + 2], pvv[jj][4 * g + 3]);
                    *(LAS u32x2*)(pimg + i * 256 + (((4 * jt + g) ^ (i & 15)) << 4) + 8 * hh) = wv; } }
#pragma unroll
            for (int i2 = 0; i2 < 8; ++i2) { const int idx = tid + 512 * i2, j = idx >> 5, cc = idx & 31;
                const u32x4 vv = *(const u32x4*)(rv + (rowc + j) * 1024 + head * 256 + cc * 8);
                *(LAS u32x4*)(vimg + (cc >> 4) * 32768 + offb(j, cc & 15)) = vv; }
        }
        __syncthreads();
        {
            const LAS unsigned char* vh = vimg + (w >> 2) * 32768;
#pragma unroll
            for (int ks = 0; ks < ((dbg & 4) ? 0 : 8); ++ks) {
                const unsigned r0 = 16 * ks + 8 * hh + trq, r1 = r0 + 4, ch = 4 * (w & 3) + 2 * trblk + (trp >> 1);
                const bf16x8 a = cat8(vtr(vh + offb(r0, ch) + 8 * (trp & 1)), vtr(vh + offb(r1, ch) + 8 * (trp & 1)));
#pragma unroll
                for (int it = 0; it < 4; ++it) { const int i = 32 * it + c; acc[it] = MFMA32(a, *(const LAS bf16x8*)(pimg + i * 256 + (((2 * ks + hh) ^ (i & 15)) << 4)), acc[it]); }
                if (ks & 1) asm volatile("" ::: "memory");
            }
        }
        u32x4 gq[8];
#pragma unroll
        for (int i2 = 0; i2 < 8; ++i2) { const int idx = tid + 512 * i2, j = idx >> 5, cc = idx & 31; gq[i2] = *(const u32x4*)(rg + (rowc + j) * 1024 + head * 256 + cc * 8); }
#pragma unroll
        for (int it = 0; it < 4; ++it) { float s1 = 0.f, s2 = 0.f;
#pragma unroll
            for (int r = 0; r < 16; ++r) { s1 += acc[it][r]; s2 += acc[it][r] * acc[it][r]; }
            s1 += __shfl_xor(s1, 32); s2 += __shfl_xor(s2, 32);
            if (hh == 0) *(LAS f32x2*)(part + (w * 128 + 32 * it + c) * 2) = (f32x2){s1, s2}; }
        __syncthreads();
#pragma unroll
        for (int it = 0; it < 4; ++it) { const int i = 32 * it + c; float s1 = 0.f, s2 = 0.f;
#pragma unroll
            for (int ww = 0; ww < 8; ++ww) { const f32x2 pp = *(const LAS f32x2*)(part + (ww * 128 + i) * 2); s1 += pp[0]; s2 += pp[1]; }
            const float mean = s1 * (1.0f / 256.0f); const float var = fmaxf(s2 * (1.0f / 256.0f) - mean * mean, 0.f); const float rstd = 1.0f / sqrtf(var + LN_EPS);
#pragma unroll
            for (int g = 0; g < 4; ++g) { f32x4 y; y[0] = (acc[it][4 * g] - mean) * rstd; y[1] = (acc[it][4 * g + 1] - mean) * rstd; y[2] = (acc[it][4 * g + 2] - mean) * rstd; y[3] = (acc[it][4 * g + 3] - mean) * rstd;
                *(LAS f32x4*)(X.lds + i * 1024 + (((8 * w + hh + 2 * g) ^ (i & 15)) << 4)) = y; }
        }
        __syncthreads();
#pragma unroll
        for (int i2 = 0; i2 < 8; ++i2) { const int idx = tid + 512 * i2, j = idx >> 5, cc = idx & 31;
            const f32x4 y0 = *(const LAS f32x4*)(X.lds + j * 1024 + (((2 * cc) ^ (j & 15)) << 4)), y1 = *(const LAS f32x4*)(X.lds + j * 1024 + (((2 * cc + 1) ^ (j & 15)) << 4));
            const u32x4 gw = gq[i2]; u32x4 wv;
#define RO_G(gwc, ya, yb) ({ const float ga = bflo(gwc), gb = bfhi(gwc); cvtpk(ga / (1.f + __expf(-ga)) * (ya), gb / (1.f + __expf(-gb)) * (yb)); })
            wv.x = RO_G(gw.x, y0[0], y0[1]); wv.y = RO_G(gw.y, y0[2], y0[3]); wv.z = RO_G(gw.z, y1[0], y1[1]); wv.w = RO_G(gw.w, y1[2], y1[3]);
#undef RO_G
            *(u32x4*)(mix + (rowc + j) * D + 1024 + head * 256 + cc * 8) = wv; }
        __syncthreads();
    }
}

DI void phase_ret_naive(const Ctx& X) {
    const bf16_t* rq = (const bf16_t*)(X.ws + WS_B) + (size_t)3 * T * 1024; const bf16_t* rk = rq + (size_t)T * 1024; const bf16_t* rv = rk + (size_t)T * 1024;
    LAS float* qsm = (LAS float*)X.lds;
    LAS float* ksm = qsm + 16 * 256;
    LAS float* vsm = ksm + 16 * 256;
    LAS float* yp = vsm + 16 * 64;
    const int e = X.tid_f() & 63, dq = X.wave;
    for (int it = X.vcu; it < 16 * 2 * 4; it += X.G) {
        const int eq = it & 3, dir = (it >> 2) & 1, bh = it >> 3, b = bh >> 2, hh = bh & 3;
        const float gam = expf(dir ? X.ldb()[hh] : X.ldf()[hh]);
        float* ybuf = (float*)(X.ws + (dir ? WS_YB : WS_YF));
        float st[32];
#pragma unroll
        for (int i = 0; i < 32; ++i) st[i] = 0.f;
        for (int blk = 0; blk < SEQ / 16; ++blk) {
            const int t0 = dir ? (SEQ - 16 - 16 * blk) : 16 * blk;
            const size_t row0 = (size_t)b * SEQ + t0;
            {
                const int tt = X.tid_f() >> 5, c8 = (X.tid_f() & 31) * 8;
                const u32x4 qw = *(const u32x4*)(rq + (row0 + tt) * 1024 + hh * 256 + c8), kw = *(const u32x4*)(rk + (row0 + tt) * 1024 + hh * 256 + c8);
                LAS float* qd = qsm + tt * 256 + c8; LAS float* kd = ksm + tt * 256 + c8;
                qd[0] = bflo(qw.x); qd[1] = bfhi(qw.x); qd[2] = bflo(qw.y); qd[3] = bfhi(qw.y); qd[4] = bflo(qw.z); qd[5] = bfhi(qw.z); qd[6] = bflo(qw.w); qd[7] = bfhi(qw.w);
                kd[0] = bflo(kw.x); kd[1] = bfhi(kw.x); kd[2] = bflo(kw.y); kd[3] = bfhi(kw.y); kd[4] = bflo(kw.z); kd[5] = bfhi(kw.z); kd[6] = bflo(kw.w); kd[7] = bfhi(kw.w);
                if (X.tid_f() < 256) { const int t2 = X.tid_f() >> 4, c4 = (X.tid_f() & 15) * 4; const u32x2 vw = *(const u32x2*)(rv + (row0 + t2) * 1024 + hh * 256 + eq * 64 + c4);
                    LAS float* vd = vsm + t2 * 64 + c4; vd[0] = bflo(vw.x); vd[1] = bfhi(vw.x); vd[2] = bflo(vw.y); vd[3] = bfhi(vw.y); }
            }
            __syncthreads();
#pragma unroll 1
            for (int i = 0; i < 16; ++i) {
                const int tt = dir ? 15 - i : i;
                const float vv = vsm[tt * 64 + e];
                const LAS float* kq = ksm + tt * 256 + dq * 32; const LAS float* qq = qsm + tt * 256 + dq * 32;
                float y = 0.f;
                if (dir == 0) {
#pragma unroll
                    for (int d = 0; d < 32; ++d) { st[d] = gam * st[d] + kq[d] * vv; y += qq[d] * st[d]; }
                } else {
#pragma unroll
                    for (int d = 0; d < 32; ++d) { y += qq[d] * st[d]; st[d] = gam * st[d] + kq[d] * vv; }
                    y *= gam;
                }
                yp[(dq * 16 + tt) * 64 + e] = y;
            }
            __syncthreads();
            for (int o = X.tid_f(); o < 16 * 64; o += NTHREADS) {
                const int tt = o >> 6, ee = o & 63; float y = 0.f;
#pragma unroll
                for (int q = 0; q < 8; ++q) y += yp[(q * 16 + tt) * 64 + ee];
                ybuf[(row0 + tt) * 1024 + hh * 256 + eq * 64 + ee] = y;
            }
            __syncthreads();
        }
    }
}

DI void phase_ret_fin_naive(const Ctx& X) {
    const float* yf = (const float*)(X.ws + WS_YF); const float* yb = (const float*)(X.ws + WS_YB);
    const bf16_t* rg = (const bf16_t*)(X.ws + WS_B) + (size_t)6 * T * 1024;
    bf16_t* mix = (bf16_t*)(X.ws + WS_A);
    for (int it = X.gw; it < T * RH; it += X.NGW) {
        const int row = it >> 2, hh = it & 3; const size_t off = (size_t)row * 1024 + hh * 256 + 4 * X.lane_f();
        f32x4 y = *(const f32x4*)(yf + off) + *(const f32x4*)(yb + off);
        const float mean = wave_sum((y[0] + y[1]) + (y[2] + y[3])) * (1.0f / 256.0f);
        y = y - mean;
        const float var = wave_sum((y[0] * y[0] + y[1] * y[1]) + (y[2] * y[2] + y[3] * y[3])) * (1.0f / 256.0f);
        const float rstd = 1.0f / sqrtf(var + LN_EPS);
        const u32x2 gw = *(const u32x2*)(rg + off);
        const float g0 = bflo(gw.x), g1 = bfhi(gw.x), g2 = bflo(gw.y), g3 = bfhi(gw.y);
        f32x4 o; o[0] = g0 / (1.f + expf(-g0)) * y[0] * rstd; o[1] = g1 / (1.f + expf(-g1)) * y[1] * rstd; o[2] = g2 / (1.f + expf(-g2)) * y[2] * rstd; o[3] = g3 / (1.f + expf(-g3)) * y[3] * rstd;
        u32x2 w; w.x = pk2(o[0], o[1]); w.y = pk2(o[2], o[3]);
        *(u32x2*)(mix + (size_t)row * D + 1024 + hh * 256 + 4 * X.lane_f()) = w;
    }
}

DI void phase_w2_copy(const Ctx& X) {
    LAS float* scr = (LAS float*)(X.lds + X.wave * TR_SCR);
    bf16_t* W2 = (bf16_t*)(X.ws + WS_W2);
    unsigned* ctr = (unsigned*)(X.ws + CTL_WQ);
    constexpr int I_2 = (FF / 64) * (D / 64);
    for (;;) {
        unsigned it0 = 0;
        if (X.lane_f() == 0) it0 = __hip_atomic_fetch_add(ctr, 2u, __ATOMIC_RELAXED, __HIP_MEMORY_SCOPE_AGENT);
        it0 = (unsigned)__builtin_amdgcn_readfirstlane((int)it0);
        if (it0 >= (unsigned)(NE * I_2)) break;
        for (int j = 0; j < 2; ++j) {
            const int it = (int)it0 + j; const int e = it / I_2, r = it % I_2;
            transpose_item(X.w2() + (size_t)e * FF * D, FF, D, W2 + (size_t)e * D * FF, RowId{}, scr, r, X.lane_f());
        }
    }
}

DI void phase_route(const Ctx& X, const int parts) {
    if (parts & 1) {
        LAS float* scr = (LAS float*)(X.lds + X.wave * TR_SCR);
        bf16_t* W13 = (bf16_t*)(X.ws + WS_W13); bf16_t* W2 = (bf16_t*)(X.ws + WS_W2);
        constexpr int I_1 = (D / 64) * (FF / 64);
        for (int it = X.gw; it < NE * 2 * I_1; it += X.NGW) {
            const int e = it / (2 * I_1); const int r = it % (2 * I_1);
            if (r < I_1) transpose_item(X.w1() + (size_t)e * D * FF, D, FF, W13 + (size_t)e * 1024 * D, RowGate{0}, scr, r, X.lane_f());
            else transpose_item(X.w3() + (size_t)e * D * FF, D, FF, W13 + (size_t)e * 1024 * D, RowGate{1}, scr, r - I_1, X.lane_f());
        }
    }
    __syncthreads();
    const float* t = (const float*)(X.ws + WS_T); const float* part = (const float*)(X.ws + WS_STAT1);
    const float* mod = (const float*)(X.ws + CTL_MOD); const float* WRt = (const float*)(X.ws + WS_WR);
    bf16_t* h2 = (bf16_t*)(X.ws + WS_H2);
    unsigned* slot = (unsigned*)(X.ws + WS_SLOT); float* wt = (float*)(X.ws + WS_WT); unsigned* lists = (unsigned*)(X.ws + WS_LIST); unsigned* cnt = (unsigned*)(X.ws + CTL_CNT);
    const bf16_t* WRh = (const bf16_t*)(X.ws + WS_WR + 512 * 1024); const bf16_t* WRl = (const bf16_t*)(X.ws + WS_WR + 768 * 1024);
    const float* PP = (const float*)(X.ws + WS_WR + 1024 * 1024);
    LAS float* lgl = (LAS float*)(X.lds + X.wave * 4096);
    if (parts & 2) for (int grp = X.gw; grp < T / 16; grp += X.NGW) {
        const int row0 = grp * 16, b = row0 / SEQ, r = X.lane_f() & 15, kq = X.lane_f() >> 4, row = row0 + r;
        float ps = 0.f, pq = 0.f;
        { const f32x4* pp = (const f32x4*)(part + ((size_t)row * 32 + kq * 8) * 2);
#pragma unroll
          for (int i = 0; i < 4; ++i) { const f32x4 x = pp[i]; ps += x[0] + x[2]; pq += x[1] + x[3]; } }
        ps += __shfl_xor(ps, 16); ps += __shfl_xor(ps, 32); pq += __shfl_xor(pq, 16); pq += __shfl_xor(pq, 32);
        const float mean = ps * (1.0f / D); const float var = fmaxf(pq * (1.0f / D) - mean * mean, 0.f); const float rstd = 1.0f / sqrtf(var + LN_EPS);
        const float* P1 = PP + ((size_t)b * 2) * D + 8 * kq; const float* P2 = P1 + D;
        const bf16_t* trow = (const bf16_t*)t + (size_t)row * D + 8 * kq; bf16_t* hrow = h2 + (size_t)row * D + 8 * kq;
        const bf16_t* wh = WRh + (size_t)r * D + 8 * kq; const bf16_t* wl_ = WRl + (size_t)r * D + 8 * kq;
        f32x4 acc[3];
#pragma unroll
        for (int ct = 0; ct < 3; ++ct) acc[ct] = (f32x4){0.f, 0.f, 0.f, 0.f};
#pragma unroll 4
        for (int m = 0; m < 64; ++m) {
            const u32x4 tw = *(const u32x4*)(trow + 32 * m); const f32x4 ta = {bflo(tw.x), bfhi(tw.x), bflo(tw.y), bfhi(tw.y)}, tb = {bflo(tw.z), bfhi(tw.z), bflo(tw.w), bfhi(tw.w)};
            const f32x4 p1a = *(const f32x4*)(P1 + 32 * m), p1b = *(const f32x4*)(P1 + 32 * m + 4), p2a = *(const f32x4*)(P2 + 32 * m), p2b = *(const f32x4*)(P2 + 32 * m + 4);
            const f32x4 ha = (ta - mean) * rstd * p1a + p2a, hb = (tb - mean) * rstd * p1b + p2b;
            u32x4 hi; hi.x = cvtpk(ha[0], ha[1]); hi.y = cvtpk(ha[2], ha[3]); hi.z = cvtpk(hb[0], hb[1]); hi.w = cvtpk(hb[2], hb[3]);
            u32x4 lo; lo.x = cvtpk(ha[0] - bflo(hi.x), ha[1] - bfhi(hi.x)); lo.y = cvtpk(ha[2] - bflo(hi.y), ha[3] - bfhi(hi.y)); lo.z = cvtpk(hb[0] - bflo(hi.z), hb[1] - bfhi(hi.z)); lo.w = cvtpk(hb[2] - bflo(hi.w), hb[3] - bfhi(hi.w));
            *(u32x4*)(hrow + 32 * m) = hi;
            if (!(parts & 16)) {
                const bf16x8 ahi = __builtin_bit_cast(bf16x8, hi), alo = __builtin_bit_cast(bf16x8, lo);
#pragma unroll
                for (int ct = 0; ct < 3; ++ct) {
                    const bf16x8 bh = *(const bf16x8*)(wh + (size_t)ct * 16 * D + 32 * m), bl = *(const bf16x8*)(wl_ + (size_t)ct * 16 * D + 32 * m);
                    acc[ct] = __builtin_amdgcn_mfma_f32_16x16x32_bf16(ahi, bh, acc[ct], 0, 0, 0);
                    acc[ct] = __builtin_amdgcn_mfma_f32_16x16x32_bf16(ahi, bl, acc[ct], 0, 0, 0);
                    acc[ct] = __builtin_amdgcn_mfma_f32_16x16x32_bf16(alo, bh, acc[ct], 0, 0, 0);
                }
            }
        }
        if (parts & 16) continue;
#pragma unroll
        for (int ct = 0; ct < 3; ++ct)
#pragma unroll
            for (int g = 0; g < 4; ++g) lgl[(4 * kq + g) * 48 + 16 * ct + r] = acc[ct][g];
        LDS_WAIT();
        if (X.lane_f() < 16) {
            const LAS float* lg = lgl + X.lane_f() * 48;
            float gl[4];
#pragma unroll
            for (int g = 0; g < 4; ++g) gl[g] = lg[32 + g] + X.b_group()[g];
            int gs = 0; float gm = gl[0];
#pragma unroll
            for (int g = 1; g < 4; ++g) if (gl[g] > gm) { gm = gl[g]; gs = g; }
            float den = 0.f;
#pragma unroll
            for (int g = 0; g < 4; ++g) den += expf(gl[g] - gm);
            const float pg = 1.0f / den;
            float sl[8];
#pragma unroll
            for (int e = 0; e < 8; ++e) sl[e] = lg[gs * 8 + e] + X.b_sub()[gs * 8 + e];
            int i0 = 0; float v0 = sl[0];
#pragma unroll
            for (int e = 1; e < 8; ++e) if (sl[e] > v0) { v0 = sl[e]; i0 = e; }
            int i1 = -1; float v1 = -3.0e38f;
#pragma unroll
            for (int e = 0; e < 8; ++e) if (e != i0 && sl[e] > v1) { v1 = sl[e]; i1 = e; }
            const float e1 = expf(v1 - v0); const float w0 = pg / (1.0f + e1), w1 = pg * e1 / (1.0f + e1);
            if (!(parts & 8)) {
                const int rw = row0 + X.lane_f(), ea = gs * 8 + i0, eb = gs * 8 + i1;
                const unsigned pa = atomicAdd(cnt + ea * 64, 1u), pb = atomicAdd(cnt + eb * 64, 1u);
                lists[(size_t)ea * 65536 + pa] = (unsigned)rw; lists[(size_t)eb * 65536 + pb] = (unsigned)rw;
                slot[rw * 2] = ((unsigned)ea << 20) | pa; slot[rw * 2 + 1] = ((unsigned)eb << 20) | pb;
                wt[rw * 2] = w0; wt[rw * 2 + 1] = w1;
            }
        }
        LDS_WAIT();
    }
}

DI int moe_prefix(const Ctx& X, LAS int* pre) {
    const unsigned* cnt = (const unsigned*)(X.ws + CTL_CNT);
    if (X.tid_f() == 0) { int s = 0; for (int e = 0; e < NE; ++e) { pre[e] = s; s += ((int)__hip_atomic_load(cnt + e * 64, __ATOMIC_RELAXED, __HIP_MEMORY_SCOPE_AGENT) + 255) >> 8; } pre[NE] = s; }
    __syncthreads();
    return pre[NE];
}

DI void phase_final(const Ctx& X) {
    LAS int* pre = (LAS int*)(X.lds + LDS_MISC);
    moe_prefix(X, pre);
    const float* t = (const float*)(X.ws + WS_T); const float* part = (const float*)(X.ws + WS_STAT1);
    const float* mod = (const float*)(X.ws + CTL_MOD);
    const bf16_t* Y = (const bf16_t*)(X.ws + WS_Y);
    const unsigned* slot = (const unsigned*)(X.ws + WS_SLOT); const float* wt = (const float*)(X.ws + WS_WT);
    LAS float* prm = (LAS float*)(X.lds + 1024);
    { __syncthreads();
      for (int i = X.tid_f(); i < D; i += NTHREADS) { prm[i] = X.ln1_g()[i]; prm[D + i] = X.ln1_b()[i]; prm[3 * D + i] = X.ln2_g()[i]; prm[4 * D + i] = X.ln2_b()[i];
#pragma unroll
          for (int bb = 0; bb < 4; ++bb) prm[(5 + bb) * D + i] = 1.0f + mod[(size_t)bb * 6 * D + 5 * D + i]; }
      __syncthreads(); }
    {
#pragma unroll 1
      for (int k8 = 0; k8 < 8; ++k8) {
        const int rowa = 2 * (X.gw + k8 * X.NGW);
        const int b = rowa / SEQ; const LAS float* g2l = prm + (5 + b) * D;
        f32x4 tv[2][8]; u32x2 ya[2][8], yb[2][8]; float w0[2], w1[2], mean[2], rstd[2];
#pragma unroll
        for (int rr = 0; rr < 2; ++rr) {
            const int row = rowa + rr;
            const unsigned s0 = slot[row * 2], s1 = slot[row * 2 + 1]; w0[rr] = wt[row * 2]; w1[rr] = wt[row * 2 + 1];
            const size_t r0 = (size_t)pre[s0 >> 20] * 256 + (s0 & 0xfffffu), r1 = (size_t)pre[s1 >> 20] * 256 + (s1 & 0xfffffu);
            const u32x2* tr = (const u32x2*)((const bf16_t*)t + (size_t)row * D) + X.lane_f();
            const u32x2* y0 = (const u32x2*)(Y + r0 * D) + X.lane_f(); const u32x2* y1 = (const u32x2*)(Y + r1 * D) + X.lane_f();
#pragma unroll
            for (int j = 0; j < 8; ++j) { const u32x2 tw = tr[64 * j]; tv[rr][j] = (f32x4){bflo(tw.x), bfhi(tw.x), bflo(tw.y), bfhi(tw.y)}; ya[rr][j] = y0[64 * j]; yb[rr][j] = y1[64 * j]; }
            float ps = 0.f, pq = 0.f; if (X.lane_f() < 32) { const f32x2 p = *(const f32x2*)(part + ((size_t)row * 32 + X.lane_f()) * 2); ps = p[0]; pq = p[1]; }
            ps = wave_sum(ps); pq = wave_sum(pq);
            mean[rr] = ps * (1.0f / D); const float var = fmaxf(pq * (1.0f / D) - mean[rr] * mean[rr], 0.f); rstd[rr] = 1.0f / sqrtf(var + LN_EPS);
        }
        float s[2] = {0.f, 0.f};
#pragma unroll
        for (int j = 0; j < 8; ++j) {
            const int c = 4 * X.lane_f() + 256 * j;
            const f32x4 gg = *(const LAS f32x4*)(prm + c), bb = *(const LAS f32x4*)(prm + D + c), g2v = *(const LAS f32x4*)(g2l + c);
#pragma unroll
            for (int rr = 0; rr < 2; ++rr) {
                const f32x4 x1 = (tv[rr][j] - mean[rr]) * rstd[rr] * gg + bb;
                const u32x2 a = ya[rr][j], bq = yb[rr][j];
                f32x4 f; f[0] = w0[rr] * bflo(a.x) + w1[rr] * bflo(bq.x); f[1] = w0[rr] * bfhi(a.x) + w1[rr] * bfhi(bq.x); f[2] = w0[rr] * bflo(a.y) + w1[rr] * bflo(bq.y); f[3] = w0[rr] * bfhi(a.y) + w1[rr] * bfhi(bq.y);
                const f32x4 uu = DN_ALPHA * x1 + g2v * f; tv[rr][j] = uu;
                s[rr] += (uu[0] + uu[1]) + (uu[2] + uu[3]);
            }
        }
#pragma unroll
        for (int rr = 0; rr < 2; ++rr) {
            const float m2 = wave_sum(s[rr]) * (1.0f / D); float q = 0.f;
#pragma unroll
            for (int j = 0; j < 8; ++j) { tv[rr][j] = tv[rr][j] - m2; q += (tv[rr][j][0] * tv[rr][j][0] + tv[rr][j][1] * tv[rr][j][1]) + (tv[rr][j][2] * tv[rr][j][2] + tv[rr][j][3] * tv[rr][j][3]); }
            const float rs2 = 1.0f / sqrtf(wave_sum(q) * (1.0f / D) + LN_EPS);
            f32x4* orow = (f32x4*)(X.out + (size_t)(rowa + rr) * D) + X.lane_f();
#pragma unroll
            for (int j = 0; j < 8; ++j) { const int c = 4 * X.lane_f() + 256 * j; __builtin_nontemporal_store(tv[rr][j] * rs2 * *(const LAS f32x4*)(prm + 3 * D + c) + *(const LAS f32x4*)(prm + 4 * D + c), orow + 64 * j); }
        }
      }
    }
}

#define XB_TMO      128
#define XB_XCNT(j)  (256  + 64 * (j))
#define XB_XSUB(j)  (1280 + 64 * (j))
#define XB_XGEN(j)  (2304 + 64 * (j))
#define XB_TOP      3328
#define XB_TOPGEN   3392
#define XCD_BAR_WORDS 3456
#define XB_SPIN_CAP (1u << 22)
DI unsigned xb_ld(unsigned* p)              { return __hip_atomic_load(p, __ATOMIC_RELAXED, __HIP_MEMORY_SCOPE_AGENT); }
DI unsigned xb_add(unsigned* p, unsigned v) { return __hip_atomic_fetch_add(p, v, __ATOMIC_RELAXED, __HIP_MEMORY_SCOPE_AGENT); }
DI unsigned xb_xcc_id() { return (unsigned)__builtin_amdgcn_s_getreg((3 << 11) | 20) & 0xFu; }
#define XB_SPIN(cond, bar) do { unsigned _sp = 0; while (cond) { __builtin_amdgcn_s_sleep(1); \
    if ((++_sp & 255u) == 0u) { if (xb_ld(&(bar)[XB_TMO])) break; if (_sp > XB_SPIN_CAP) { atomicAdd(&(bar)[XB_TMO], 1u); break; } } } } while (0)
struct XcdBarrier { unsigned* bar; unsigned x; volatile LAS unsigned* st; };
DI XcdBarrier xcd_barrier_post(unsigned* bar, volatile LAS unsigned* st, const bool t0) {
    XcdBarrier b; b.bar = bar; b.x = xb_xcc_id(); b.st = st;
    if (t0) (void)xb_add(&bar[XB_XCNT(b.x)], 1u);
    return b;
}
DI void xcd_barrier_complete(unsigned* bar, unsigned x, unsigned& nloc, unsigned& nx) {
    const unsigned G = gridDim.x * gridDim.y * gridDim.z;
    unsigned sum, cnt, mine, sp = 0u;
    for (;;) {
        sum = 0u; cnt = 0u; mine = 0u;
#pragma unroll
        for (unsigned j = 0; j < 16; ++j) { const unsigned c = xb_ld(&bar[XB_XCNT(j)]); sum += c; cnt += (c > 0u) ? 1u : 0u; mine = (j == x) ? c : mine; }
        if (sum == G) break;
        __builtin_amdgcn_s_sleep(1);
        if ((++sp & 255u) == 0u) { if (xb_ld(&bar[XB_TMO])) break; if (sp > XB_SPIN_CAP) { atomicAdd(&bar[XB_TMO], 1u); break; } }
    }
    nloc = mine > 0u ? mine : 1u; nx = cnt > 0u ? cnt : 1u;
}
DI void xcd_barrier(const XcdBarrier& b, const bool t0) {
    asm volatile("s_waitcnt vmcnt(0)" ::: "memory");
    __syncthreads();
    if (t0) {
        unsigned* bar = b.bar;
        __builtin_amdgcn_s_waitcnt(0);
        unsigned nloc = b.st[0], nx = b.st[1];
        if (nloc == 0u) { xcd_barrier_complete(bar, b.x, nloc, nx); b.st[0] = nloc; b.st[1] = nx; }
        const unsigned old = xb_add(&bar[XB_XSUB(b.x)], 1u);
        const unsigned gen = old / nloc;
        if (old + 1u == (gen + 1u) * nloc) {
            __builtin_amdgcn_fence(__ATOMIC_RELEASE, "agent");
            asm volatile("s_waitcnt vmcnt(0)" ::: "memory");
            const unsigned og = xb_add(&bar[XB_TOP], 1u);
            const unsigned tg = og / nx;
            if (og + 1u == (tg + 1u) * nx) xb_add(&bar[XB_TOPGEN], 1u);
            else XB_SPIN(xb_ld(&bar[XB_TOPGEN]) == tg, bar);
            __builtin_amdgcn_fence(__ATOMIC_ACQUIRE, "agent");
            xb_add(&bar[XB_XGEN(b.x)], 1u);
            asm volatile("s_waitcnt vmcnt(0)" ::: "memory");
        } else {
            XB_SPIN(xb_ld(&bar[XB_XGEN(b.x)]) == gen, bar);
            __builtin_amdgcn_fence(__ATOMIC_ACQUIRE, "agent");
            asm volatile("s_waitcnt vmcnt(0)" ::: "memory");
        }
    }
    __syncthreads();
}

__global__ void __launch_bounds__(NTHREADS, 2) fwd_kernel(Args args) {
    extern __shared__ __attribute__((aligned(16))) unsigned char lds_raw[];
    Ctx X;
    X.lds = (LAS unsigned char*)lds_raw;
    X.wave = __builtin_amdgcn_readfirstlane((int)(threadIdx.x >> 6));
    X.G = gridDim.x; { const int bx = blockIdx.x; X.vcu = (X.G % 8 == 0) ? (bx % 8) * (X.G / 8) + bx / 8 : bx; }
    X.gw = X.vcu * NWAVES + X.wave; X.NGW = X.G * NWAVES;
    X.kin = (const void* const*)__builtin_amdgcn_kernarg_segment_ptr();
    X.out = args.out; X.ws = args.ws;
    const int lo = args.ph_lo, hi = args.ph_hi;
    if (args.ph_hi > 1000) cg::this_grid().sync();
    volatile LAS unsigned* bst = (volatile LAS unsigned*)(X.lds + LDS_BYTES - 16);
    if (X.tid_f() < 4) bst[X.tid_f()] = 0u;
    __syncthreads();
    XcdBarrier gbar; gbar.bar = (unsigned*)(X.ws + CTL_BAR); gbar.x = 0; gbar.st = bst;
    if (hi - lo > 1) gbar = xcd_barrier_post((unsigned*)(X.ws + CTL_BAR), bst, X.tid_f() == 0);
#ifndef PH_MASK
#define PH_MASK 0x3ff
#endif
#define IN(k) (((PH_MASK >> (k)) & 1) && lo <= (k) && (k) < hi)
#ifndef DBL_MASK
#define DBL_MASK 0
#endif
#ifndef ATTN_NAIVE
#define ATTN_NAIVE 0
#endif
#ifndef RET_NAIVE
#define RET_NAIVE 0
#endif
#define DBL(k) ((DBL_MASK >> (k)) & 1)
#ifndef USE_CG_SYNC
#define USE_CG_SYNC 0
#endif
#define GSYNC() do { if (USE_CG_SYNC) cg::this_grid().sync(); else xcd_barrier(gbar, X.tid_f() == 0); } while (0)
#define SEAM(k) do { if (IN(k) && IN((k) + 1)) { GSYNC(); } } while (0)

    if (IN(0)) { phase_mod(X); } SEAM(0);
#ifndef P1_PARTS2
#define P1_PARTS2 7
#endif
#define PH1 { phase_pre(X); }
#define PH1B { phase_pre(X, P1_PARTS2); }
#ifndef P2_DBG2
#define P2_DBG2 0
#endif
#define PH2 { pg8::StaticOrder S; S.init(T, NIN, D, X.G, (int)blockIdx.x, X.ws + WS_A, X.ws + WS_WIN); \
        const unsigned* tabA = (const unsigned*)(X.ws + WS_TAB); const unsigned* tabR = tabA + (size_t)T * 16; \
        EpiInProj E{(bf16_t*)(X.ws + WS_B), tabA, tabR, P2DBG}; \
        pg8::gemm_phase<EpiInProj, pg8::StaticOrder, false>(X.lds, D, S, E, X.wave); }
#ifndef P3_ONLY
#define P3_ONLY 3
#endif
#define PH3 { if (!(X.vcu & 1)) { phase_ret_states64(X, X.vcu >> 1); __syncthreads(); } phase_attn(X, 0, 1); }
#ifndef P3_PARTS2
#define P3_PARTS2 3
#endif
#ifndef P3_DBG
#define P3_DBG 0
#endif
#define PH3B PH3
#ifndef P4_DBG
#define P4_DBG 1
#endif
#define PH4 { if (RET_NAIVE) phase_ret_fin_naive(X); else phase_ret_out(X); }
#define PH4B { phase_ret_out(X, P4_DBG); }
#define PH5 { pg8::StaticOrder S; S.init(T, D, D, X.G, (int)blockIdx.x, X.ws + WS_A, X.ws + WS_WOUT); \
        float* mu0 = (float*)(X.ws + WS_STAT0); \
        EpiOutProj E{X.x(), mu0, mu0 + T, X.ln0_g(), X.ln0_b(), (const float*)(X.ws + CTL_MOD), (float*)(X.ws + WS_T), (float*)(X.ws + WS_STAT1)}; \
        pg8::gemm_phase<EpiOutProj, pg8::StaticOrder, false>(X.lds, D, S, E, X.wave); }
#ifndef P6_PARTS2
#define P6_PARTS2 3
#endif
#define PH6 { phase_route(X, 3); }
#define PH6B { phase_route(X, P6_PARTS2); }
#define PH7 { LAS int* pre = (LAS int*)(X.lds + LDS_MISC); \
        const int nmt = moe_prefix(X, pre); \
        MoeOrder S{pre, 4, X.G, X.vcu, nmt * 4, (const char*)(X.ws + WS_H2), (const char*)(X.ws + WS_W13), (size_t)1024 * D * 2, (size_t)256 * D * 2, 0, (const unsigned*)(X.ws + WS_LIST), (const unsigned*)(X.ws + CTL_CNT), true}; \
        EpiMoeUp E{(bf16_t*)(X.ws + WS_A)}; \
        pg8::gemm_phase<EpiMoeUp, MoeOrder, true, true>(X.lds, D, S, E, X.wave); \
        __syncthreads(); phase_w2_copy(X); }
#define PH8 { LAS int* pre = (LAS int*)(X.lds + LDS_MISC); \
        const int nmt = moe_prefix(X, pre); \
        MoeOrder S{pre, 8, X.G, X.vcu, nmt * 8, (const char*)(X.ws + WS_A), (const char*)(X.ws + WS_W2), (size_t)D * FF * 2, (size_t)256 * FF * 2, (size_t)256 * FF * 2, nullptr, (const unsigned*)(X.ws + CTL_CNT), false}; \
        EpiMoeDown E{(bf16_t*)(X.ws + WS_Y)}; \
        pg8::gemm_phase<EpiMoeDown, MoeOrder, false, true>(X.lds, FF, S, E, X.wave); }
#define PH9 { phase_final(X); }
#define RUNPH(k, BODY) if (IN(k)) { BODY; if (DBL(k)) { GSYNC(); BODY; } } SEAM(k);
    if (IN(1)) { PH1; if (DBL(1)) { GSYNC(); PH1B; } } SEAM(1);
    { int P2DBG = 0; if (IN(2)) { PH2; if (DBL(2)) { GSYNC(); P2DBG = P2_DBG2; PH2; } } SEAM(2); }
    if (IN(3)) { PH3; if (DBL(3)) { GSYNC(); PH3B; } } SEAM(3);
    if (IN(4)) { PH4; if (DBL(4)) { GSYNC(); PH4B; } } SEAM(4);
    RUNPH(5, PH5)
    if (IN(6)) { PH6; if (DBL(6)) { GSYNC(); if ((P6_PARTS2 & 10) == 2) { if (X.vcu == 0 && X.tid_f() < NE) ((unsigned*)(X.ws + CTL_CNT))[X.tid_f() * 64] = 0u; GSYNC(); } PH6B; } } SEAM(6);
    RUNPH(7, PH7) RUNPH(8, PH8)
    if (IN(9)) { PH9; if (DBL(9)) { GSYNC(); PH9; } }
#undef IN
#undef SEAM
}

extern "C" void kernel_launch(void* const* d_in, const int* in_sizes, int n_in, void* d_out, int out_size, void* d_ws, size_t ws_size, hipStream_t stream) {
    static int grid = 0;
    if (grid == 0) {
        if (n_in != 22 || in_sizes[0] != T * D || out_size != T * D || ws_size < WS_END) { fprintf(stderr, "kernel_launch: unexpected shapes (n_in %d, in0 %d, out %d, ws %zu)\n", n_in, n_in > 0 ? in_sizes[0] : -1, out_size, ws_size); grid = -1; return; }
        int dev = 0, cus = 0, per_cu = 0;
        hipGetDevice(&dev); hipDeviceGetAttribute(&cus, hipDeviceAttributeMultiprocessorCount, dev);
        hipFuncSetAttribute((const void*)fwd_kernel, hipFuncAttributeMaxDynamicSharedMemorySize, LDS_BYTES);
        hipOccupancyMaxActiveBlocksPerMultiprocessor(&per_cu, (const void*)fwd_kernel, NTHREADS, LDS_BYTES);
        if (per_cu < 1) { fprintf(stderr, "kernel_launch: occupancy query says %d blocks per CU\n", per_cu); per_cu = 1; }
        (void)hipGetLastError();
        grid = cus;
        if (grid != 256) { fprintf(stderr, "kernel_launch: this build's phase 3 work split assumes 256 CUs (8 XCDs x 32); found %d\n", cus); grid = -1; return; }
    }
    if (grid < 0) return;
    hipMemsetAsync((char*)d_ws + WS_CTL, 0, CTL_ZERO_BYTES, stream);
    Args a{};
    for (int i = 0; i < 22; ++i) a.in[i] = d_in[i];
    a.out = (float*)d_out; a.ws = (unsigned char*)d_ws;
#if MK_PER_PHASE_LAUNCH
    for (int p = 0; p < NPHASE; ++p) {
        a.ph_lo = p; a.ph_hi = p + 1;
        hipLaunchKernelGGL(fwd_kernel, dim3(grid), dim3(NTHREADS), LDS_BYTES, stream, a);
    }
#else
    a.ph_lo = 0; a.ph_hi = NPHASE;
    void* kargs[] = {&a};
    hipError_t e = hipLaunchCooperativeKernel((const void*)fwd_kernel, dim3(grid), dim3(NTHREADS), kargs, LDS_BYTES, stream);
    if (e != hipSuccess) fprintf(stderr, "cooperative launch failed: %s (grid %d)\n", hipGetErrorString(e), grid);
#endif
}
```

```cpp
#include <hip/hip_runtime.h>
#include <hip/hip_cooperative_groups.h>
#include <cstdio>
#include <cstdint>
namespace cg = cooperative_groups;

#ifndef MK_PER_PHASE_LAUNCH
#define MK_PER_PHASE_LAUNCH 0
#endif

#define LAS __attribute__((address_space(3)))
#define GAS __attribute__((address_space(1)))
typedef unsigned short bf16_t;
typedef short bf16x8 __attribute__((ext_vector_type(8)));
typedef float f32x4 __attribute__((ext_vector_type(4)));
typedef float f32x2 __attribute__((ext_vector_type(2)));
typedef unsigned u32x4 __attribute__((ext_vector_type(4)));
typedef unsigned u32x2 __attribute__((ext_vector_type(2)));
#define DI __device__ __forceinline__

constexpr int D = 2048, BATCH = 4, SEQ = 8192, T = BATCH * SEQ;
constexpr int AW = 1024, NIN = 7168, AH = 8, RH = 4;
constexpr int NE = 32, FF = 512;
constexpr float LN_EPS = 1e-5f;
constexpr float DN_ALPHA = 1.189207115002721f;
constexpr int NWAVES = 8, NTHREADS = 512;
constexpr int NPHASE = 10;

constexpr size_t MiB = 1u << 20;
constexpr size_t WS_CTL = 0, CTL_ZERO_BYTES = 1 * MiB;
constexpr size_t CTL_BAR = 16 * 1024;
constexpr size_t CTL_MOD = 64 * 1024;
constexpr size_t CTL_CNT = 512 * 1024;
constexpr size_t CTL_WQ = 544 * 1024;
constexpr size_t WS_WIN = 2 * MiB;
constexpr size_t WS_WOUT = 30 * MiB;
constexpr size_t WS_W13 = 38 * MiB;
constexpr size_t WS_W2 = 166 * MiB;
constexpr size_t WS_TAB = 230 * MiB;
constexpr size_t WS_STAT0 = 266 * MiB;
constexpr size_t WS_STAT1 = 267 * MiB;
constexpr size_t WS_SLOT = 275 * MiB;
constexpr size_t WS_WT = WS_SLOT + 256 * 1024;
constexpr size_t WS_LIST = 276 * MiB;
constexpr size_t WS_WR = 284 * MiB;
constexpr size_t WS_A = 288 * MiB;
constexpr size_t WS_B = 416 * MiB;
constexpr size_t WS_T = WS_B, WS_H2 = WS_B + 256 * MiB;
constexpr size_t WS_Y = WS_H2;
constexpr size_t WS_YF = 864 * MiB;
constexpr size_t WS_YB = WS_W13;
constexpr size_t WS_END = 1024 * MiB;

constexpr int LDS_BYTES = 155648;
constexpr int LDS_MISC = 131072;

DI unsigned f2bf(float f) { unsigned u = __float_as_uint(f); return (u + 0x7fffu + ((u >> 16) & 1u)) >> 16; }
typedef __bf16 bf16x2_t __attribute__((ext_vector_type(2)));
DI unsigned cvtpk(float lo, float hi) { f32x2 v = {lo, hi}; bf16x2_t b = __builtin_convertvector(v, bf16x2_t); return __builtin_bit_cast(unsigned, b); }
DI unsigned pk2(float lo, float hi) { return cvtpk(lo, hi); }
DI float bf2f(unsigned h) { return __uint_as_float(h << 16); }
DI float bflo(unsigned w) { return __uint_as_float(w << 16); }
DI float bfhi(unsigned w) { return __uint_as_float(w & 0xffff0000u); }
#define dpp_f(v, ctrl) __int_as_float(__builtin_amdgcn_update_dpp(0, __float_as_int(v), (ctrl), 0xF, 0xF, true))
#define DPP_QP1 0xB1
#define DPP_QP2 0x4E
#define DPP_RHM 0x141
#define DPP_RM  0x140
DI float wave_sum(float v) {
    v += dpp_f(v, DPP_QP1); v += dpp_f(v, DPP_QP2); v += dpp_f(v, DPP_RHM); v += dpp_f(v, DPP_RM);
    const float a = __int_as_float(__builtin_amdgcn_readlane(__float_as_int(v), 0)), b = __int_as_float(__builtin_amdgcn_readlane(__float_as_int(v), 16));
    const float c = __int_as_float(__builtin_amdgcn_readlane(__float_as_int(v), 32)), d = __int_as_float(__builtin_amdgcn_readlane(__float_as_int(v), 48));
    return (a + b) + (c + d);
}
DI float wave_max(float v) {
    v = fmaxf(v, dpp_f(v, DPP_QP1)); v = fmaxf(v, dpp_f(v, DPP_QP2)); v = fmaxf(v, dpp_f(v, DPP_RHM)); v = fmaxf(v, dpp_f(v, DPP_RM));
    const float a = __int_as_float(__builtin_amdgcn_readlane(__float_as_int(v), 0)), b = __int_as_float(__builtin_amdgcn_readlane(__float_as_int(v), 16));
    const float c = __int_as_float(__builtin_amdgcn_readlane(__float_as_int(v), 32)), d = __int_as_float(__builtin_amdgcn_readlane(__float_as_int(v), 48));
    return fmaxf(fmaxf(a, b), fmaxf(c, d));
}
#define LDS_WAIT() asm volatile("s_waitcnt lgkmcnt(0)" ::: "memory")

struct Args { const void* in[22]; float* out; unsigned char* ws; int ph_lo, ph_hi; };

struct Ctx {
    LAS unsigned char* lds;
    int wave, G, vcu, gw, NGW;
    const void* const* kin;
    DI int lane_f() const { int l; asm volatile("v_mbcnt_lo_u32_b32 %0, -1, 0\n\tv_mbcnt_hi_u32_b32 %0, -1, %0" : "=v"(l)); return l; }
    DI int tid_f() const { return wave * 64 + lane_f(); }
    float* out; unsigned char* ws;
    DI const float* x() const { return (const float*)kin[0]; }
    DI const float* c() const { return (const float*)kin[1]; }
    DI const int* positions() const { return (const int*)kin[2]; }
    DI const float* ln0_g() const { return (const float*)kin[3]; }
    DI const float* ln0_b() const { return (const float*)kin[4]; }
    DI const float* w_ada() const { return (const float*)kin[5]; }
    DI const float* b_ada() const { return (const float*)kin[6]; }
    DI const float* w_in() const { return (const float*)kin[7]; }
    DI const float* w_out() const { return (const float*)kin[8]; }
    DI const float* ldf() const { return (const float*)kin[9]; }
    DI const float* ldb() const { return (const float*)kin[10]; }
    DI const float* ln1_g() const { return (const float*)kin[11]; }
    DI const float* ln1_b() const { return (const float*)kin[12]; }
    DI const float* w_group() const { return (const float*)kin[13]; }
    DI const float* b_group() const { return (const float*)kin[14]; }
    DI const float* w_sub() const { return (const float*)kin[15]; }
    DI const float* b_sub() const { return (const float*)kin[16]; }
    DI const float* w1() const { return (const float*)kin[17]; }
    DI const float* w3() const { return (const float*)kin[18]; }
    DI const float* w2() const { return (const float*)kin[19]; }
    DI const float* ln2_g() const { return (const float*)kin[20]; }
    DI const float* ln2_b() const { return (const float*)kin[21]; }
};

namespace pg8 {
constexpr int BM = 256, BK = 64, HALF = 128, HTB = HALF * BK * 2, STAGE_BYTES = 8 * HTB, NXCD = 8, WGM = 8;
__host__ __device__ __forceinline__ int lds_byte(int r, int c) { const int st = (r >> 4) * 2 + (c >> 5), rr = r & 15, cc = c & 31, ob = rr * 64 + cc * 2; return st * 1024 + (ob ^ (((ob >> 9) & 1) << 5)); }
__host__ __device__ __forceinline__ void stage_rc(int b, int& R, int& C) { const int st = b / 1024, sb = b % 1024, swz = sb ^ (((sb >> 9) & 1) << 5); R = (st >> 1) * 16 + swz / 64; C = (st & 1) * 32 + (swz % 64) / 2; }

struct Unit { const char* A; const char* B; const unsigned* rows; int nrows; int pm, pn, e; };

struct StaticOrder {
    int nM, nN, nwg, G, c; const char* A; const char* B; size_t tstepA, tstepB;
    DI void init(int M, int N, int K, int G_, int c_, const void* A_, const void* B_) { nM = M / BM; nN = N / BM; nwg = nM * nN; G = G_; c = c_; A = (const char*)A_; B = (const char*)B_; tstepA = (size_t)BM * K * 2; tstepB = (size_t)BM * K * 2; }
    DI bool next(int i, Unit& u) const {
        const long L = (long)i * G + c; if (L >= nwg) return false;
        int wgid = (int)L; { const int q = nwg / NXCD, r = nwg % NXCD, xcd = wgid % NXCD, off = wgid / NXCD; wgid = (xcd < r ? xcd * (q + 1) : r * (q + 1) + (xcd - r) * q) + off; }
        const int nig = WGM * nN, gid = wgid / nig, fm = gid * WGM, gsz = (nM - fm) < WGM ? (nM - fm) : WGM;
        u.pm = fm + ((wgid % nig) % gsz); u.pn = (wgid % nig) / gsz; u.e = 0; u.rows = nullptr; u.nrows = 0;
        u.A = A + (size_t)u.pm * tstepA; u.B = B + (size_t)u.pn * tstepB; return true;
    }
};

DI unsigned cvt_pk_bf16(float lo, float hi) { unsigned r; asm volatile("v_cvt_pk_bf16_f32 %0, %1, %2" : "=v"(r) : "v"(lo), "v"(hi)); return r; }

__host__ __device__ __forceinline__ int perm32(int rho) { const int n = rho >> 4, i = rho & 15; return 8 * (i >> 2) + 4 * n + (i & 3); }
template <class Epi, class Sched, bool GATHER, bool PERM = false>
DI void gemm_phase(LAS unsigned char* lds, const int K, const Sched& S, const Epi& E, const int wid) {
    int lane; asm volatile("v_mbcnt_lo_u32_b32 %0, -1, 0\n\tv_mbcnt_hi_u32_b32 %0, -1, %0" : "=v"(lane));
    const int tid = wid * 64 + lane, wr = wid >> 2, wc = wid & 3, fr = lane & 15, fq = lane >> 4;
    const int nt = K / BK;
    int Rr[2], Cc[2];
    unsigned voffB[2], voffN[2], vA0[2], vA1[2], nA0[2], nA1[2];
#pragma unroll
    for (int i = 0; i < 2; ++i) { stage_rc(tid * 16 + i * 8192, Rr[i], Cc[i]); voffN[i] = (unsigned)(Rr[i] * K + Cc[i]) * 2u; const int Rb = PERM ? ((Rr[i] & ~31) + perm32(Rr[i] & 31)) : Rr[i]; voffB[i] = (unsigned)(Rb * K + Cc[i]) * 2u; }
    const size_t kstep = (size_t)(BK * 2);
    const size_t hstep = (size_t)HALF * K * 2;
    const unsigned ldsw = (unsigned)wid * 1024u;
    const int aoff = lds_byte(wr * 64 + fr, fq * 8), boff = lds_byte(wc * 32 + fr, fq * 8);
#define PG8_SA(b, h) (((b) * 2 + (h)) * HTB)
#define PG8_SB(b, h) ((4 + (b) * 2 + (h)) * HTB)
#define PG8_STAGE(bufoff, gbase, voff) do { _Pragma("unroll") for (int _i = 0; _i < 2; ++_i) \
        __builtin_amdgcn_global_load_lds((const unsigned*)((const char*)(gbase) + (voff)[_i]), (LAS unsigned*)(lds + (bufoff) + ldsw + _i * 8192), 16, 0, 0); } while (0)
#define PG8_LDA(dst, b, h) do { _Pragma("unroll") for (int m = 0; m < 4; ++m) _Pragma("unroll") for (int k = 0; k < 2; ++k) dst[m][k] = *(const LAS bf16x8*)(lds + PG8_SA(b, h) + aoff + m * 2048 + k * 1024); } while (0)
#define PG8_LDB(dst, b, h) do { _Pragma("unroll") for (int n = 0; n < 2; ++n) _Pragma("unroll") for (int k = 0; k < 2; ++k) dst[n][k] = *(const LAS bf16x8*)(lds + PG8_SB(b, h) + boff + n * 2048 + k * 1024); } while (0)
#define PG8_MMA(ai, bj, At, Bt) do { __builtin_amdgcn_s_setprio(1); _Pragma("unroll") for (int m = 0; m < 4; ++m) _Pragma("unroll") for (int n = 0; n < 2; ++n) _Pragma("unroll") for (int k = 0; k < 2; ++k) \
        acc[ai][bj][m][n] = __builtin_amdgcn_mfma_f32_16x16x32_bf16(Bt[n][k], At[m][k], acc[ai][bj][m][n], 0, 0, 0); __builtin_amdgcn_s_setprio(0); } while (0)
#define PG8_STAGE_A(bufoff, gbase, half_, vo0, vo1) do { if constexpr (GATHER) { if ((half_) == 0) PG8_STAGE(bufoff, gbase, vo0); else PG8_STAGE(bufoff, gbase, vo1); } else { PG8_STAGE(bufoff, (gbase) + ((half_) ? hstep : 0), voffN); } } while (0)
#define PG8_WAIT_V(n) asm volatile("s_waitcnt vmcnt(" #n ")" ::: "memory")
#define PG8_WAIT_L(n) asm volatile("s_waitcnt lgkmcnt(" #n ")" ::: "memory")
#define PG8_BAR __builtin_amdgcn_s_barrier()
#define PG8_SCHED __builtin_amdgcn_sched_barrier(0)
#define PG8_AOFFS(u, o0, o1) do { _Pragma("unroll") for (int _i = 0; _i < 2; ++_i) { \
        if constexpr (GATHER) { const int r0 = Rr[_i], r1 = Rr[_i] + HALF; \
            const unsigned t0 = r0 < (u).nrows ? (u).rows[r0] : 0u, t1 = r1 < (u).nrows ? (u).rows[r1] : 0u; \
            o0[_i] = (t0 * (unsigned)K + (unsigned)Cc[_i]) * 2u; o1[_i] = (t1 * (unsigned)K + (unsigned)Cc[_i]) * 2u; } \
        else { o0[_i] = voffN[_i]; o1[_i] = voffN[_i] + (unsigned)hstep; } } } while (0)
    Unit cur, nxt; int ui = 0;
    if (!S.next(0, cur)) return;
    f32x4 acc[2][2][4][2];
#pragma unroll
    for (int a = 0; a < 2; ++a)
#pragma unroll
        for (int b = 0; b < 2; ++b)
#pragma unroll
            for (int m = 0; m < 4; ++m)
#pragma unroll
                for (int n = 0; n < 2; ++n) acc[a][b][m][n] = (f32x4){0.f, 0.f, 0.f, 0.f};
    bf16x8 At[4][2], B0[2][2], B1[2][2];
    const char* cA = cur.A; const char* cB = cur.B;
    if constexpr (GATHER) { PG8_AOFFS(cur, vA0, vA1); }
    PG8_STAGE(PG8_SB(0, 0), cB, voffB); PG8_STAGE(PG8_SB(0, 1), cB + hstep, voffB); PG8_STAGE_A(PG8_SA(0, 0), cA, 0, vA0, vA1); PG8_STAGE_A(PG8_SA(0, 1), cA, 1, vA0, vA1);
    if (wr == 1) PG8_BAR;
    PG8_WAIT_V(2); PG8_BAR;
    PG8_STAGE(PG8_SB(1, 0), cB + kstep, voffB); PG8_STAGE_A(PG8_SA(1, 0), cA + kstep, 0, vA0, vA1); PG8_STAGE(PG8_SB(1, 1), cB + hstep + kstep, voffB);
    PG8_WAIT_V(6); PG8_BAR;
    for (;;) {
        const bool has_next = S.next(ui + 1, nxt);
        const char* nA = has_next ? nxt.A : cA; const char* nB = has_next ? nxt.B : cB;
        if constexpr (GATHER) { if (has_next) { PG8_AOFFS(nxt, nA0, nA1); } else {
#pragma unroll
            for (int i = 0; i < 2; ++i) { nA0[i] = vA0[i]; nA1[i] = vA1[i]; } } }
        for (int t = 0; t < nt; t += 2) {
            const bool last = (t == nt - 2);
            const char* a1 = cA + (size_t)(t + 1) * kstep;
            const char* a2 = last ? nA : cA + (size_t)(t + 2) * kstep; const char* b2 = last ? nB : cB + (size_t)(t + 2) * kstep;
            const char* a3 = a2 + kstep; const char* b3 = b2 + kstep;
            unsigned u0[2], u1[2];
            if constexpr (GATHER) {
#pragma unroll
            for (int i = 0; i < 2; ++i) { u0[i] = last ? nA0[i] : vA0[i]; u1[i] = last ? nA1[i] : vA1[i]; } }
            PG8_LDB(B0, 0, 0); PG8_LDB(B1, 0, 1); PG8_SCHED; PG8_LDA(At, 0, 0); PG8_STAGE_A(PG8_SA(1, 1), a1, 1, vA0, vA1);
            PG8_WAIT_V(8); PG8_WAIT_L(0); PG8_BAR; PG8_MMA(0, 0, At, B0); PG8_MMA(0, 1, At, B1); PG8_BAR; PG8_SCHED;
            PG8_LDA(At, 0, 1); PG8_STAGE(PG8_SB(0, 0), b2, voffB); PG8_STAGE(PG8_SB(0, 1), b2 + hstep, voffB); PG8_STAGE_A(PG8_SA(0, 0), a2, 0, u0, u1);
            PG8_WAIT_V(8); PG8_WAIT_L(0); PG8_BAR; PG8_MMA(1, 0, At, B0); PG8_MMA(1, 1, At, B1); PG8_BAR; PG8_SCHED;
            PG8_LDB(B0, 1, 0); PG8_LDB(B1, 1, 1); PG8_SCHED; PG8_LDA(At, 1, 0); PG8_STAGE_A(PG8_SA(0, 1), a2, 1, u0, u1);
            PG8_WAIT_V(8); PG8_WAIT_L(0); PG8_BAR; PG8_MMA(0, 0, At, B0); PG8_MMA(0, 1, At, B1); PG8_BAR; PG8_SCHED;
            PG8_LDA(At, 1, 1); PG8_STAGE(PG8_SB(1, 0), b3, voffB); PG8_STAGE(PG8_SB(1, 1), b3 + hstep, voffB); PG8_STAGE_A(PG8_SA(1, 0), a3, 0, u0, u1);
            PG8_WAIT_V(8); PG8_WAIT_L(0); PG8_BAR; PG8_MMA(1, 0, At, B0); PG8_MMA(1, 1, At, B1); PG8_BAR; PG8_SCHED;
        }
        if (wr == 0) PG8_BAR;
        E(acc, cur, wr, wc, fr, fq, lds, lane);
        if (!has_next) break;
#pragma unroll
        for (int a = 0; a < 2; ++a)
#pragma unroll
            for (int b = 0; b < 2; ++b)
#pragma unroll
                for (int m = 0; m < 4; ++m)
#pragma unroll
                    for (int n = 0; n < 2; ++n) acc[a][b][m][n] = (f32x4){0.f, 0.f, 0.f, 0.f};
        cur = nxt; cA = nA; cB = nB; ++ui;
        if constexpr (GATHER) {
#pragma unroll
        for (int i = 0; i < 2; ++i) { vA0[i] = nA0[i]; vA1[i] = nA1[i]; } }
        if (wr == 1) PG8_BAR;
    }
    PG8_WAIT_V(0);
    PG8_BAR;
#undef PG8_SA
#undef PG8_SB
#undef PG8_STAGE
#undef PG8_STAGE_A
#undef PG8_LDA
#undef PG8_LDB
#undef PG8_MMA
#undef PG8_WAIT_V
#undef PG8_WAIT_L
#undef PG8_BAR
#undef PG8_SCHED
#undef PG8_AOFFS
}
}

constexpr int EPI_STG = 3 * 16384;
constexpr int EPI_STG2 = 131072 + 1024;
#define EPI_BAR() do { asm volatile("s_waitcnt lgkmcnt(0)" ::: "memory"); __builtin_amdgcn_s_barrier(); asm volatile("" ::: "memory"); } while (0)
DI void stg_rows_out(LAS unsigned char* R, unsigned char* grow0, size_t row_bytes, int wc, int lane) {
#pragma unroll
    for (int i = 0; i < 2; ++i) { const int row = 4 * wc + 2 * i + (lane >> 5), ch = lane & 31;
        const u32x4 v = *(const LAS u32x4*)(R + row * 512 + ((ch ^ (row & 7)) << 4));
        __builtin_nontemporal_store(v, (u32x4*)(grow0 + (size_t)row * row_bytes + ch * 16)); }
}
DI float h2f_lo(unsigned w) { return (float)__builtin_bit_cast(_Float16, (unsigned short)(w & 0xffffu)); }
DI float h2f_hi(unsigned w) { return (float)__builtin_bit_cast(_Float16, (unsigned short)(w >> 16)); }
DI unsigned pack_h2(float lo, float hi) { return (unsigned)__builtin_bit_cast(unsigned short, (_Float16)lo) | ((unsigned)__builtin_bit_cast(unsigned short, (_Float16)hi) << 16); }
struct EpiInProj {
    bf16_t* z; const unsigned* tabA; const unsigned* tabR; int dbg;
    DI void operator()(f32x4 (&acc)[2][2][4][2], const pg8::Unit& u, int wr, int wc, int fr, int fq, LAS unsigned char* lds, int lane) const {
        if (dbg == 2) {
#pragma unroll
            for (int a = 0; a < 2; ++a)
#pragma unroll
                for (int b = 0; b < 2; ++b)
#pragma unroll
                    for (int m = 0; m < 4; ++m)
#pragma unroll
                        for (int n = 0; n < 2; ++n) asm volatile("" :: "v"(acc[a][b][m][n]));
            return; }
        const int seg = (u.pn >> 2), colt = (u.pn & 3) * 256;
        bf16_t* zs = z + (size_t)seg * T * 1024;
        const float scale = (seg == 0) ? 0.08838834764831845f : (seg == 4 ? 0.0625f : 1.0f);
        const int row0 = u.pm * 256 + wr * 64 + fr;
        bf16_t* zp = zs + (size_t)row0 * 1024 + colt + wc * 32 + fq * 4;
        LAS unsigned char* R = lds + EPI_STG + wr * 8192;
#define EIP_STORE(ai_, m_, v00, v01, v10, v11) do { \
            { const f32x4 o = (v00) * scale; u32x2 w; w.x = pk2(o[0], o[1]); w.y = pk2(o[2], o[3]); *(LAS u32x2*)(R + fr * 512 + (((wc * 4 + (fq >> 1)) ^ (fr & 7)) << 4) + (fq & 1) * 8) = w; } \
            { const f32x4 o = (v01) * scale; u32x2 w; w.x = pk2(o[0], o[1]); w.y = pk2(o[2], o[3]); *(LAS u32x2*)(R + fr * 512 + (((wc * 4 + 2 + (fq >> 1)) ^ (fr & 7)) << 4) + (fq & 1) * 8) = w; } \
            { const f32x4 o = (v10) * scale; u32x2 w; w.x = pk2(o[0], o[1]); w.y = pk2(o[2], o[3]); *(LAS u32x2*)(R + fr * 512 + (((16 + wc * 4 + (fq >> 1)) ^ (fr & 7)) << 4) + (fq & 1) * 8) = w; } \
            { const f32x4 o = (v11) * scale; u32x2 w; w.x = pk2(o[0], o[1]); w.y = pk2(o[2], o[3]); *(LAS u32x2*)(R + fr * 512 + (((16 + wc * 4 + 2 + (fq >> 1)) ^ (fr & 7)) << 4) + (fq & 1) * 8) = w; } \
            EPI_BAR(); \
            stg_rows_out(R, (unsigned char*)(zs + (size_t)(u.pm * 256 + wr * 64 + (ai_) * 128 + (m_) * 16) * 1024 + colt), 2048, wc, lane); \
            EPI_BAR(); } while (0)
        if (seg == 3 || seg == 4) {
            const unsigned* tp = tabR + (size_t)row0 * 128 + wc * 32 + fq * 4;
            u32x4 tv[2][2];
            tv[0][0] = *(const u32x4*)(tp); tv[0][1] = *(const u32x4*)(tp + 16);
#pragma unroll
            for (int g = 0; g < 8; ++g) { const int ai = g >> 2, m = g & 3;
                if (g < 7) { const unsigned* tn = tp + (size_t)(((g + 1) >> 2) * 128 + ((g + 1) & 3) * 16) * 128; tv[(g + 1) & 1][0] = *(const u32x4*)(tn); tv[(g + 1) & 1][1] = *(const u32x4*)(tn + 16); }
                f32x4 r0[2], r1[2];
#pragma unroll
                for (int n = 0; n < 2; ++n) { const u32x4 tw = tv[g & 1][n];
                    const f32x4 cs = {h2f_lo(tw.x), h2f_lo(tw.y), h2f_lo(tw.z), h2f_lo(tw.w)}, sn = {h2f_hi(tw.x), h2f_hi(tw.y), h2f_hi(tw.z), h2f_hi(tw.w)};
                    const f32x4 x1 = acc[ai][0][m][n], x2 = acc[ai][1][m][n]; r0[n] = x1 * cs - x2 * sn; r1[n] = x2 * cs + x1 * sn; }
                if (dbg != 3) EIP_STORE(ai, m, r0[0], r0[1], r1[0], r1[1]);
            }
        } else if (seg <= 1 && wc == 0) {
            const unsigned* tp = tabA + (size_t)row0 * 16 + fq * 4;
            u32x4 tv[8];
#pragma unroll
            for (int g = 0; g < 8; ++g) tv[g] = *(const u32x4*)(tp + (size_t)((g >> 2) * 128 + (g & 3) * 16) * 16);
#pragma unroll
            for (int g = 0; g < 8; ++g) { const int ai = g >> 2, m = g & 3; const u32x4 tw = tv[g];
                const f32x4 cs = {h2f_lo(tw.x), h2f_lo(tw.y), h2f_lo(tw.z), h2f_lo(tw.w)}, sn = {h2f_hi(tw.x), h2f_hi(tw.y), h2f_hi(tw.z), h2f_hi(tw.w)};
                const f32x4 a1 = acc[ai][0][m][0], a2 = acc[ai][0][m][1], b1 = acc[ai][1][m][0], b2 = acc[ai][1][m][1];
                if (dbg != 3) EIP_STORE(ai, m, a1 * cs - a2 * sn, a2 * cs + a1 * sn, b1 * cs - b2 * sn, b2 * cs + b1 * sn);
            }
        } else {
#pragma unroll
            for (int g = 0; g < 8; ++g) { const int ai = g >> 2, m = g & 3;
                if (dbg != 3) EIP_STORE(ai, m, acc[ai][0][m][0], acc[ai][0][m][1], acc[ai][1][m][0], acc[ai][1][m][1]); }
        }
#undef EIP_STORE
    }
};

struct EpiOutProj {
    const float* x; const float* mu0; const float* rstd0; const float* g0; const float* b0; const float* mod; float* t; float* part;
    DI void operator()(f32x4 (&acc)[2][2][4][2], const pg8::Unit& u, int wr, int wc, int fr, int fq, LAS unsigned char* lds, int lane) const {
        const int col0 = u.pn * 256 + wc * 32 + fq * 8;
        const int b = (u.pm * 256) / SEQ;
        const float* g1 = mod + (size_t)b * 6 * D + 2 * D;
        const int row0 = u.pm * 256 + wr * 64 + fr;
        f32x4 pa[2][2];
#pragma unroll
        for (int bj = 0; bj < 2; ++bj)
#pragma unroll
            for (int n = 0; n < 2; ++n) { const int c = col0 + bj * 128 + n * 4;
                pa[bj][n] = DN_ALPHA * *(const f32x4*)(g0 + c); const f32x4 pb = DN_ALPHA * *(const f32x4*)(b0 + c); const f32x4 pc = 1.0f + *(const f32x4*)(g1 + c);
#pragma unroll
                for (int ai = 0; ai < 2; ++ai)
#pragma unroll
                    for (int m = 0; m < 4; ++m) acc[ai][bj][m][n] = acc[ai][bj][m][n] * pc + pb; }
        f32x4 xv[3][2]; float mu[2], rs[2], ss = 0.f, qq = 0.f;
#define EOP_LD(k_) do { const int gn = (k_) >> 1, bn = (k_) & 1; const int rn = row0 + (gn >> 2) * 128 + (gn & 3) * 16; const float* xp = (const float*)((const char*)x + (unsigned)(rn * D + col0 + bn * 128) * 4u); \
            if (bn == 0) { mu[gn & 1] = mu0[rn]; rs[gn & 1] = rstd0[rn]; } \
            xv[(k_) % 3][0] = *(const f32x4*)(xp); xv[(k_) % 3][1] = *(const f32x4*)(xp + 4); } while (0)
        EOP_LD(0); EOP_LD(1);
#pragma unroll
        for (int k = 0; k < 16; ++k) { const int g = k >> 1, bj = k & 1, ai = g >> 2, m = g & 3; const int row = row0 + ai * 128 + m * 16;
            if (k < 14) EOP_LD(k + 2);
            bf16_t* tp = (bf16_t*)((char*)t + (unsigned)(row * D + col0 + bj * 128) * 2u);
            u32x4 w;
#pragma unroll
            for (int n = 0; n < 2; ++n) {
                const f32x4 o = (xv[k % 3][n] - mu[g & 1]) * rs[g & 1] * pa[bj][n] + acc[ai][bj][m][n];
                if (n == 0) { w.x = pk2(o[0], o[1]); w.y = pk2(o[2], o[3]); } else { w.z = pk2(o[0], o[1]); w.w = pk2(o[2], o[3]); }
                ss += (o[0] + o[1]) + (o[2] + o[3]); qq += (o[0] * o[0] + o[1] * o[1]) + (o[2] * o[2] + o[3] * o[3]); }
            __builtin_nontemporal_store(w, (u32x4*)tp);
            if (bj == 1) {
                ss += __shfl_xor(ss, 16); ss += __shfl_xor(ss, 32); qq += __shfl_xor(qq, 16); qq += __shfl_xor(qq, 32);
                if (fq == 0) *(f32x2*)((char*)part + (unsigned)(row * 32 + u.pn * 4 + wc) * 8u) = (f32x2){ss, qq};
                ss = 0.f; qq = 0.f; }
        }
#undef EOP_LD
    }
};

struct EpiMoeUp {
    bf16_t* act;
    DI void operator()(f32x4 (&acc)[2][2][4][2], const pg8::Unit& u, int wr, int wc, int fr, int fq, LAS unsigned char* lds, int lane) const {
#pragma unroll
        for (int ai = 0; ai < 2; ++ai)
#pragma unroll
            for (int mh = 0; mh < 2; ++mh) {
                LAS unsigned char* R = lds + (mh ? EPI_STG2 : EPI_STG) + wr * 8192;
#pragma unroll
                for (int mm = 0; mm < 2; ++mm) { const int m = 2 * mh + mm, r = mm * 16 + fr;
                    f32x4 o[2];
#pragma unroll
                    for (int n = 0; n < 2; ++n) { const f32x4 g = acc[ai][0][m][n], up = acc[ai][1][m][n];
#pragma unroll
                        for (int j = 0; j < 4; ++j) o[n][j] = g[j] / (1.0f + __expf(-g[j])) * up[j]; }
                    u32x4 w; w.x = pk2(o[0][0], o[0][1]); w.y = pk2(o[0][2], o[0][3]); w.z = pk2(o[1][0], o[1][1]); w.w = pk2(o[1][2], o[1][3]);
                    *(LAS u32x4*)(R + r * 256 + (((wc * 4 + fq) ^ (r & 15)) << 4)) = w; }
                EPI_BAR();
#pragma unroll
                for (int i = 0; i < 2; ++i) { const int r = 8 * wc + 4 * i + (lane >> 4), ch = lane & 15;
                    const u32x4 v = *(const LAS u32x4*)(R + r * 256 + ((ch ^ (r & 15)) << 4));
                    const int grow = u.pm * 256 + wr * 64 + ai * 128 + mh * 32 + r;
                    __builtin_nontemporal_store(v, (u32x4*)(act + (size_t)grow * FF + u.pn * 128 + ch * 8)); }
            }
        EPI_BAR();
    }
};
struct EpiMoeDown {
    bf16_t* Y;
    DI void operator()(f32x4 (&acc)[2][2][4][2], const pg8::Unit& u, int wr, int wc, int fr, int fq, LAS unsigned char* lds, int lane) const {
#pragma unroll
        for (int ai = 0; ai < 2; ++ai)
#pragma unroll
            for (int m = 0; m < 4; ++m) {
                LAS unsigned char* R = lds + ((m & 1) ? EPI_STG2 : EPI_STG) + wr * 8192;
#pragma unroll
                for (int bj = 0; bj < 2; ++bj) { const f32x4 a = acc[ai][bj][m][0], b = acc[ai][bj][m][1];
                    u32x4 w; w.x = pk2(a[0], a[1]); w.y = pk2(a[2], a[3]); w.z = pk2(b[0], b[1]); w.w = pk2(b[2], b[3]);
                    *(LAS u32x4*)(R + fr * 512 + (((bj * 16 + wc * 4 + fq) ^ (fr & 7)) << 4)) = w; }
                EPI_BAR();
                stg_rows_out(R, (unsigned char*)(Y + (size_t)(u.pm * 256 + wr * 64 + ai * 128 + m * 16) * D + u.pn * 256), (size_t)D * 2, wc, lane);
            }
        EPI_BAR();
    }
};

struct MoeOrder {
    const LAS int* pre; int NT, G, c, total; const char* A; const char* Bw; size_t bstride_e, tstepB, tstepA; const unsigned* lists; const unsigned* cnt; bool gather;
    DI bool next(int i, pg8::Unit& u) const {
        const long L = (long)i * G + c; if (L >= total) return false;
        const int mt = (int)(L / NT), nt = (int)(L % NT);
        int e = 0;
#pragma unroll 1
        for (int k = 1; k < NE; ++k) e += (pre[k] <= mt) ? 1 : 0;
        const int lm = mt - pre[e];
        u.pm = mt; u.pn = nt; u.e = e;
        u.B = Bw + (size_t)e * bstride_e + (size_t)nt * tstepB;
        if (gather) { u.A = A; u.rows = lists + (size_t)e * 65536 + lm * 256; const int cn = (int)cnt[e * 64] - lm * 256; u.nrows = cn < 256 ? cn : 256; }
        else { u.A = A + (size_t)mt * tstepA; u.rows = nullptr; u.nrows = 0; }
        return true;
    }
};

DI void phase_mod(const Ctx& X) {
    float* mod = (float*)(X.ws + CTL_MOD);
    LAS float* ps = (LAS float*)X.lds;
    LAS float* cs = (LAS float*)(X.lds + 16384);
    const int lane = X.lane_f();
    for (int i = X.tid_f(); i < 4 * D; i += NTHREADS) { const float cv = X.c()[i]; cs[i] = cv / (1.0f + expf(-cv)); }
    __syncthreads();
    for (int cgp = X.vcu; cgp < 96; cgp += X.G) {
        const float* W = X.w_ada() + (size_t)(X.wave * 256) * (6 * D) + cgp * 128 + lane * 2;
        f32x2 acc[4];
#pragma unroll
        for (int b = 0; b < 4; ++b) acc[b] = (f32x2){0.f, 0.f};
#pragma unroll 1
        for (int k0 = 0; k0 < 256; k0 += 16) {
            f32x2 wv[16];
#pragma unroll
            for (int kk = 0; kk < 16; ++kk) wv[kk] = *(const f32x2*)(W + (size_t)(k0 + kk) * (6 * D));
#pragma unroll
            for (int kk = 0; kk < 16; ++kk)
#pragma unroll
                for (int b = 0; b < 4; ++b) acc[b] += cs[b * D + X.wave * 256 + k0 + kk] * wv[kk];
        }
#pragma unroll
        for (int b = 0; b < 4; ++b) *(LAS f32x2*)(ps + (X.wave * 4 + b) * 128 + lane * 2) = acc[b];
        __syncthreads();
        { const int o = X.tid_f();
          float sum = X.b_ada()[cgp * 128 + (o & 127)];
#pragma unroll
          for (int w8 = 0; w8 < 8; ++w8) sum += ps[(w8 * 4 + (o >> 7)) * 128 + (o & 127)];
          mod[(size_t)(o >> 7) * 6 * D + cgp * 128 + (o & 127)] = sum; }
        __syncthreads();
    }
}

constexpr int TR_SCR = 16896;
template <class RowMap>
DI void transpose_item(const float* W, int K, int N, bf16_t* WT, const RowMap& rm, LAS float* scr, int item, int lane) {
    const int nblk = N / 64, kb = item / nblk, nb = item % nblk, k0 = 64 * kb, n0 = 64 * nb;
    f32x4 v[16];
#pragma unroll
    for (int r = 0; r < 16; ++r) v[r] = *(const f32x4*)(W + (size_t)(k0 + 4 * r + (lane >> 4)) * N + n0 + 4 * (lane & 15));
#pragma unroll
    for (int r = 0; r < 16; ++r) { LAS float* d = scr + (4 * r + (lane >> 4)) * 65 + 4 * (lane & 15); d[0] = v[r][0]; d[1] = v[r][1]; d[2] = v[r][2]; d[3] = v[r][3]; }
    LDS_WAIT();
    const int c = lane & 7;
#pragma unroll
    for (int j = 0; j < 8; ++j) { const int n = (lane >> 3) + 8 * j; const LAS float* sp = scr + (8 * c) * 65 + n;
        u32x4 o; o.x = pk2(sp[0 * 65], sp[1 * 65]); o.y = pk2(sp[2 * 65], sp[3 * 65]); o.z = pk2(sp[4 * 65], sp[5 * 65]); o.w = pk2(sp[6 * 65], sp[7 * 65]);
        *(u32x4*)(WT + (size_t)rm(n0 + n) * K + k0 + 8 * c) = o; }
    LDS_WAIT();
}
struct RowId { DI int operator()(int n) const { return n; } };
struct RowPerm32 { DI int operator()(int n) const { return (n & ~31) + 16 * ((n >> 2) & 1) + 4 * ((n >> 3) & 3) + (n & 3); } };
struct RowGate { int up; DI int operator()(int n) const { return (n >> 7) * 256 + up * 128 + (n & 127); } };

DI void sincos_f(float a, float& c, float& s) {
    const float k = rintf(a * 0.636619772f);
    float r = fmaf(-k, 1.5707855225e+00f, a); r = fmaf(-k, 1.0804334124e-05f, r);
    const float r2 = r * r;
    const float sn = fmaf(r * r2, fmaf(r2, fmaf(r2, fmaf(r2, 2.7557319e-6f, -1.9841270e-4f), 8.3333333e-3f), -1.6666667e-1f), r);
    const float cn = fmaf(r2 * r2, fmaf(r2, fmaf(r2, 2.4801587e-5f, -1.3888889e-3f), 4.1666667e-2f), fmaf(r2, -0.5f, 1.0f));
    const int qq = ((int)k) & 3;
    float so, co;
    if (qq == 0) { so = sn; co = cn; } else if (qq == 1) { so = cn; co = -sn; } else if (qq == 2) { so = -sn; co = -cn; } else { so = -cn; co = sn; }
    c = co; s = so;
}
DI void sincos_d(float angf, float& c, float& s) {
    const double a = (double)angf;
    const double k = rint(a * 0.63661977236758134308);
    double r = a - k * 1.57079632673412561417e+00; r -= k * 6.07710050650619224932e-11;
    const double r2 = r * r;
    double sp = -1.0 / 6227020800.0; sp = sp * r2 + 1.0 / 39916800.0; sp = sp * r2 - 1.0 / 362880.0; sp = sp * r2 + 1.0 / 5040.0; sp = sp * r2 - 1.0 / 120.0; sp = sp * r2 + 1.0 / 6.0;
    const double sn = r - r * r2 * sp;
    double cp = -1.0 / 87178291200.0; cp = cp * r2 + 1.0 / 479001600.0; cp = cp * r2 - 1.0 / 3628800.0; cp = cp * r2 + 1.0 / 40320.0; cp = cp * r2 - 1.0 / 720.0; cp = cp * r2 + 1.0 / 24.0;
    const double cn = 1.0 - 0.5 * r2 + r2 * r2 * cp;
    const long long q = (long long)k; const int qq = (int)(q & 3);
    double so, co;
    if (qq == 0) { so = sn; co = cn; } else if (qq == 1) { so = cn; co = -sn; } else if (qq == 2) { so = -sn; co = -cn; } else { so = -cn; co = sn; }
    c = (float)co; s = (float)so;
}

DI void phase_pre(const Ctx& X, const int parts = 7) {
    LAS float* scr = (LAS float*)(X.lds + X.wave * TR_SCR);
    bf16_t* WinT = (bf16_t*)(X.ws + WS_WIN); bf16_t* WoutT = (bf16_t*)(X.ws + WS_WOUT);
    constexpr int I_IN = (D / 64) * (NIN / 64), I_OUT = (D / 64) * (D / 64);
    if (parts & 1) for (int it = X.gw; it < I_IN + I_OUT; it += X.NGW) {
        if (it < I_IN) transpose_item(X.w_in(), D, NIN, WinT, RowId{}, scr, it, X.lane_f());
        else transpose_item(X.w_out(), D, D, WoutT, RowPerm32{}, scr, it - I_IN, X.lane_f());
    }
    unsigned* tabA = (unsigned*)(X.ws + WS_TAB); unsigned* tabR = tabA + (size_t)T * 16;
    {
        const long gt = (long)X.gw * 64 + X.lane_f(), NGT = (long)X.NGW * 64;
        LAS float* invs = (LAS float*)(X.lds + 8 * TR_SCR);
        __syncthreads();
        if (X.tid_f() < 144) { const int f = X.tid_f(); float inv;
            if (f < 16) inv = (float)exp(-((double)(2 * f) / 32.0) * 13.122363377404328);
            else { const float tt = (float)(f - 16) / 127.0f; inv = (float)exp(-(double)tt * 9.210340371976184); }
            invs[f] = inv; }
        __syncthreads();
        if (parts & 2) for (int i = (int)gt; i < T * 144; i += (int)NGT) {
            const int tok = i / 144, f = i - tok * 144;
            const float pos = (float)X.positions()[tok];
            const float inv = invs[f];
            const float ang = pos * inv; float c, s; sincos_f(ang, c, s);
            if (f < 16) tabA[(size_t)tok * 16 + f] = pack_h2(c, s); else tabR[(size_t)tok * 128 + f - 16] = pack_h2(c, s);
        }
        bf16_t* WRh = (bf16_t*)(X.ws + WS_WR + 512 * 1024); bf16_t* WRl = (bf16_t*)(X.ws + WS_WR + 768 * 1024);
        for (long i = gt; i < 48L * D; i += NGT) {
            const int col = (int)(i / D), k = (int)(i % D);
            const float wv = col < 32 ? X.w_sub()[((size_t)(col >> 3) * D + k) * 8 + (col & 7)] : (col < 36 ? X.w_group()[(size_t)k * 4 + (col - 32)] : 0.f);
            const unsigned hi = f2bf(wv); WRh[i] = (bf16_t)hi; WRl[i] = (bf16_t)f2bf(wv - bf2f(hi));
        }
        float* PP = (float*)(X.ws + WS_WR + 1024 * 1024); const float* modp = (const float*)(X.ws + CTL_MOD);
        for (long i = gt; i < 4L * D; i += NGT) {
            const int bb_ = (int)(i / D), k = (int)(i % D);
            const float sc = modp[(size_t)bb_ * 6 * D + 4 * D + k], sh = modp[(size_t)bb_ * 6 * D + 3 * D + k];
            PP[((size_t)bb_ * 2) * D + k] = X.ln1_g()[k] * (1.0f + sc); PP[((size_t)bb_ * 2 + 1) * D + k] = X.ln1_b()[k] * (1.0f + sc) + sh;
        }
    }
    const float* mod = (const float*)(X.ws + CTL_MOD);
    float* mu0 = (float*)(X.ws + WS_STAT0); float* rstd0 = mu0 + T;
    bf16_t* h = (bf16_t*)(X.ws + WS_A);
    if (parts & 4) {
        const int lane = X.lane_f();
        const int rowb = X.gw * 16; const int b = rowb / SEQ;
        LAS float* prm = (LAS float*)X.lds;
        { const float* sh1p = mod + (size_t)b * 6 * D; const float* sc1p = sh1p + D;
          __syncthreads();
          for (int i = X.tid_f(); i < D; i += NTHREADS) { prm[i] = X.ln0_g()[i]; prm[D + i] = X.ln0_b()[i]; prm[2 * D + i] = 1.0f + sc1p[i]; prm[3 * D + i] = sh1p[i]; }
          __syncthreads(); }
        f32x4 v[2][8], vn[2][8];
#pragma unroll
        for (int rr = 0; rr < 2; ++rr) { const f32x4* xr = (const f32x4*)(X.x() + (size_t)(rowb + rr) * D) + lane;
#pragma unroll
            for (int j = 0; j < 8; ++j) vn[rr][j] = xr[64 * j]; }
#pragma unroll 1
        for (int k8 = 0; k8 < 8; ++k8) {
            const int rowa = rowb + 2 * k8;
#pragma unroll
            for (int rr = 0; rr < 2; ++rr)
#pragma unroll
                for (int j = 0; j < 8; ++j) v[rr][j] = vn[rr][j];
            float mean[2], rstd[2];
#pragma unroll
            for (int rr = 0; rr < 2; ++rr) { float s_ = 0.f;
#pragma unroll
                for (int j = 0; j < 8; ++j) s_ += (v[rr][j][0] + v[rr][j][1]) + (v[rr][j][2] + v[rr][j][3]);
                mean[rr] = wave_sum(s_) * (1.0f / D); float s2 = 0.f;
#pragma unroll
                for (int j = 0; j < 8; ++j) { v[rr][j] = v[rr][j] - mean[rr]; s2 += (v[rr][j][0] * v[rr][j][0] + v[rr][j][1] * v[rr][j][1]) + (v[rr][j][2] * v[rr][j][2] + v[rr][j][3] * v[rr][j][3]); }
                rstd[rr] = 1.0f / sqrtf(wave_sum(s2) * (1.0f / D) + LN_EPS); }
            if (k8 < 7) {
#pragma unroll
                for (int rr = 0; rr < 2; ++rr) { const f32x4* xr = (const f32x4*)(X.x() + (size_t)(rowa + 2 + rr) * D) + lane;
#pragma unroll
                    for (int j = 0; j < 8; ++j) vn[rr][j] = xr[64 * j]; } }
            asm volatile("" ::: "memory");
            if (lane == 0) { mu0[rowa] = mean[0]; rstd0[rowa] = rstd[0]; mu0[rowa + 1] = mean[1]; rstd0[rowa + 1] = rstd[1]; }
#pragma unroll
            for (int j = 0; j < 8; ++j) { const int c = 4 * lane + 256 * j;
                const f32x4 gg = *(const LAS f32x4*)(prm + c), bb = *(const LAS f32x4*)(prm + D + c), sc = *(const LAS f32x4*)(prm + 2 * D + c), sh = *(const LAS f32x4*)(prm + 3 * D + c);
#pragma unroll
                for (int rr = 0; rr < 2; ++rr) { const f32x4 xn = v[rr][j] * rstd[rr] * gg + bb; const f32x4 hv = xn * sc + sh;
                    u32x2 w; w.x = pk2(hv[0], hv[1]); w.y = pk2(hv[2], hv[3]); ((u32x2*)(h + (size_t)(rowa + rr) * D) + lane)[64 * j] = w; } }
        }
    }
}

DI void phase_attn_naive(const Ctx& X) {
    const bf16_t* aq = (const bf16_t*)(X.ws + WS_B); const bf16_t* ak = aq + (size_t)T * 1024; const bf16_t* av = ak + (size_t)T * 1024;
    bf16_t* mix = (bf16_t*)(X.ws + WS_A);
    LAS float* qs = (LAS float*)(X.lds + X.wave * 1024);
    for (int it = X.gw; it < T * AH; it += X.NGW) {
        const int row = it >> 3, hh = it & 7, s = row & (SEQ - 1);
        { const unsigned w = *(const unsigned*)(aq + (size_t)row * 1024 + hh * 128 + 2 * X.lane_f()); qs[2 * X.lane_f()] = bflo(w); qs[2 * X.lane_f() + 1] = bfhi(w); }
        LDS_WAIT();
        float sc[9]; bool vd[9];
#pragma unroll
        for (int p = 0; p < 3; ++p) {
            const int dil = p == 0 ? 1 : (p == 1 ? 4 : 16);
#pragma unroll
            for (int ps = 0; ps < 3; ++ps) {
                const int j = ps == 0 ? X.lane_f() - 64 : (ps == 1 ? X.lane_f() : 64);
                const int sp = s + dil * j;
                const bool valid = (ps < 2 || X.lane_f() == 0) && sp >= 0 && sp < SEQ;
                const int spc = valid ? sp : s;
                const u32x4* kr = (const u32x4*)(ak + ((size_t)(row - s + spc)) * 1024 + hh * 128);
                float dot = 0.f;
#pragma unroll 4
                for (int ch = 0; ch < 16; ++ch) {
                    const u32x4 kw = kr[ch]; const f32x4 q0 = *(const LAS f32x4*)(qs + 8 * ch), q1 = *(const LAS f32x4*)(qs + 8 * ch + 4);
                    dot += bflo(kw.x) * q0[0] + bfhi(kw.x) * q0[1] + bflo(kw.y) * q0[2] + bfhi(kw.y) * q0[3] + bflo(kw.z) * q1[0] + bfhi(kw.z) * q1[1] + bflo(kw.w) * q1[2] + bfhi(kw.w) * q1[3];
                }
                sc[p * 3 + ps] = valid ? dot : -1e30f; vd[p * 3 + ps] = valid;
            }
        }
        float m = sc[0];
#pragma unroll
        for (int i = 1; i < 9; ++i) m = fmaxf(m, sc[i]);
        m = wave_max(m);
        float l = 0.f;
#pragma unroll
        for (int i = 0; i < 9; ++i) { sc[i] = vd[i] ? expf(sc[i] - m) : 0.f; l += sc[i]; }
        l = wave_sum(l);
        float a0 = 0.f, a1 = 0.f;
#pragma unroll
        for (int p = 0; p < 3; ++p) {
            const int dil = p == 0 ? 1 : (p == 1 ? 4 : 16);
#pragma unroll
            for (int ps = 0; ps < 3; ++ps) {
                const int nk = ps < 2 ? 64 : 1;
                for (int k = 0; k < nk; ++k) {
                    const float pk = __shfl(sc[p * 3 + ps], k);
                    if (pk != 0.f) {
                        const int j = ps == 0 ? k - 64 : (ps == 1 ? k : 64);
                        const unsigned w = *(const unsigned*)(av + ((size_t)(row + dil * j)) * 1024 + hh * 128 + 2 * X.lane_f());
                        a0 += pk * bflo(w); a1 += pk * bfhi(w);
                    }
                }
            }
        }
        const float il = 1.0f / l;
        *(unsigned*)(mix + (size_t)row * D + hh * 128 + 2 * X.lane_f()) = pk2(a0 * il, a1 * il);
        LDS_WAIT();
    }
}


typedef float f32x16 __attribute__((ext_vector_type(16)));
typedef short s16x4 __attribute__((ext_vector_type(4)));
typedef short v4i16_t __attribute__((ext_vector_type(4)));
DI s16x4 vtr(const LAS unsigned char* p) { return __builtin_bit_cast(s16x4, __builtin_amdgcn_ds_read_tr16_b64_v4i16((LAS v4i16_t*)p)); }
#define MFMA32(a, b, c) __builtin_amdgcn_mfma_f32_32x32x16_bf16((a), (b), (c), 0, 0, 0)
DI bf16x8 cat8(s16x4 lo, s16x4 hi) { return (bf16x8){lo[0], lo[1], lo[2], lo[3], hi[0], hi[1], hi[2], hi[3]}; }

DI unsigned offb(unsigned row, unsigned ch) { return 256u * row + 16u * (ch ^ (((row & 3u) << 2) | ((row >> 2) & 3u))); }
DI void dma16(const void* gsrc, unsigned lds_dst) { unsigned keep; asm volatile("s_mov_b32 %0, m0\n\ts_mov_b32 m0, %2\n\ts_nop 0\n\tglobal_load_lds_dwordx4 %1, off\n\ts_mov_b32 m0, %0" : "=&s"(keep) : "v"(gsrc), "s"(lds_dst) : "memory"); }
template <int IMM> DI void dma16s(unsigned voff, const void* sbase, unsigned lds_base) { unsigned keep; asm volatile("s_mov_b32 %0, m0\n\ts_add_u32 m0, %3, %4\n\ts_nop 0\n\tglobal_load_lds_dwordx4 %1, %2\n\ts_mov_b32 m0, %0" : "=&s"(keep) : "v"(voff), "s"(sbase), "s"(lds_base), "i"(IMM) : "memory", "scc"); }
constexpr int ATT_XROW = 264, ATT_MOFF = 131072, ATT_LOFF = ATT_MOFF + 1024;
static_assert(256 * ATT_XROW <= 131072 && ATT_LOFF + 1024 <= LDS_BYTES - 16, "attention LDS map");
DI void phase_attn(const Ctx& X, const int dbg = 0, const int split = 0) {
    const bf16_t* aq = (const bf16_t*)(X.ws + WS_B); const bf16_t* ak = aq + (size_t)T * 1024; const bf16_t* av = ak + (size_t)T * 1024;
    bf16_t* mix = (dbg & 4) ? (bf16_t*)(X.ws + WS_WIN) : (bf16_t*)(X.ws + WS_A);
    const int w = X.wave;
    LAS unsigned char* vbase = X.lds + w * 16384;
    LAS unsigned char* xbuf = X.lds; LAS float* mS = (LAS float*)(X.lds + ATT_MOFF); LAS float* lS = (LAS float*)(X.lds + ATT_LOFF);
    const float LOG2E = 1.4426950408889634f;
    const int nit = split ? ((X.vcu & 1) ? 5 : 3) : (BATCH * AH * (SEQ / 256) - X.vcu + X.G - 1) / X.G;
    for (int iti = 0; iti < nit; ++iti) {
        int item;
        if (split) { const int k = ((X.vcu & 1) ? 0 : 5) + iti, xq = X.vcu >> 5, jq = (X.vcu & 31) >> 1; item = (4 * xq + (k >> 1)) * 32 + 16 * (k & 1) + jq; }
        else item = X.vcu + iti * X.G;
        int lane = X.lane_f(); asm volatile("" : "+v"(lane));
        const int c = lane & 31, hh = lane >> 5, trq = (lane & 15) >> 2, trp = lane & 3, trblk = (lane >> 4) & 1;
        const int qb = item & 31, head = (item >> 5) & 7, b = item >> 8;
        const int t0 = qb * 256; const size_t rowbase = (size_t)b * SEQ;
        const char* akh0 = (const char*)ak + (rowbase * 1024 + head * 128) * 2;
        const char* avh = (const char*)av + (rowbase * 1024 + head * 128) * 2;
        f32x16 o[4];
#pragma unroll
        for (int dt = 0; dt < 4; ++dt)
#pragma unroll
            for (int i = 0; i < 16; ++i) o[dt][i] = 0.f;
        float m = -1e30f, l = 0.f;
        int offq = 0;
#pragma unroll 1
        for (int p = 0; p < 3; ++p) {
            const int sh = 2 * p, dil = 1 << sh;
            offq = p == 0 ? 32 * w + c : (p == 1 ? 128 * (w >> 2) + 4 * c + (w & 3) : (c < 16 ? 16 * c + 2 * w : 16 * (c - 16) + 2 * w + 1));
            if (p > 0) {
#pragma unroll
                for (int dt = 0; dt < 4; ++dt)
#pragma unroll
                    for (int g = 0; g < 4; ++g) { const u32x2 wv = *(const LAS u32x2*)(xbuf + offq * ATT_XROW + (32 * dt + 8 * g + 4 * hh) * 2);
                        o[dt][4 * g] = bflo(wv.x); o[dt][4 * g + 1] = bfhi(wv.x); o[dt][4 * g + 2] = bflo(wv.y); o[dt][4 * g + 3] = bfhi(wv.y); }
                m = mS[offq]; l = lS[offq];
                __syncthreads();
            }
            const int pq = t0 + offq;
            bf16x8 qf[8];
            { const char* qp = (const char*)aq + ((rowbase + pq) * 1024 + head * 128) * 2 + hh * 16;
#pragma unroll
              for (int s = 0; s < 8; ++s) qf[s] = *(const bf16x8*)(qp + 32 * s); }
            asm volatile("s_waitcnt vmcnt(0)" ::: "memory");
#pragma unroll
            for (int s = 0; s < 8; ++s) asm volatile("" : "+v"(qf[s]));
            const int ntile = p == 2 ? 10 : 5;
#define ATT_KB(ti_) (p == 0 ? t0 + 32 * w - 64 + 32 * ((ti_) % 5) : (p == 1 ? t0 + 4 * (32 * (w >> 2) - 64 + 32 * ((ti_) % 5)) + (w & 3) : t0 + 16 * (-64 + 32 * ((ti_) % 5)) + 2 * w + (ti_) / 5))
#define ATT_DMA(ti_, gbase_, buf_, KSWZ_) do { const int kb_ = (dbg & 1) ? 4096 : ATT_KB(ti_); int lane = X.lane_f(); asm volatile("" : "+v"(lane)); \
                _Pragma("unroll") for (int i = 0; i < 8; ++i) { const int r_ = (KSWZ_) ? 4 * i + (lane >> 4) : 8 * (i >> 1) + ((lane >> 2) & 7); int pk_ = kb_ + (r_ << sh); pk_ = pk_ < 0 ? 0 : (pk_ > SEQ - 1 ? SEQ - 1 : pk_); \
                    const int ch_ = (KSWZ_) ? ((lane & 15) ^ (r_ & 15)) : (4 * (2 * (i & 1) + (lane >> 5)) + ((lane & 3) ^ ((2 * ((i >> 1) & 1) + ((lane >> 4) & 1)) & 3))); \
                    dma16((gbase_) + (size_t)pk_ * 2048 + ch_ * 16, (unsigned)__builtin_amdgcn_readfirstlane((int)(unsigned)(size_t)((buf_) + i * 1024))); } } while (0)
            LAS unsigned char* kbuf = vbase; LAS unsigned char* vbuf = vbase + 8192;
            const unsigned kbuf_u = (unsigned)__builtin_amdgcn_readfirstlane((int)(unsigned)(size_t)kbuf), vbuf_u = kbuf_u + 8192u;
            const unsigned offK0 = (unsigned)(((lane >> 4) << sh) * 2048) + (unsigned)(((lane & 15) ^ (lane >> 4)) << 4);
            const unsigned offV0 = (unsigned)((((lane >> 2) & 7) << sh) * 2048) + (unsigned)((4 * (lane >> 5) + ((lane & 3) ^ ((lane >> 4) & 1))) << 4);
#define ATT_OFFK(q_) (offK0 ^ (unsigned)(64 * (q_)))
#define ATT_OFFV(q_) ((offV0 + (unsigned)(128 * ((q_) & 1))) ^ (unsigned)(32 * ((q_) >> 1)))
#define ATT_INR(kb_) (((kb_) >= 0) && ((kb_) + (31 << sh) < SEQ))
#define ATT_DMA2(ti_, gbase_, bufu_, KSWZ_) do { const int kbn_ = ATT_KB(ti_); \
                if (ATT_INR(kbn_) && !(dbg & 1)) { const char* sb_ = (gbase_) + (size_t)kbn_ * 2048; const size_t st_ = (size_t)(4 << sh) * 2048; \
                    dma16s<0>((KSWZ_) ? ATT_OFFK(0) : ATT_OFFV(0), sb_, bufu_); dma16s<1024>((KSWZ_) ? ATT_OFFK(1) : ATT_OFFV(1), sb_ + st_ * ((KSWZ_) ? 1 : 0), bufu_); \
                    dma16s<2048>((KSWZ_) ? ATT_OFFK(2) : ATT_OFFV(2), sb_ + st_ * 2, bufu_); dma16s<3072>((KSWZ_) ? ATT_OFFK(3) : ATT_OFFV(3), sb_ + st_ * ((KSWZ_) ? 3 : 2), bufu_); \
                    dma16s<4096>((KSWZ_) ? ATT_OFFK(0) : ATT_OFFV(0), sb_ + st_ * 4, bufu_); dma16s<5120>((KSWZ_) ? ATT_OFFK(1) : ATT_OFFV(1), sb_ + st_ * ((KSWZ_) ? 5 : 4), bufu_); \
                    dma16s<6144>((KSWZ_) ? ATT_OFFK(2) : ATT_OFFV(2), sb_ + st_ * 6, bufu_); dma16s<7168>((KSWZ_) ? ATT_OFFK(3) : ATT_OFFV(3), sb_ + st_ * ((KSWZ_) ? 7 : 6), bufu_); } \
                else ATT_DMA(ti_, gbase_, (LAS unsigned char*)nullptr + (bufu_), KSWZ_); } while (0)
            ATT_DMA2(0, akh0, kbuf_u, 1); ATT_DMA2(0, avh, vbuf_u, 0);
            const LAS unsigned char* kfa = kbuf + c * 256;
            const LAS unsigned char* vt0 = vbuf + 64 * (4 * hh + trq) + 16 * ((2 * trblk + (trp >> 1)) ^ (hh & 3)) + 8 * (trp & 1);
            const LAS unsigned char* vt1 = vbuf + 2048 + 64 * (4 * hh + trq) + 16 * ((2 * trblk + (trp >> 1)) ^ ((2 + hh) & 3)) + 8 * (trp & 1);
#pragma unroll 1
            for (int ti = 0; ti < ntile; ++ti) {
                const int kb = ATT_KB(ti), tau = ti % 5;
                const bool more = ti + 1 < ntile;
                asm volatile("s_waitcnt vmcnt(8)" ::: "memory");
                bf16x8 kf[8];
#pragma unroll
                for (int s = 0; s < 8; ++s) kf[s] = *(const LAS bf16x8*)(kfa + (((2 * s + hh) ^ (c & 15)) << 4));
                f32x16 sa;
#pragma unroll
                for (int i = 0; i < 16; ++i) sa[i] = 0.f;
                if (dbg & 8) { sa[0] = __builtin_bit_cast(float, (int)kf[0][0]) * 1e-30f; } else
#pragma unroll
                for (int s = 0; s < 8; ++s) sa = MFMA32(kf[s], qf[s], sa);
                __builtin_amdgcn_sched_barrier(0);
                if (more) ATT_DMA2(ti + 1, akh0, kbuf_u, 1);
                __builtin_amdgcn_sched_barrier(0);
                const bool cm = ((kb - pq) & (dil - 1)) == 0;
                const bool fullt = (tau >= 1) && (tau <= 3) && ATT_INR(kb);
                bf16x8 pf[2];
                if (dbg & 8) { l += sa[0]; } else
                if (fullt) {
                    float tmax = fmaxf(fmaxf(sa[0], sa[1]), fmaxf(sa[2], sa[3]));
#pragma unroll
                    for (int r = 4; r < 16; r += 4) tmax = fmaxf(tmax, fmaxf(fmaxf(sa[r], sa[r + 1]), fmaxf(sa[r + 2], sa[r + 3])));
                    tmax *= LOG2E;
                    tmax = fmaxf(tmax, __shfl_xor(tmax, 32));
                    tmax = cm ? tmax : -1e30f;
                    const float mn = fmaxf(m, tmax);
                    if (__any(mn > m)) { const float alpha = __builtin_amdgcn_exp2f(m - mn); l *= alpha;
#pragma unroll
                        for (int dt = 0; dt < 4; ++dt) o[dt] = o[dt] * alpha; }
                    m = mn;
                    const float mneg = cm ? -mn : -1e30f;
                    float ps = 0.f;
#pragma unroll
                    for (int r = 0; r < 16; ++r) { sa[r] = __builtin_amdgcn_exp2f(__builtin_fmaf(sa[r], LOG2E, mneg)); ps += sa[r]; }
                    ps += __shfl_xor(ps, 32);
                    l += ps;
                } else {
                    float tmax = -1e30f;
#pragma unroll
                    for (int r = 0; r < 16; ++r) { const int kr = (r & 3) + 8 * (r >> 2) + 4 * hh; const int pk = kb + (kr << sh); const int df = pk - pq; const int ad = df < 0 ? -df : df;
                        const bool vdr = cm && (pk >= 0) && (pk < SEQ) && (ad <= (64 << sh));
                        sa[r] = vdr ? sa[r] * LOG2E : -1e30f; tmax = fmaxf(tmax, sa[r]); }
                    tmax = fmaxf(tmax, __shfl_xor(tmax, 32));
                    const float mn = fmaxf(m, tmax);
                    if (__any(mn > m)) { const float alpha = __builtin_amdgcn_exp2f(m - mn); l *= alpha;
#pragma unroll
                        for (int dt = 0; dt < 4; ++dt) o[dt] = o[dt] * alpha; }
                    m = mn;
                    float ps = 0.f;
#pragma unroll
                    for (int r = 0; r < 16; ++r) { sa[r] = sa[r] > -1e29f ? __builtin_amdgcn_exp2f(sa[r] - mn) : 0.f; ps += sa[r]; }
                    ps += __shfl_xor(ps, 32);
                    l += ps;
                }
#pragma unroll
                for (int s = 0; s < 2; ++s) { u32x4 pw; pw.x = cvtpk(sa[8 * s], sa[8 * s + 1]); pw.y = cvtpk(sa[8 * s + 2], sa[8 * s + 3]); pw.z = cvtpk(sa[8 * s + 4], sa[8 * s + 5]); pw.w = cvtpk(sa[8 * s + 6], sa[8 * s + 7]); pf[s] = __builtin_bit_cast(bf16x8, pw); }
                if (more) asm volatile("s_waitcnt vmcnt(8)" ::: "memory"); else asm volatile("s_waitcnt vmcnt(0)" ::: "memory");
#pragma unroll
                for (int dt = 0; dt < ((dbg & 8) ? 0 : 4); ++dt)
#pragma unroll
                    for (int s = 0; s < 2; ++s) { const s16x4 lo = vtr(vt0 + 4096 * s + 512 * dt), hi = vtr(vt1 + 4096 * s + 512 * dt);
                        o[dt] = MFMA32(cat8(lo, hi), pf[s], o[dt]); }
                asm volatile("s_waitcnt lgkmcnt(0)" ::: "memory");
                __builtin_amdgcn_sched_barrier(0);
                if (more) ATT_DMA2(ti + 1, avh, vbuf_u, 0);
                __builtin_amdgcn_sched_barrier(0);
            }
#undef ATT_DMA2
#undef ATT_INR
#undef ATT_OFFK
#undef ATT_OFFV
#undef ATT_KB
#undef ATT_DMA
            if (p < 2) {
                __syncthreads();
#pragma unroll
                for (int dt = 0; dt < 4; ++dt)
#pragma unroll
                    for (int g = 0; g < 4; ++g) { u32x2 wv; wv.x = cvtpk(o[dt][4 * g], o[dt][4 * g + 1]); wv.y = cvtpk(o[dt][4 * g + 2], o[dt][4 * g + 3]);
                        *(LAS u32x2*)(xbuf + offq * ATT_XROW + (32 * dt + 8 * g + 4 * hh) * 2) = wv; }
                if (hh == 0) { mS[offq] = m; lS[offq] = l; }
                __syncthreads();
            }
        }
        const float il = 1.0f / l;
        bf16_t* orow = mix + ((dbg & 4) ? ((rowbase + t0 + offq) & 4095) : (rowbase + t0 + offq)) * D + head * 128;
        if (!(dbg & 3))
#pragma unroll
        for (int dt = 0; dt < 4; ++dt)
#pragma unroll
            for (int g = 0; g < 4; ++g) { u32x2 wv; wv.x = cvtpk(o[dt][4 * g] * il, o[dt][4 * g + 1] * il); wv.y = cvtpk(o[dt][4 * g + 2] * il, o[dt][4 * g + 3] * il);
                *(u32x2*)(orow + 32 * dt + 8 * g + 4 * hh) = wv; }
    }
}

constexpr float LOG2E_F = 1.4426950408889634f;
constexpr size_t ST_CHUNK = 65536;

DI void phase_ret_states(const Ctx& X, const int dbg = 0) {
    const bf16_t* rk = (const bf16_t*)(X.ws + WS_B) + (size_t)4 * T * 1024; const bf16_t* rv = rk + (size_t)T * 1024;
    bf16_t* STf = (bf16_t*)(X.ws + WS_YF); bf16_t* STb = (bf16_t*)(X.ws + WS_YB);
    const int lane = X.lane_f(), c = lane & 31, hh = lane >> 5, w = X.wave, tid = X.tid_f();
    const int trq = (lane & 15) >> 2, trp = lane & 3, trblk = (lane >> 4) & 1;
    constexpr int BUF = 65536 + 8192;
    for (int item = X.vcu; item < 256; item += X.G) {
        const int es = item & 7, dir = (item >> 3) & 1, bh = item >> 4, b = bh >> 2, head = bh & 3;
        const float lg2 = (dir ? X.ldb()[head] : X.ldf()[head]) * LOG2E_F; const float gC = exp2f(128.0f * lg2);
        bf16_t* ST = (dir ? STb : STf) + (size_t)bh * 64 * ST_CHUNK;
        f32x16 acc;
#pragma unroll
        for (int i = 0; i < 16; ++i) acc[i] = 0.f;
        u32x4 kregA[8], kregB[8], vregA, vregB;
        const int vj = tid >> 2, vp = tid & 3;
        const float zeta = exp2f((float)(dir ? vj : 127 - vj) * lg2);
#define RS_LOADG(n_, kreg, vreg4) do { const size_t rowc = (size_t)b * SEQ + 128 * (n_); \
            _Pragma("unroll") for (int i = 0; i < 8; ++i) { const int idx = tid + 512 * i, j = idx >> 5, cc = idx & 31; kreg[i] = *(const u32x4*)(rk + (rowc + j) * 1024 + head * 256 + cc * 8); } \
            vreg4 = *(const u32x4*)(rv + (rowc + vj) * 1024 + head * 256 + 32 * es + 8 * vp); } while (0)
#define RS_STORE(buf_, kreg, vreg4) do { LAS unsigned char* kimg = X.lds + (buf_) * BUF; LAS unsigned char* vimg = kimg + 65536; \
            _Pragma("unroll") for (int i = 0; i < 8; ++i) { const int idx = tid + 512 * i, j = idx >> 5, cc = idx & 31; *(LAS u32x4*)(kimg + (cc >> 4) * 32768 + offb(j, cc & 15)) = kreg[i]; } \
            u32x4 sv; sv.x = cvtpk(bflo(vreg4.x) * zeta, bfhi(vreg4.x) * zeta); sv.y = cvtpk(bflo(vreg4.y) * zeta, bfhi(vreg4.y) * zeta); sv.z = cvtpk(bflo(vreg4.z) * zeta, bfhi(vreg4.z) * zeta); sv.w = cvtpk(bflo(vreg4.w) * zeta, bfhi(vreg4.w) * zeta); \
            *(LAS u32x4*)(vimg + vj * 64 + vp * 16) = sv; } while (0)
#define RS_CHUNK(step_) (dir ? 63 - (step_) : (step_))
        RS_LOADG(RS_CHUNK(0), kregA, vregA); RS_STORE(0, kregA, vregA);
        RS_LOADG(RS_CHUNK(1), kregB, vregB);
        __syncthreads();
#define RS_STEP(step_, kregNext, vregNext, kregLoad, vregLoad) do { const int step = (step_); const int n = RS_CHUNK(step), buf = step & 1; \
            if (step + 2 < 64) RS_LOADG(RS_CHUNK(step + 2), kregLoad, vregLoad); \
            if (!(dbg & 1)) {   \
              _Pragma("unroll") for (int gp = 0; gp < 2; ++gp) { const int ga = 2 * gp, gb = 2 * gp + 1; \
                const unsigned a0 = cvtpk(acc[4 * ga], acc[4 * ga + 1]), a1 = cvtpk(acc[4 * ga + 2], acc[4 * ga + 3]), b0 = cvtpk(acc[4 * gb], acc[4 * gb + 1]), b1 = cvtpk(acc[4 * gb + 2], acc[4 * gb + 3]); \
                const unsigned r0 = __shfl_xor(hh ? a0 : b0, 32), r1 = __shfl_xor(hh ? a1 : b1, 32); \
                u32x4 wv; if (hh == 0) { wv.x = a0; wv.y = a1; wv.z = r0; wv.w = r1; } else { wv.x = r0; wv.y = r1; wv.z = b0; wv.w = b1; } \
                *(u32x4*)(ST + (size_t)n * ST_CHUNK + ((size_t)(4 * w + (hh ? gb : ga)) * 256 + 32 * es + c) * 8) = wv; } } \
            acc = acc * gC; \
            const LAS unsigned char* kimg = X.lds + buf * BUF + (w >> 2) * 32768; const LAS unsigned char* vimg = X.lds + buf * BUF + 65536; \
            if (!(dbg & 2)) _Pragma("unroll") for (int ks = 0; ks < 8; ++ks) { \
                const unsigned r0 = 16 * ks + 8 * hh + trq, r1 = r0 + 4, ch = 4 * (w & 3) + 2 * trblk + (trp >> 1); \
                const s16x4 a0 = vtr(kimg + offb(r0, ch) + 8 * (trp & 1)), a1 = vtr(kimg + offb(r1, ch) + 8 * (trp & 1)); \
                const s16x4 b0 = vtr(vimg + r0 * 64 + 32 * trblk + 8 * trp), b1 = vtr(vimg + r1 * 64 + 32 * trblk + 8 * trp); \
                acc = MFMA32(cat8(a0, a1), cat8(b0, b1), acc); } \
            if (step + 1 < 64 && !(dbg & 4)) RS_STORE(buf ^ 1, kregNext, vregNext); \
            __syncthreads(); } while (0)
#pragma unroll 1
        for (int s2 = 0; s2 < 64; s2 += 2) {
            RS_STEP(s2, kregB, vregB, kregA, vregA);
            RS_STEP(s2 + 1, kregA, vregA, kregB, vregB);
        }
#undef RS_STEP
#undef RS_CHUNK
#undef RS_LOADG
#undef RS_STORE
    }
}

DI void phase_ret_states64(const Ctx& X, const int q) {
    const bf16_t* rk = (const bf16_t*)(X.ws + WS_B) + (size_t)4 * T * 1024; const bf16_t* rv = rk + (size_t)T * 1024;
    bf16_t* STf = (bf16_t*)(X.ws + WS_YF); bf16_t* STb = (bf16_t*)(X.ws + WS_YB);
    const int lane = X.lane_f(), c = lane & 31, hh = lane >> 5, w = X.wave, tid = X.tid_f();
    const int trq = (lane & 15) >> 2, trp = lane & 3, trblk = (lane >> 4) & 1;
    const int es4 = q & 3, dir = (q >> 2) & 1, bh = q >> 3, b = bh >> 2, head = bh & 3;
    const float lg2 = (dir ? X.ldb()[head] : X.ldf()[head]) * LOG2E_F; const float gC = exp2f(128.0f * lg2);
    bf16_t* ST = (dir ? STb : STf) + (size_t)bh * 64 * ST_CHUNK;
    f32x16 acc[2];
#pragma unroll
    for (int et = 0; et < 2; ++et)
#pragma unroll
        for (int i = 0; i < 16; ++i) acc[et][i] = 0.f;
    u32x4 kregA[8], vregA[2];
    const int vj0 = tid >> 3, vj1 = (tid + 512) >> 3, vp = tid & 7;
    const float zeta0 = exp2f((float)(dir ? vj0 : 127 - vj0) * lg2), zeta1 = exp2f((float)(dir ? vj1 : 127 - vj1) * lg2);
    LAS unsigned char* vimg = X.lds + 131072;
#define R6_LOADG(n_, kreg, vreg) do { const size_t rowc = (size_t)b * SEQ + 128 * (n_); \
        _Pragma("unroll") for (int i = 0; i < 8; ++i) { const int idx = tid + 512 * i, j = idx >> 5, cc = idx & 31; kreg[i] = *(const u32x4*)(rk + (rowc + j) * 1024 + head * 256 + cc * 8); } \
        vreg[0] = *(const u32x4*)(rv + (rowc + vj0) * 1024 + head * 256 + 64 * es4 + 8 * vp); vreg[1] = *(const u32x4*)(rv + (rowc + vj1) * 1024 + head * 256 + 64 * es4 + 8 * vp); } while (0)
#define R6_STOREK(buf_, kreg) do { LAS unsigned char* kimg = X.lds + (buf_) * 65536; \
        _Pragma("unroll") for (int i = 0; i < 8; ++i) { const int idx = tid + 512 * i, j = idx >> 5, cc = idx & 31; *(LAS u32x4*)(kimg + (cc >> 4) * 32768 + offb(j, cc & 15)) = kreg[i]; } } while (0)
#define R6_SCALE(v_, z_) ({ u32x4 sv_; sv_.x = cvtpk(bflo((v_).x) * (z_), bfhi((v_).x) * (z_)); sv_.y = cvtpk(bflo((v_).y) * (z_), bfhi((v_).y) * (z_)); sv_.z = cvtpk(bflo((v_).z) * (z_), bfhi((v_).z) * (z_)); sv_.w = cvtpk(bflo((v_).w) * (z_), bfhi((v_).w) * (z_)); sv_; })
#define R6_STOREV(vreg) do { *(LAS u32x4*)(vimg + vj0 * 128 + vp * 16) = R6_SCALE(vreg[0], zeta0); *(LAS u32x4*)(vimg + vj1 * 128 + vp * 16) = R6_SCALE(vreg[1], zeta1); } while (0)
#define R6_CHUNK(step_) (dir ? 63 - (step_) : (step_))
    R6_LOADG(R6_CHUNK(0), kregA, vregA); R6_STOREK(0, kregA); R6_STOREV(vregA);
    __syncthreads();
#define R6_STEP(step_, kregNext, vregNext, kregLoad, vregLoad) do { const int step = (step_); const int n = R6_CHUNK(step), buf = step & 1; \
        if (step + 1 < 64) R6_LOADG(R6_CHUNK(step + 1), kregLoad, vregLoad); \
        _Pragma("unroll") for (int et = 0; et < 2; ++et) _Pragma("unroll") for (int gp = 0; gp < 2; ++gp) { const int ga = 2 * gp, gb = 2 * gp + 1; \
            const unsigned a0 = cvtpk(acc[et][4 * ga], acc[et][4 * ga + 1]), a1 = cvtpk(acc[et][4 * ga + 2], acc[et][4 * ga + 3]), b0 = cvtpk(acc[et][4 * gb], acc[et][4 * gb + 1]), b1 = cvtpk(acc[et][4 * gb + 2], acc[et][4 * gb + 3]); \
            const unsigned r0 = __shfl_xor(hh ? a0 : b0, 32), r1 = __shfl_xor(hh ? a1 : b1, 32); \
            u32x4 wv; if (hh == 0) { wv.x = a0; wv.y = a1; wv.z = r0; wv.w = r1; } else { wv.x = r0; wv.y = r1; wv.z = b0; wv.w = b1; } \
            *(u32x4*)(ST + (size_t)n * ST_CHUNK + ((size_t)(4 * w + (hh ? gb : ga)) * 256 + 64 * es4 + 32 * et + c) * 8) = wv; } \
        acc[0] = acc[0] * gC; acc[1] = acc[1] * gC; \
        const LAS unsigned char* kimg = X.lds + buf * 65536 + (w >> 2) * 32768; \
        _Pragma("unroll") for (int ks = 0; ks < 8; ++ks) { \
            const unsigned r0 = 16 * ks + 8 * hh + trq, r1 = r0 + 4, ch = 4 * (w & 3) + 2 * trblk + (trp >> 1); \
            const bf16x8 a = cat8(vtr(kimg + offb(r0, ch) + 8 * (trp & 1)), vtr(kimg + offb(r1, ch) + 8 * (trp & 1))); \
            _Pragma("unroll") for (int et = 0; et < 2; ++et) { \
                const s16x4 b0 = vtr(vimg + r0 * 128 + 64 * et + 32 * trblk + 8 * trp), b1 = vtr(vimg + r1 * 128 + 64 * et + 32 * trblk + 8 * trp); \
                acc[et] = MFMA32(a, cat8(b0, b1), acc[et]); } } \
        if (step + 1 < 64) R6_STOREK(buf ^ 1, kregNext); \
        __syncthreads();                                     \
        if (step + 1 < 64) R6_STOREV(vregNext); \
        __syncthreads(); } while (0)
#pragma unroll 1
    for (int s2 = 0; s2 < 64; ++s2) {
        R6_STEP(s2, kregA, vregA, kregA, vregA);
    }
#undef R6_STEP
#undef R6_CHUNK
#undef R6_LOADG
#undef R6_STOREK
#undef R6_STOREV
#undef R6_SCALE
}

DI void phase_ret_out(const Ctx& X, const int dbg = 0) {
    const bf16_t* rq = (const bf16_t*)(X.ws + WS_B) + (size_t)3 * T * 1024; const bf16_t* rk = rq + (size_t)T * 1024; const bf16_t* rv = rk + (size_t)T * 1024; const bf16_t* rg = rv + (size_t)T * 1024;
    const bf16_t* STf = (const bf16_t*)(X.ws + WS_YF); const bf16_t* STb = (const bf16_t*)(X.ws + WS_YB);
    bf16_t* mix = dbg ? (bf16_t*)(X.ws + WS_Y) : (bf16_t*)(X.ws + WS_A);
    const int w = X.wave;
    LAS unsigned char* qimg = X.lds; LAS unsigned char* kimg = X.lds + 65536; LAS unsigned char* pimg = kimg; LAS unsigned char* vimg = X.lds;
    LAS float* part = (LAS float*)(X.lds + 131072);
    for (int item = X.vcu; item < 1024; item += X.G) {
        int lane_o = X.lane_f(); asm volatile("" : "+v"(lane_o));
        int tid = X.tid_f(); asm volatile("" : "+v"(tid));
        const int c = lane_o & 31, hh = lane_o >> 5, trq = (lane_o & 15) >> 2, trp = lane_o & 3, trblk = (lane_o >> 4) & 1;
        const int n = item & 63, bh = item >> 6, b = bh >> 2, head = bh & 3; const size_t rowc = (size_t)b * SEQ + 128 * n;
        const float lg2f = X.ldf()[head] * LOG2E_F, lg2b = X.ldb()[head] * LOG2E_F;
#pragma unroll
        for (int i = 0; i < 8; ++i) { const int idx = tid + 512 * i, j = idx >> 5, cc = idx & 31;
            const u32x4 qv = *(const u32x4*)(rq + (rowc + j) * 1024 + head * 256 + cc * 8), kv = *(const u32x4*)(rk + (rowc + j) * 1024 + head * 256 + cc * 8);
            *(LAS u32x4*)(qimg + j * 512 + ((cc ^ (j & 15)) << 4)) = qv; *(LAS u32x4*)(kimg + j * 512 + ((cc ^ (j & 15)) << 4)) = kv; }
        __syncthreads();
        f32x16 acc[4];
#pragma unroll
        for (int it = 0; it < 4; ++it)
#pragma unroll
            for (int i = 0; i < 16; ++i) acc[it][i] = 0.f;
        {
            const bf16_t* spf = STf + ((size_t)bh * 64 + n) * ST_CHUNK + ((size_t)hh * 256 + 32 * w + c) * 8;
            const bf16_t* spb = STb + ((size_t)bh * 64 + n) * ST_CHUNK + ((size_t)hh * 256 + 32 * w + c) * 8;
            bf16x8 afA[8], afB[8];
#define RO_LOAD(dst, sp_, sh_) do { _Pragma("unroll") for (int s = 0; s < 8; ++s) dst[s] = *(const bf16x8*)((sp_) + (size_t)(8 * (sh_) + s) * 2 * 256 * 8); } while (0)
#define RO_MMA(src, sh_) do { _Pragma("unroll") for (int it = 0; it < 4; ++it) { const int i = 32 * it + c; const LAS unsigned char* qrow = qimg + i * 512; \
                _Pragma("unroll") for (int s = 0; s < 8; ++s) acc[it] = MFMA32(src[s], *(const LAS bf16x8*)(qrow + (((2 * (8 * (sh_) + s) + hh) ^ (i & 15)) << 4)), acc[it]); \
                asm volatile("" ::: "memory"); } } while (0)
            if (!(dbg & 2)) {
            RO_LOAD(afA, spf, 0); RO_LOAD(afB, spf, 1);
            RO_MMA(afA, 0); RO_LOAD(afA, spb, 0);
            RO_MMA(afB, 1); RO_LOAD(afB, spb, 1);
#pragma unroll
            for (int it = 0; it < 4; ++it) { const int i = 32 * it + c; acc[it] = acc[it] * __builtin_amdgcn_exp2f((float)(i + 1) * lg2f - (float)(128 - i) * lg2b); }
            RO_MMA(afA, 0);
            RO_MMA(afB, 1);
            }
#pragma unroll
            for (int it = 0; it < 4; ++it) { const int i = 32 * it + c; acc[it] = acc[it] * __builtin_amdgcn_exp2f((float)(128 - i) * lg2b); }
#undef RO_LOAD
#undef RO_MMA
        }
        float pvv[2][16];
        {
            const int it = w & 3, i = 32 * it + c; const LAS unsigned char* qrow = qimg + i * 512;
#pragma unroll
            for (int jj = 0; jj < 2; ++jj) {
                const int jt = 2 * (w >> 2) + jj, j = 32 * jt + c; const LAS unsigned char* krow = kimg + j * 512;
                f32x16 sa;
#pragma unroll
                for (int r = 0; r < 16; ++r) sa[r] = 0.f;
#pragma unroll
                for (int s = 0; s < ((dbg & 4) ? 0 : 16); ++s) { sa = MFMA32(*(const LAS bf16x8*)(krow + (((2 * s + hh) ^ (j & 15)) << 4)), *(const LAS bf16x8*)(qrow + (((2 * s + hh) ^ (i & 15)) << 4)), sa);
                    if ((s & 3) == 3) asm volatile("" ::: "memory"); }
#pragma unroll
                for (int r = 0; r < 16; ++r) { const int jr = 32 * jt + (r & 3) + 8 * (r >> 2) + 4 * hh; const int df = i - jr;
                    const float dm = __builtin_amdgcn_exp2f(df >= 0 ? (float)df * lg2f : (float)(-df) * lg2b); pvv[jj][r] = sa[r] * dm; }
            }
        }
        __syncthreads();
        {
            const int it = w & 3, i = 32 * it + c;
#pragma unroll
            for (int jj = 0; jj < 2; ++jj) { const int jt = 2 * (w >> 2) + jj;
#pragma unroll
                for (int g = 0; g < 4; ++g) { u32x2 wv; wv.x = cvtpk(pvv[jj][4 * g], pvv[jj][4 * g + 1]); wv.y = cvtpk(pvv[jj][4 * g + 2], pvv[jj][4 * g + 3]);
                    *(LAS u32x2*)(pimg + i * 256 + (((4 * jt + g) ^ (i & 15)) << 4) + 8 * hh) = wv; } }
#pragma unroll
            for (int i2 = 0; i2 < 8; ++i2) { const int idx = tid + 512 * i2, j = idx >> 5, cc = idx & 31;
                const u32x4 vv = *(const u32x4*)(rv + (rowc + j) * 1024 + head * 256 + cc * 8);
                *(LAS u32x4*)(vimg + (cc >> 4) * 32768 + offb(j, cc & 15)) = vv; }
        }
        __syncthreads();
        {
            const LAS unsigned char* vh = vimg + (w >> 2) * 32768;
#pragma unroll
            for (int ks = 0; ks < ((dbg & 4) ? 0 : 8); ++ks) {
                const unsigned r0 = 16 * ks + 8 * hh + trq, r1 = r0 + 4, ch = 4 * (w & 3) + 2 * trblk + (trp >> 1);
                const bf16x8 a = cat8(vtr(vh + offb(r0, ch) + 8 * (trp & 1)), vtr(vh + offb(r1, ch) + 8 * (trp & 1)));
#pragma unroll
                for (int it = 0; it < 4; ++it) { const int i = 32 * it + c; acc[it] = MFMA32(a, *(const LAS bf16x8*)(pimg + i * 256 + (((2 * ks + hh) ^ (i & 15)) << 4)), acc[it]); }
                if (ks & 1) asm volatile("" ::: "memory");
            }
        }
        u32x4 gq[8];
#pragma unroll
        for (int i2 = 0; i2 < 8; ++i2) { const int idx = tid + 512 * i2, j = idx >> 5, cc = idx & 31; gq[i2] = *(const u32x4*)(rg + (rowc + j) * 1024 + head * 256 + cc * 8); }
#pragma unroll
        for (int it = 0; it < 4; ++it) { float s1 = 0.f, s2 = 0.f;
#pragma unroll
            for (int r = 0; r < 16; ++r) { s1 += acc[it][r]; s2 += acc[it][r] * acc[it][r]; }
            s1 += __shfl_xor(s1, 32); s2 += __shfl_xor(s2, 32);
            if (hh == 0) *(LAS f32x2*)(part + (w * 128 + 32 * it + c) * 2) = (f32x2){s1, s2}; }
        __syncthreads();
#pragma unroll
        for (int it = 0; it < 4; ++it) { const int i = 32 * it + c; float s1 = 0.f, s2 = 0.f;
#pragma unroll
            for (int ww = 0; ww < 8; ++ww) { const f32x2 pp = *(const LAS f32x2*)(part + (ww * 128 + i) * 2); s1 += pp[0]; s2 += pp[1]; }
            const float mean = s1 * (1.0f / 256.0f); const float var = fmaxf(s2 * (1.0f / 256.0f) - mean * mean, 0.f); const float rstd = 1.0f / sqrtf(var + LN_EPS);
#pragma unroll
            for (int g = 0; g < 4; ++g) { f32x4 y; y[0] = (acc[it][4 * g] - mean) * rstd; y[1] = (acc[it][4 * g + 1] - mean) * rstd; y[2] = (acc[it][4 * g + 2] - mean) * rstd; y[3] = (acc[it][4 * g + 3] - mean) * rstd;
                *(LAS f32x4*)(X.lds + i * 1024 + (((8 * w + hh + 2 * g) ^ (i & 15)) << 4)) = y; }
        }
        __syncthreads();
#pragma unroll
        for (int i2 = 0; i2 < 8; ++i2) { const int idx = tid + 512 * i2, j = idx >> 5, cc = idx & 31;
            const f32x4 y0 = *(const LAS f32x4*)(X.lds + j * 1024 + (((2 * cc) ^ (j & 15)) << 4)), y1 = *(const LAS f32x4*)(X.lds + j * 1024 + (((2 * cc + 1) ^ (j & 15)) << 4));
            const u32x4 gw = gq[i2]; u32x4 wv;
#define RO_G(gwc, ya, yb) ({ const float ga = bflo(gwc), gb = bfhi(gwc); cvtpk(ga / (1.f + __expf(-ga)) * (ya), gb / (1.f + __expf(-gb)) * (yb)); })
            wv.x = RO_G(gw.x, y0[0], y0[1]); wv.y = RO_G(gw.y, y0[2], y0[3]); wv.z = RO_G(gw.z, y1[0], y1[1]); wv.w = RO_G(gw.w, y1[2], y1[3]);
#undef RO_G
            *(u32x4*)(mix + (rowc + j) * D + 1024 + head * 256 + cc * 8) = wv; }
        __syncthreads();
    }
}

DI void phase_ret_naive(const Ctx& X) {
    const bf16_t* rq = (const bf16_t*)(X.ws + WS_B) + (size_t)3 * T * 1024; const bf16_t* rk = rq + (size_t)T * 1024; const bf16_t* rv = rk + (size_t)T * 1024;
    LAS float* qsm = (LAS float*)X.lds;
    LAS float* ksm = qsm + 16 * 256;
    LAS float* vsm = ksm + 16 * 256;
    LAS float* yp = vsm + 16 * 64;
    const int e = X.tid_f() & 63, dq = X.wave;
    for (int it = X.vcu; it < 16 * 2 * 4; it += X.G) {
        const int eq = it & 3, dir = (it >> 2) & 1, bh = it >> 3, b = bh >> 2, hh = bh & 3;
        const float gam = expf(dir ? X.ldb()[hh] : X.ldf()[hh]);
        float* ybuf = (float*)(X.ws + (dir ? WS_YB : WS_YF));
        float st[32];
#pragma unroll
        for (int i = 0; i < 32; ++i) st[i] = 0.f;
        for (int blk = 0; blk < SEQ / 16; ++blk) {
            const int t0 = dir ? (SEQ - 16 - 16 * blk) : 16 * blk;
            const size_t row0 = (size_t)b * SEQ + t0;
            {
                const int tt = X.tid_f() >> 5, c8 = (X.tid_f() & 31) * 8;
                const u32x4 qw = *(const u32x4*)(rq + (row0 + tt) * 1024 + hh * 256 + c8), kw = *(const u32x4*)(rk + (row0 + tt) * 1024 + hh * 256 + c8);
                LAS float* qd = qsm + tt * 256 + c8; LAS float* kd = ksm + tt * 256 + c8;
                qd[0] = bflo(qw.x); qd[1] = bfhi(qw.x); qd[2] = bflo(qw.y); qd[3] = bfhi(qw.y); qd[4] = bflo(qw.z); qd[5] = bfhi(qw.z); qd[6] = bflo(qw.w); qd[7] = bfhi(qw.w);
                kd[0] = bflo(kw.x); kd[1] = bfhi(kw.x); kd[2] = bflo(kw.y); kd[3] = bfhi(kw.y); kd[4] = bflo(kw.z); kd[5] = bfhi(kw.z); kd[6] = bflo(kw.w); kd[7] = bfhi(kw.w);
                if (X.tid_f() < 256) { const int t2 = X.tid_f() >> 4, c4 = (X.tid_f() & 15) * 4; const u32x2 vw = *(const u32x2*)(rv + (row0 + t2) * 1024 + hh * 256 + eq * 64 + c4);
                    LAS float* vd = vsm + t2 * 64 + c4; vd[0] = bflo(vw.x); vd[1] = bfhi(vw.x); vd[2] = bflo(vw.y); vd[3] = bfhi(vw.y); }
            }
            __syncthreads();
#pragma unroll 1
            for (int i = 0; i < 16; ++i) {
                const int tt = dir ? 15 - i : i;
                const float vv = vsm[tt * 64 + e];
                const LAS float* kq = ksm + tt * 256 + dq * 32; const LAS float* qq = qsm + tt * 256 + dq * 32;
                float y = 0.f;
                if (dir == 0) {
#pragma unroll
                    for (int d = 0; d < 32; ++d) { st[d] = gam * st[d] + kq[d] * vv; y += qq[d] * st[d]; }
                } else {
#pragma unroll
                    for (int d = 0; d < 32; ++d) { y += qq[d] * st[d]; st[d] = gam * st[d] + kq[d] * vv; }
                    y *= gam;
                }
                yp[(dq * 16 + tt) * 64 + e] = y;
            }
            __syncthreads();
            for (int o = X.tid_f(); o < 16 * 64; o += NTHREADS) {
                const int tt = o >> 6, ee = o & 63; float y = 0.f;
#pragma unroll
                for (int q = 0; q < 8; ++q) y += yp[(q * 16 + tt) * 64 + ee];
                ybuf[(row0 + tt) * 1024 + hh * 256 + eq * 64 + ee] = y;
            }
            __syncthreads();
        }
    }
}

DI void phase_ret_fin_naive(const Ctx& X) {
    const float* yf = (const float*)(X.ws + WS_YF); const float* yb = (const float*)(X.ws + WS_YB);
    const bf16_t* rg = (const bf16_t*)(X.ws + WS_B) + (size_t)6 * T * 1024;
    bf16_t* mix = (bf16_t*)(X.ws + WS_A);
    for (int it = X.gw; it < T * RH; it += X.NGW) {
        const int row = it >> 2, hh = it & 3; const size_t off = (size_t)row * 1024 + hh * 256 + 4 * X.lane_f();
        f32x4 y = *(const f32x4*)(yf + off) + *(const f32x4*)(yb + off);
        const float mean = wave_sum((y[0] + y[1]) + (y[2] + y[3])) * (1.0f / 256.0f);
        y = y - mean;
        const float var = wave_sum((y[0] * y[0] + y[1] * y[1]) + (y[2] * y[2] + y[3] * y[3])) * (1.0f / 256.0f);
        const float rstd = 1.0f / sqrtf(var + LN_EPS);
        const u32x2 gw = *(const u32x2*)(rg + off);
        const float g0 = bflo(gw.x), g1 = bfhi(gw.x), g2 = bflo(gw.y), g3 = bfhi(gw.y);
        f32x4 o; o[0] = g0 / (1.f + expf(-g0)) * y[0] * rstd; o[1] = g1 / (1.f + expf(-g1)) * y[1] * rstd; o[2] = g2 / (1.f + expf(-g2)) * y[2] * rstd; o[3] = g3 / (1.f + expf(-g3)) * y[3] * rstd;
        u32x2 w; w.x = pk2(o[0], o[1]); w.y = pk2(o[2], o[3]);
        *(u32x2*)(mix + (size_t)row * D + 1024 + hh * 256 + 4 * X.lane_f()) = w;
    }
}

DI void phase_w2_copy(const Ctx& X) {
    LAS float* scr = (LAS float*)(X.lds + X.wave * TR_SCR);
    bf16_t* W2 = (bf16_t*)(X.ws + WS_W2);
    unsigned* ctr = (unsigned*)(X.ws + CTL_WQ);
    constexpr int I_2 = (FF / 64) * (D / 64);
    for (;;) {
        unsigned it0 = 0;
        if (X.lane_f() == 0) it0 = __hip_atomic_fetch_add(ctr, 2u, __ATOMIC_RELAXED, __HIP_MEMORY_SCOPE_AGENT);
        it0 = (unsigned)__builtin_amdgcn_readfirstlane((int)it0);
        if (it0 >= (unsigned)(NE * I_2)) break;
        for (int j = 0; j < 2; ++j) {
            const int it = (int)it0 + j; const int e = it / I_2, r = it % I_2;
            transpose_item(X.w2() + (size_t)e * FF * D, FF, D, W2 + (size_t)e * D * FF, RowId{}, scr, r, X.lane_f());
        }
    }
}

DI void phase_route(const Ctx& X, const int parts) {
    if (parts & 1) {
        LAS float* scr = (LAS float*)(X.lds + X.wave * TR_SCR);
        bf16_t* W13 = (bf16_t*)(X.ws + WS_W13); bf16_t* W2 = (bf16_t*)(X.ws + WS_W2);
        constexpr int I_1 = (D / 64) * (FF / 64);
        for (int it = X.gw; it < NE * 2 * I_1; it += X.NGW) {
            const int e = it / (2 * I_1); const int r = it % (2 * I_1);
            if (r < I_1) transpose_item(X.w1() + (size_t)e * D * FF, D, FF, W13 + (size_t)e * 1024 * D, RowGate{0}, scr, r, X.lane_f());
            else transpose_item(X.w3() + (size_t)e * D * FF, D, FF, W13 + (size_t)e * 1024 * D, RowGate{1}, scr, r - I_1, X.lane_f());
        }
    }
    __syncthreads();
    const float* t = (const float*)(X.ws + WS_T); const float* part = (const float*)(X.ws + WS_STAT1);
    const float* mod = (const float*)(X.ws + CTL_MOD); const float* WRt = (const float*)(X.ws + WS_WR);
    bf16_t* h2 = (bf16_t*)(X.ws + WS_H2);
    unsigned* slot = (unsigned*)(X.ws + WS_SLOT); float* wt = (float*)(X.ws + WS_WT); unsigned* lists = (unsigned*)(X.ws + WS_LIST); unsigned* cnt = (unsigned*)(X.ws + CTL_CNT);
    const bf16_t* WRh = (const bf16_t*)(X.ws + WS_WR + 512 * 1024); const bf16_t* WRl = (const bf16_t*)(X.ws + WS_WR + 768 * 1024);
    const float* PP = (const float*)(X.ws + WS_WR + 1024 * 1024);
    LAS float* lgl = (LAS float*)(X.lds + X.wave * 4096);
    if (parts & 2) for (int grp = X.gw; grp < T / 16; grp += X.NGW) {
        const int row0 = grp * 16, b = row0 / SEQ, r = X.lane_f() & 15, kq = X.lane_f() >> 4, row = row0 + r;
        float ps = 0.f, pq = 0.f;
        { const f32x4* pp = (const f32x4*)(part + ((size_t)row * 32 + kq * 8) * 2);
#pragma unroll
          for (int i = 0; i < 4; ++i) { const f32x4 x = pp[i]; ps += x[0] + x[2]; pq += x[1] + x[3]; } }
        ps += __shfl_xor(ps, 16); ps += __shfl_xor(ps, 32); pq += __shfl_xor(pq, 16); pq += __shfl_xor(pq, 32);
        const float mean = ps * (1.0f / D); const float var = fmaxf(pq * (1.0f / D) - mean * mean, 0.f); const float rstd = 1.0f / sqrtf(var + LN_EPS);
        const float* P1 = PP + ((size_t)b * 2) * D + 8 * kq; const float* P2 = P1 + D;
        const bf16_t* trow = (const bf16_t*)t + (size_t)row * D + 8 * kq; bf16_t* hrow = h2 + (size_t)row * D + 8 * kq;
        const bf16_t* wh = WRh + (size_t)r * D + 8 * kq; const bf16_t* wl_ = WRl + (size_t)r * D + 8 * kq;
        f32x4 acc[3];
#pragma unroll
        for (int ct = 0; ct < 3; ++ct) acc[ct] = (f32x4){0.f, 0.f, 0.f, 0.f};
#pragma unroll 4
        for (int m = 0; m < 64; ++m) {
            const u32x4 tw = *(const u32x4*)(trow + 32 * m); const f32x4 ta = {bflo(tw.x), bfhi(tw.x), bflo(tw.y), bfhi(tw.y)}, tb = {bflo(tw.z), bfhi(tw.z), bflo(tw.w), bfhi(tw.w)};
            const f32x4 p1a = *(const f32x4*)(P1 + 32 * m), p1b = *(const f32x4*)(P1 + 32 * m + 4), p2a = *(const f32x4*)(P2 + 32 * m), p2b = *(const f32x4*)(P2 + 32 * m + 4);
            const f32x4 ha = (ta - mean) * rstd * p1a + p2a, hb = (tb - mean) * rstd * p1b + p2b;
            u32x4 hi; hi.x = cvtpk(ha[0], ha[1]); hi.y = cvtpk(ha[2], ha[3]); hi.z = cvtpk(hb[0], hb[1]); hi.w = cvtpk(hb[2], hb[3]);
            u32x4 lo; lo.x = cvtpk(ha[0] - bflo(hi.x), ha[1] - bfhi(hi.x)); lo.y = cvtpk(ha[2] - bflo(hi.y), ha[3] - bfhi(hi.y)); lo.z = cvtpk(hb[0] - bflo(hi.z), hb[1] - bfhi(hi.z)); lo.w = cvtpk(hb[2] - bflo(hi.w), hb[3] - bfhi(hi.w));
            *(u32x4*)(hrow + 32 * m) = hi;
            if (!(parts & 16)) {
                const bf16x8 ahi = __builtin_bit_cast(bf16x8, hi), alo = __builtin_bit_cast(bf16x8, lo);
#pragma unroll
                for (int ct = 0; ct < 3; ++ct) {
                    const bf16x8 bh = *(const bf16x8*)(wh + (size_t)ct * 16 * D + 32 * m), bl = *(const bf16x8*)(wl_ + (size_t)ct * 16 * D + 32 * m);
                    acc[ct] = __builtin_amdgcn_mfma_f32_16x16x32_bf16(ahi, bh, acc[ct], 0, 0, 0);
                    acc[ct] = __builtin_amdgcn_mfma_f32_16x16x32_bf16(ahi, bl, acc[ct], 0, 0, 0);
                    acc[ct] = __builtin_amdgcn_mfma_f32_16x16x32_bf16(alo, bh, acc[ct], 0, 0, 0);
                }
            }
        }
        if (parts & 16) continue;
#pragma unroll
        for (int ct = 0; ct < 3; ++ct)
#pragma unroll
            for (int g = 0; g < 4; ++g) lgl[(4 * kq + g) * 48 + 16 * ct + r] = acc[ct][g];
        LDS_WAIT();
        if (X.lane_f() < 16) {
            const LAS float* lg = lgl + X.lane_f() * 48;
            float gl[4];
#pragma unroll
            for (int g = 0; g < 4; ++g) gl[g] = lg[32 + g] + X.b_group()[g];
            int gs = 0; float gm = gl[0];
#pragma unroll
            for (int g = 1; g < 4; ++g) if (gl[g] > gm) { gm = gl[g]; gs = g; }
            float den = 0.f;
#pragma unroll
            for (int g = 0; g < 4; ++g) den += expf(gl[g] - gm);
            const float pg = 1.0f / den;
            float sl[8];
#pragma unroll
            for (int e = 0; e < 8; ++e) sl[e] = lg[gs * 8 + e] + X.b_sub()[gs * 8 + e];
            int i0 = 0; float v0 = sl[0];
#pragma unroll
            for (int e = 1; e < 8; ++e) if (sl[e] > v0) { v0 = sl[e]; i0 = e; }
            int i1 = -1; float v1 = -3.0e38f;
#pragma unroll
            for (int e = 0; e < 8; ++e) if (e != i0 && sl[e] > v1) { v1 = sl[e]; i1 = e; }
            const float e1 = expf(v1 - v0); const float w0 = pg / (1.0f + e1), w1 = pg * e1 / (1.0f + e1);
            if (!(parts & 8)) {
                const int rw = row0 + X.lane_f(), ea = gs * 8 + i0, eb = gs * 8 + i1;
                const unsigned pa = atomicAdd(cnt + ea * 64, 1u), pb = atomicAdd(cnt + eb * 64, 1u);
                lists[(size_t)ea * 65536 + pa] = (unsigned)rw; lists[(size_t)eb * 65536 + pb] = (unsigned)rw;
                slot[rw * 2] = ((unsigned)ea << 20) | pa; slot[rw * 2 + 1] = ((unsigned)eb << 20) | pb;
                wt[rw * 2] = w0; wt[rw * 2 + 1] = w1;
            }
        }
        LDS_WAIT();
    }
}

DI int moe_prefix(const Ctx& X, LAS int* pre) {
    const unsigned* cnt = (const unsigned*)(X.ws + CTL_CNT);
    if (X.tid_f() == 0) { int s = 0; for (int e = 0; e < NE; ++e) { pre[e] = s; s += ((int)__hip_atomic_load(cnt + e * 64, __ATOMIC_RELAXED, __HIP_MEMORY_SCOPE_AGENT) + 255) >> 8; } pre[NE] = s; }
    __syncthreads();
    return pre[NE];
}

DI void phase_final(const Ctx& X) {
    LAS int* pre = (LAS int*)(X.lds + LDS_MISC);
    moe_prefix(X, pre);
    const float* t = (const float*)(X.ws + WS_T); const float* part = (const float*)(X.ws + WS_STAT1);
    const float* mod = (const float*)(X.ws + CTL_MOD);
    const bf16_t* Y = (const bf16_t*)(X.ws + WS_Y);
    const unsigned* slot = (const unsigned*)(X.ws + WS_SLOT); const float* wt = (const float*)(X.ws + WS_WT);
    LAS float* prm = (LAS float*)(X.lds + 1024);
    { __syncthreads();
      for (int i = X.tid_f(); i < D; i += NTHREADS) { prm[i] = X.ln1_g()[i]; prm[D + i] = X.ln1_b()[i]; prm[3 * D + i] = X.ln2_g()[i]; prm[4 * D + i] = X.ln2_b()[i];
#pragma unroll
          for (int bb = 0; bb < 4; ++bb) prm[(5 + bb) * D + i] = 1.0f + mod[(size_t)bb * 6 * D + 5 * D + i]; }
      __syncthreads(); }
    {
      u32x4 nsl = *(const u32x4*)(slot + (size_t)4 * X.gw); f32x4 nwt = *(const f32x4*)(wt + (size_t)4 * X.gw);
#pragma unroll 1
      for (int k8 = 0; k8 < 8; ++k8) {
        const int rowa = 2 * (X.gw + k8 * X.NGW);
        const int b = rowa / SEQ; const LAS float* g2l = prm + (5 + b) * D;
        f32x4 tv[2][8]; u32x2 ya[2][8], yb[2][8]; float w0[2], w1[2], mean[2], rstd[2];
        const u32x4 csl = nsl; const f32x4 cwt = nwt;
#pragma unroll
        for (int rr = 0; rr < 2; ++rr) {
            const int row = rowa + rr;
            const unsigned s0 = rr ? csl.z : csl.x, s1 = rr ? csl.w : csl.y; w0[rr] = rr ? cwt[2] : cwt[0]; w1[rr] = rr ? cwt[3] : cwt[1];
            const size_t r0 = (size_t)pre[s0 >> 20] * 256 + (s0 & 0xfffffu), r1 = (size_t)pre[s1 >> 20] * 256 + (s1 & 0xfffffu);
            const u32x2* tr = (const u32x2*)((const bf16_t*)t + (size_t)row * D) + X.lane_f();
            const u32x2* y0 = (const u32x2*)(Y + r0 * D) + X.lane_f(); const u32x2* y1 = (const u32x2*)(Y + r1 * D) + X.lane_f();
#pragma unroll
            for (int j = 0; j < 8; ++j) { const u32x2 tw = tr[64 * j]; tv[rr][j] = (f32x4){bflo(tw.x), bfhi(tw.x), bflo(tw.y), bfhi(tw.y)}; ya[rr][j] = y0[64 * j]; yb[rr][j] = y1[64 * j]; }
            float ps = 0.f, pq = 0.f; if (X.lane_f() < 32) { const f32x2 p = *(const f32x2*)(part + ((size_t)row * 32 + X.lane_f()) * 2); ps = p[0]; pq = p[1]; }
            ps = wave_sum(ps); pq = wave_sum(pq);
            mean[rr] = ps * (1.0f / D); const float var = fmaxf(pq * (1.0f / D) - mean[rr] * mean[rr], 0.f); rstd[rr] = 1.0f / sqrtf(var + LN_EPS);
        }
        if (k8 < 7) { const size_t nrow = (size_t)2 * (X.gw + (k8 + 1) * X.NGW); nsl = *(const u32x4*)(slot + nrow * 2); nwt = *(const f32x4*)(wt + nrow * 2); }
        float s[2] = {0.f, 0.f};
#pragma unroll
        for (int j = 0; j < 8; ++j) {
            const int c = 4 * X.lane_f() + 256 * j;
            const f32x4 gg = *(const LAS f32x4*)(prm + c), bb = *(const LAS f32x4*)(prm + D + c), g2v = *(const LAS f32x4*)(g2l + c);
#pragma unroll
            for (int rr = 0; rr < 2; ++rr) {
                const f32x4 x1 = (tv[rr][j] - mean[rr]) * rstd[rr] * gg + bb;
                const u32x2 a = ya[rr][j], bq = yb[rr][j];
                f32x4 f; f[0] = w0[rr] * bflo(a.x) + w1[rr] * bflo(bq.x); f[1] = w0[rr] * bfhi(a.x) + w1[rr] * bfhi(bq.x); f[2] = w0[rr] * bflo(a.y) + w1[rr] * bflo(bq.y); f[3] = w0[rr] * bfhi(a.y) + w1[rr] * bfhi(bq.y);
                const f32x4 uu = DN_ALPHA * x1 + g2v * f; tv[rr][j] = uu;
                s[rr] += (uu[0] + uu[1]) + (uu[2] + uu[3]);
            }
        }
#pragma unroll
        for (int rr = 0; rr < 2; ++rr) {
            const float m2 = wave_sum(s[rr]) * (1.0f / D); float q = 0.f;
#pragma unroll
            for (int j = 0; j < 8; ++j) { tv[rr][j] = tv[rr][j] - m2; q += (tv[rr][j][0] * tv[rr][j][0] + tv[rr][j][1] * tv[rr][j][1]) + (tv[rr][j][2] * tv[rr][j][2] + tv[rr][j][3] * tv[rr][j][3]); }
            const float rs2 = 1.0f / sqrtf(wave_sum(q) * (1.0f / D) + LN_EPS);
            f32x4* orow = (f32x4*)(X.out + (size_t)(rowa + rr) * D) + X.lane_f();
#pragma unroll
            for (int j = 0; j < 8; ++j) { const int c = 4 * X.lane_f() + 256 * j; __builtin_nontemporal_store(tv[rr][j] * rs2 * *(const LAS f32x4*)(prm + 3 * D + c) + *(const LAS f32x4*)(prm + 4 * D + c), orow + 64 * j); }
        }
      }
    }
}

#define XB_TMO      128
#define XB_XCNT(j)  (256  + 64 * (j))
#define XB_XSUB(j)  (1280 + 64 * (j))
#define XB_XGEN(j)  (2304 + 64 * (j))
#define XB_TOP      3328
#define XB_TOPGEN   3392
#define XCD_BAR_WORDS 3456
#define XB_SPIN_CAP (1u << 22)
DI unsigned xb_ld(unsigned* p)              { return __hip_atomic_load(p, __ATOMIC_RELAXED, __HIP_MEMORY_SCOPE_AGENT); }
DI unsigned xb_add(unsigned* p, unsigned v) { return __hip_atomic_fetch_add(p, v, __ATOMIC_RELAXED, __HIP_MEMORY_SCOPE_AGENT); }
DI unsigned xb_xcc_id() { return (unsigned)__builtin_amdgcn_s_getreg((3 << 11) | 20) & 0xFu; }
#define XB_SPIN(cond, bar) do { unsigned _sp = 0; while (cond) { __builtin_amdgcn_s_sleep(1); \
    if ((++_sp & 255u) == 0u) { if (xb_ld(&(bar)[XB_TMO])) break; if (_sp > XB_SPIN_CAP) { atomicAdd(&(bar)[XB_TMO], 1u); break; } } } } while (0)
struct XcdBarrier { unsigned* bar; unsigned x; volatile LAS unsigned* st; };
DI XcdBarrier xcd_barrier_post(unsigned* bar, volatile LAS unsigned* st, const bool t0) {
    XcdBarrier b; b.bar = bar; b.x = xb_xcc_id(); b.st = st;
    if (t0) (void)xb_add(&bar[XB_XCNT(b.x)], 1u);
    return b;
}
DI void xcd_barrier_complete(unsigned* bar, unsigned x, unsigned& nloc, unsigned& nx) {
    const unsigned G = gridDim.x * gridDim.y * gridDim.z;
    unsigned sum, cnt, mine, sp = 0u;
    for (;;) {
        sum = 0u; cnt = 0u; mine = 0u;
#pragma unroll
        for (unsigned j = 0; j < 16; ++j) { const unsigned c = xb_ld(&bar[XB_XCNT(j)]); sum += c; cnt += (c > 0u) ? 1u : 0u; mine = (j == x) ? c : mine; }
        if (sum == G) break;
        __builtin_amdgcn_s_sleep(1);
        if ((++sp & 255u) == 0u) { if (xb_ld(&bar[XB_TMO])) break; if (sp > XB_SPIN_CAP) { atomicAdd(&bar[XB_TMO], 1u); break; } }
    }
    nloc = mine > 0u ? mine : 1u; nx = cnt > 0u ? cnt : 1u;
}
DI void xcd_barrier(const XcdBarrier& b, const bool t0) {
    asm volatile("s_waitcnt vmcnt(0)" ::: "memory");
    __syncthreads();
    if (t0) {
        unsigned* bar = b.bar;
        __builtin_amdgcn_s_waitcnt(0);
        unsigned nloc = b.st[0], nx = b.st[1];
        if (nloc == 0u) { xcd_barrier_complete(bar, b.x, nloc, nx); b.st[0] = nloc; b.st[1] = nx; }
        const unsigned old = xb_add(&bar[XB_XSUB(b.x)], 1u);
        const unsigned gen = old / nloc;
        if (old + 1u == (gen + 1u) * nloc) {
            __builtin_amdgcn_fence(__ATOMIC_RELEASE, "agent");
            asm volatile("s_waitcnt vmcnt(0)" ::: "memory");
            const unsigned og = xb_add(&bar[XB_TOP], 1u);
            const unsigned tg = og / nx;
            if (og + 1u == (tg + 1u) * nx) xb_add(&bar[XB_TOPGEN], 1u);
            else XB_SPIN(xb_ld(&bar[XB_TOPGEN]) == tg, bar);
            __builtin_amdgcn_fence(__ATOMIC_ACQUIRE, "agent");
            xb_add(&bar[XB_XGEN(b.x)], 1u);
            asm volatile("s_waitcnt vmcnt(0)" ::: "memory");
        } else {
            XB_SPIN(xb_ld(&bar[XB_XGEN(b.x)]) == gen, bar);
            __builtin_amdgcn_fence(__ATOMIC_ACQUIRE, "agent");
            asm volatile("s_waitcnt vmcnt(0)" ::: "memory");
        }
    }
    __syncthreads();
}

__global__ void __launch_bounds__(NTHREADS, 2) fwd_kernel(Args args) {
    extern __shared__ __attribute__((aligned(16))) unsigned char lds_raw[];
    Ctx X;
    X.lds = (LAS unsigned char*)lds_raw;
    X.wave = __builtin_amdgcn_readfirstlane((int)(threadIdx.x >> 6));
    X.G = gridDim.x; { const int bx = blockIdx.x; X.vcu = (X.G % 8 == 0) ? (bx % 8) * (X.G / 8) + bx / 8 : bx; }
    X.gw = X.vcu * NWAVES + X.wave; X.NGW = X.G * NWAVES;
    X.kin = (const void* const*)__builtin_amdgcn_kernarg_segment_ptr();
    X.out = args.out; X.ws = args.ws;
    const int lo = args.ph_lo, hi = args.ph_hi;
    if (args.ph_hi > 1000) cg::this_grid().sync();
    volatile LAS unsigned* bst = (volatile LAS unsigned*)(X.lds + LDS_BYTES - 16);
    if (X.tid_f() < 4) bst[X.tid_f()] = 0u;
    __syncthreads();
    XcdBarrier gbar; gbar.bar = (unsigned*)(X.ws + CTL_BAR); gbar.x = 0; gbar.st = bst;
    if (hi - lo > 1) gbar = xcd_barrier_post((unsigned*)(X.ws + CTL_BAR), bst, X.tid_f() == 0);
#ifndef PH_MASK
#define PH_MASK 0x3ff
#endif
#define IN(k) (((PH_MASK >> (k)) & 1) && lo <= (k) && (k) < hi)
#ifndef DBL_MASK
#define DBL_MASK 0
#endif
#ifndef ATTN_NAIVE
#define ATTN_NAIVE 0
#endif
#ifndef RET_NAIVE
#define RET_NAIVE 0
#endif
#define DBL(k) ((DBL_MASK >> (k)) & 1)
#ifndef USE_CG_SYNC
#define USE_CG_SYNC 0
#endif
#define GSYNC() do { if (USE_CG_SYNC) cg::this_grid().sync(); else xcd_barrier(gbar, X.tid_f() == 0); } while (0)
#define SEAM(k) do { if (IN(k) && IN((k) + 1)) { GSYNC(); } } while (0)

    if (IN(0)) { phase_mod(X); } SEAM(0);
#ifndef P1_PARTS2
#define P1_PARTS2 7
#endif
#define PH1 { phase_pre(X); }
#define PH1B { phase_pre(X, P1_PARTS2); }
#ifndef P2_DBG2
#define P2_DBG2 0
#endif
#define PH2 { pg8::StaticOrder S; S.init(T, NIN, D, X.G, (int)blockIdx.x, X.ws + WS_A, X.ws + WS_WIN); \
        const unsigned* tabA = (const unsigned*)(X.ws + WS_TAB); const unsigned* tabR = tabA + (size_t)T * 16; \
        EpiInProj E{(bf16_t*)(X.ws + WS_B), tabA, tabR, P2DBG}; \
        pg8::gemm_phase<EpiInProj, pg8::StaticOrder, false>(X.lds, D, S, E, X.wave); }
#ifndef P3_ONLY
#define P3_ONLY 3
#endif
#define PH3 { if (!(X.vcu & 1)) { phase_ret_states64(X, X.vcu >> 1); __syncthreads(); } phase_attn(X, 0, 1); }
#ifndef P3_PARTS2
#define P3_PARTS2 3
#endif
#ifndef P3_DBG
#define P3_DBG 0
#endif
#define PH3B PH3
#ifndef P4_DBG
#define P4_DBG 1
#endif
#define PH4 { if (RET_NAIVE) phase_ret_fin_naive(X); else phase_ret_out(X); }
#define PH4B { phase_ret_out(X, P4_DBG); }
#define PH5 { pg8::StaticOrder S; S.init(T, D, D, X.G, (int)blockIdx.x, X.ws + WS_A, X.ws + WS_WOUT); \
        float* mu0 = (float*)(X.ws + WS_STAT0); \
        EpiOutProj E{X.x(), mu0, mu0 + T, X.ln0_g(), X.ln0_b(), (const float*)(X.ws + CTL_MOD), (float*)(X.ws + WS_T), (float*)(X.ws + WS_STAT1)}; \
        pg8::gemm_phase<EpiOutProj, pg8::StaticOrder, false>(X.lds, D, S, E, X.wave); }
#ifndef P6_PARTS2
#define P6_PARTS2 3
#endif
#define PH6 { phase_route(X, 3); }
#define PH6B { phase_route(X, P6_PARTS2); }
#define PH7 { LAS int* pre = (LAS int*)(X.lds + LDS_MISC); \
        const int nmt = moe_prefix(X, pre); \
        MoeOrder S{pre, 4, X.G, X.vcu, nmt * 4, (const char*)(X.ws + WS_H2), (const char*)(X.ws + WS_W13), (size_t)1024 * D * 2, (size_t)256 * D * 2, 0, (const unsigned*)(X.ws + WS_LIST), (const unsigned*)(X.ws + CTL_CNT), true}; \
        EpiMoeUp E{(bf16_t*)(X.ws + WS_A)}; \
        pg8::gemm_phase<EpiMoeUp, MoeOrder, true, true>(X.lds, D, S, E, X.wave); \
        __syncthreads(); phase_w2_copy(X); }
#define PH8 { LAS int* pre = (LAS int*)(X.lds + LDS_MISC); \
        const int nmt = moe_prefix(X, pre); \
        MoeOrder S{pre, 8, X.G, X.vcu, nmt * 8, (const char*)(X.ws + WS_A), (const char*)(X.ws + WS_W2), (size_t)D * FF * 2, (size_t)256 * FF * 2, (size_t)256 * FF * 2, nullptr, (const unsigned*)(X.ws + CTL_CNT), false}; \
        EpiMoeDown E{(bf16_t*)(X.ws + WS_Y)}; \
        pg8::gemm_phase<EpiMoeDown, MoeOrder, false, true>(X.lds, FF, S, E, X.wave); }
#define PH9 { phase_final(X); }
#define RUNPH(k, BODY) if (IN(k)) { BODY; if (DBL(k)) { GSYNC(); BODY; } } SEAM(k);
    if (IN(1)) { PH1; if (DBL(1)) { GSYNC(); PH1B; } } SEAM(1);
    { int P2DBG = 0; if (IN(2)) { PH2; if (DBL(2)) { GSYNC(); P2DBG = P2_DBG2; PH2; } } SEAM(2); }
    if (IN(3)) { PH3; if (DBL(3)) { GSYNC(); PH3B; } } SEAM(3);
    if (IN(4)) { PH4; if (DBL(4)) { GSYNC(); PH4B; } } SEAM(4);
    RUNPH(5, PH5)
    if (IN(6)) { PH6; if (DBL(6)) { GSYNC(); if ((P6_PARTS2 & 10) == 2) { if (X.vcu == 0 && X.tid_f() < NE) ((unsigned*)(X.ws + CTL_CNT))[X.tid_f() * 64] = 0u; GSYNC(); } PH6B; } } SEAM(6);
    RUNPH(7, PH7) RUNPH(8, PH8)
    if (IN(9)) { PH9; if (DBL(9)) { GSYNC(); PH9; } }
#undef IN
#undef SEAM
}

extern "C" void kernel_launch(void* const* d_in, const int* in_sizes, int n_in, void* d_out, int out_size, void* d_ws, size_t ws_size, hipStream_t stream) {
    static int grid = 0;
    if (grid == 0) {
        if (n_in != 22 || in_sizes[0] != T * D || out_size != T * D || ws_size < WS_END) { fprintf(stderr, "kernel_launch: unexpected shapes (n_in %d, in0 %d, out %d, ws %zu)\n", n_in, n_in > 0 ? in_sizes[0] : -1, out_size, ws_size); grid = -1; return; }
        int dev = 0, cus = 0, per_cu = 0;
        hipGetDevice(&dev); hipDeviceGetAttribute(&cus, hipDeviceAttributeMultiprocessorCount, dev);
        hipFuncSetAttribute((const void*)fwd_kernel, hipFuncAttributeMaxDynamicSharedMemorySize, LDS_BYTES);
        hipOccupancyMaxActiveBlocksPerMultiprocessor(&per_cu, (const void*)fwd_kernel, NTHREADS, LDS_BYTES);
        if (per_cu < 1) { fprintf(stderr, "kernel_launch: occupancy query says %d blocks per CU\n", per_cu); per_cu = 1; }
        (void)hipGetLastError();
        grid = cus;
        if (grid != 256) { fprintf(stderr, "kernel_launch: this build's phase 3 work split assumes 256 CUs (8 XCDs x 32); found %d\n", cus); grid = -1; return; }
    }
    if (grid < 0) return;
    hipMemsetAsync((char*)d_ws + WS_CTL, 0, CTL_ZERO_BYTES, stream);
    Args a{};
    for (int i = 0; i < 22; ++i) a.in[i] = d_in[i];
    a.out = (float*)d_out; a.ws = (unsigned char*)d_ws;
#if MK_PER_PHASE_LAUNCH
    for (int p = 0; p < NPHASE; ++p) {
        a.ph_lo = p; a.ph_hi = p + 1;
        hipLaunchKernelGGL(fwd_kernel, dim3(grid), dim3(NTHREADS), LDS_BYTES, stream, a);
    }
#else
    a.ph_lo = 0; a.ph_hi = NPHASE;
    void* kargs[] = {&a};
    hipError_t e = hipLaunchCooperativeKernel((const void*)fwd_kernel, dim3(grid), dim3(NTHREADS), kargs, LDS_BYTES, stream);
    if (e != hipSuccess) fprintf(stderr, "cooperative launch failed: %s (grid %d)\n", hipGetErrorString(e), grid);
#endif
}
```

```cpp
#include <hip/hip_runtime.h>
#include <hip/hip_cooperative_groups.h>
#include <cstdio>
#include <cstdint>
namespace cg = cooperative_groups;

#ifndef MK_PER_PHASE_LAUNCH
#define MK_PER_PHASE_LAUNCH 0
#endif

#define LAS __attribute__((address_space(3)))
#define GAS __attribute__((address_space(1)))
typedef unsigned short bf16_t;
typedef short bf16x8 __attribute__((ext_vector_type(8)));
typedef float f32x4 __attribute__((ext_vector_type(4)));
typedef float f32x2 __attribute__((ext_vector_type(2)));
typedef unsigned u32x4 __attribute__((ext_vector_type(4)));
typedef unsigned u32x2 __attribute__((ext_vector_type(2)));
#define DI __device__ __forceinline__

constexpr int D = 2048, BATCH = 4, SEQ = 8192, T = BATCH * SEQ;
constexpr int AW = 1024, NIN = 7168, AH = 8, RH = 4;
constexpr int NE = 32, FF = 512;
constexpr float LN_EPS = 1e-5f;
constexpr float DN_ALPHA = 1.189207115002721f;
constexpr int NWAVES = 8, NTHREADS = 512;
constexpr int NPHASE = 10;

constexpr size_t MiB = 1u << 20;
constexpr size_t WS_CTL = 0, CTL_ZERO_BYTES = 1 * MiB;
constexpr size_t CTL_BAR = 16 * 1024;
constexpr size_t CTL_MOD = 64 * 1024;
constexpr size_t CTL_CNT = 512 * 1024;
constexpr size_t CTL_WQ = 544 * 1024;
constexpr size_t WS_WIN = 2 * MiB;
constexpr size_t WS_WOUT = 30 * MiB;
constexpr size_t WS_W13 = 38 * MiB;
constexpr size_t WS_W2 = 166 * MiB;
constexpr size_t WS_TAB = 230 * MiB;
constexpr size_t WS_STAT0 = 266 * MiB;
constexpr size_t WS_STAT1 = 267 * MiB;
constexpr size_t WS_SLOT = 275 * MiB;
constexpr size_t WS_WT = WS_SLOT + 256 * 1024;
constexpr size_t WS_LIST = 276 * MiB;
constexpr size_t WS_WR = 284 * MiB;
constexpr size_t WS_A = 288 * MiB;
constexpr size_t WS_B = 416 * MiB;
constexpr size_t WS_T = WS_B, WS_H2 = WS_B + 256 * MiB;
constexpr size_t WS_Y = WS_H2;
constexpr size_t WS_YF = 864 * MiB;
constexpr size_t WS_YB = WS_W13;
constexpr size_t WS_END = 1024 * MiB;

constexpr int LDS_BYTES = 155648;
constexpr int LDS_MISC = 131072;

DI unsigned f2bf(float f) { unsigned u = __float_as_uint(f); return (u + 0x7fffu + ((u >> 16) & 1u)) >> 16; }
typedef __bf16 bf16x2_t __attribute__((ext_vector_type(2)));
DI unsigned cvtpk(float lo, float hi) { f32x2 v = {lo, hi}; bf16x2_t b = __builtin_convertvector(v, bf16x2_t); return __builtin_bit_cast(unsigned, b); }
DI unsigned pk2(float lo, float hi) { return cvtpk(lo, hi); }
DI float bf2f(unsigned h) { return __uint_as_float(h << 16); }
DI float bflo(unsigned w) { return __uint_as_float(w << 16); }
DI float bfhi(unsigned w) { return __uint_as_float(w & 0xffff0000u); }
#define dpp_f(v, ctrl) __int_as_float(__builtin_amdgcn_update_dpp(0, __float_as_int(v), (ctrl), 0xF, 0xF, true))
#define DPP_QP1 0xB1
#define DPP_QP2 0x4E
#define DPP_RHM 0x141
#define DPP_RM  0x140
DI float wave_sum(float v) {
    v += dpp_f(v, DPP_QP1); v += dpp_f(v, DPP_QP2); v += dpp_f(v, DPP_RHM); v += dpp_f(v, DPP_RM);
    const float a = __int_as_float(__builtin_amdgcn_readlane(__float_as_int(v), 0)), b = __int_as_float(__builtin_amdgcn_readlane(__float_as_int(v), 16));
    const float c = __int_as_float(__builtin_amdgcn_readlane(__float_as_int(v), 32)), d = __int_as_float(__builtin_amdgcn_readlane(__float_as_int(v), 48));
    return (a + b) + (c + d);
}
DI float wave_max(float v) {
    v = fmaxf(v, dpp_f(v, DPP_QP1)); v = fmaxf(v, dpp_f(v, DPP_QP2)); v = fmaxf(v, dpp_f(v, DPP_RHM)); v = fmaxf(v, dpp_f(v, DPP_RM));
    const float a = __int_as_float(__builtin_amdgcn_readlane(__float_as_int(v), 0)), b = __int_as_float(__builtin_amdgcn_readlane(__float_as_int(v), 16));
    const float c = __int_as_float(__builtin_amdgcn_readlane(__float_as_int(v), 32)), d = __int_as_float(__builtin_amdgcn_readlane(__float_as_int(v), 48));
    return fmaxf(fmaxf(a, b), fmaxf(c, d));
}
#define LDS_WAIT() asm volatile("s_waitcnt lgkmcnt(0)" ::: "memory")

struct Args { const void* in[22]; float* out; unsigned char* ws; int ph_lo, ph_hi; };

struct Ctx {
    LAS unsigned char* lds;
    int wave, G, vcu, gw, NGW;
    const void* const* kin;
    DI int lane_f() const { int l; asm volatile("v_mbcnt_lo_u32_b32 %0, -1, 0\n\tv_mbcnt_hi_u32_b32 %0, -1, %0" : "=v"(l)); return l; }
    DI int tid_f() const { return wave * 64 + lane_f(); }
    float* out; unsigned char* ws;
    DI const float* x() const { return (const float*)kin[0]; }
    DI const float* c() const { return (const float*)kin[1]; }
    DI const int* positions() const { return (const int*)kin[2]; }
    DI const float* ln0_g() const { return (const float*)kin[3]; }
    DI const float* ln0_b() const { return (const float*)kin[4]; }
    DI const float* w_ada() const { return (const float*)kin[5]; }
    DI const float* b_ada() const { return (const float*)kin[6]; }
    DI const float* w_in() const { return (const float*)kin[7]; }
    DI const float* w_out() const { return (const float*)kin[8]; }
    DI const float* ldf() const { return (const float*)kin[9]; }
    DI const float* ldb() const { return (const float*)kin[10]; }
    DI const float* ln1_g() const { return (const float*)kin[11]; }
    DI const float* ln1_b() const { return (const float*)kin[12]; }
    DI const float* w_group() const { return (const float*)kin[13]; }
    DI const float* b_group() const { return (const float*)kin[14]; }
    DI const float* w_sub() const { return (const float*)kin[15]; }
    DI const float* b_sub() const { return (const float*)kin[16]; }
    DI const float* w1() const { return (const float*)kin[17]; }
    DI const float* w3() const { return (const float*)kin[18]; }
    DI const float* w2() const { return (const float*)kin[19]; }
    DI const float* ln2_g() const { return (const float*)kin[20]; }
    DI const float* ln2_b() const { return (const float*)kin[21]; }
};

namespace pg8 {
constexpr int BM = 256, BK = 64, HALF = 128, HTB = HALF * BK * 2, STAGE_BYTES = 8 * HTB, NXCD = 8, WGM = 8;
__host__ __device__ __forceinline__ int lds_byte(int r, int c) { const int st = (r >> 4) * 2 + (c >> 5), rr = r & 15, cc = c & 31, ob = rr * 64 + cc * 2; return st * 1024 + (ob ^ (((ob >> 9) & 1) << 5)); }
__host__ __device__ __forceinline__ void stage_rc(int b, int& R, int& C) { const int st = b / 1024, sb = b % 1024, swz = sb ^ (((sb >> 9) & 1) << 5); R = (st >> 1) * 16 + swz / 64; C = (st & 1) * 32 + (swz % 64) / 2; }

struct Unit { const char* A; const char* B; const unsigned* rows; int nrows; int pm, pn, e; };

struct StaticOrder {
    int nM, nN, nwg, G, c; const char* A; const char* B; size_t tstepA, tstepB;
    DI void init(int M, int N, int K, int G_, int c_, const void* A_, const void* B_) { nM = M / BM; nN = N / BM; nwg = nM * nN; G = G_; c = c_; A = (const char*)A_; B = (const char*)B_; tstepA = (size_t)BM * K * 2; tstepB = (size_t)BM * K * 2; }
    DI bool next(int i, Unit& u) const {
        const long L = (long)i * G + c; if (L >= nwg) return false;
        int wgid = (int)L; { const int q = nwg / NXCD, r = nwg % NXCD, xcd = wgid % NXCD, off = wgid / NXCD; wgid = (xcd < r ? xcd * (q + 1) : r * (q + 1) + (xcd - r) * q) + off; }
        const int nig = WGM * nN, gid = wgid / nig, fm = gid * WGM, gsz = (nM - fm) < WGM ? (nM - fm) : WGM;
        u.pm = fm + ((wgid % nig) % gsz); u.pn = (wgid % nig) / gsz; u.e = 0; u.rows = nullptr; u.nrows = 0;
        u.A = A + (size_t)u.pm * tstepA; u.B = B + (size_t)u.pn * tstepB; return true;
    }
};

DI unsigned cvt_pk_bf16(float lo, float hi) { unsigned r; asm volatile("v_cvt_pk_bf16_f32 %0, %1, %2" : "=v"(r) : "v"(lo), "v"(hi)); return r; }

__host__ __device__ __forceinline__ int perm32(int rho) { const int n = rho >> 4, i = rho & 15; return 8 * (i >> 2) + 4 * n + (i & 3); }
template <class Epi, class Sched, bool GATHER, bool PERM = false>
DI void gemm_phase(LAS unsigned char* lds, const int K, const Sched& S, const Epi& E, const int wid) {
    int lane; asm volatile("v_mbcnt_lo_u32_b32 %0, -1, 0\n\tv_mbcnt_hi_u32_b32 %0, -1, %0" : "=v"(lane));
    const int tid = wid * 64 + lane, wr = wid >> 2, wc = wid & 3, fr = lane & 15, fq = lane >> 4;
    const int nt = K / BK;
    int Rr[2], Cc[2];
    unsigned voffB[2], voffN[2], vA0[2], vA1[2], nA0[2], nA1[2];
#pragma unroll
    for (int i = 0; i < 2; ++i) { stage_rc(tid * 16 + i * 8192, Rr[i], Cc[i]); voffN[i] = (unsigned)(Rr[i] * K + Cc[i]) * 2u; const int Rb = PERM ? ((Rr[i] & ~31) + perm32(Rr[i] & 31)) : Rr[i]; voffB[i] = (unsigned)(Rb * K + Cc[i]) * 2u; }
    const size_t kstep = (size_t)(BK * 2);
    const size_t hstep = (size_t)HALF * K * 2;
    const unsigned ldsw = (unsigned)wid * 1024u;
    const int aoff = lds_byte(wr * 64 + fr, fq * 8), boff = lds_byte(wc * 32 + fr, fq * 8);
#define PG8_SA(b, h) (((b) * 2 + (h)) * HTB)
#define PG8_SB(b, h) ((4 + (b) * 2 + (h)) * HTB)
#define PG8_STAGE(bufoff, gbase, voff) do { _Pragma("unroll") for (int _i = 0; _i < 2; ++_i) \
        __builtin_amdgcn_global_load_lds((const unsigned*)((const char*)(gbase) + (voff)[_i]), (LAS unsigned*)(lds + (bufoff) + ldsw + _i * 8192), 16, 0, 0); } while (0)
#define PG8_LDA(dst, b, h) do { _Pragma("unroll") for (int m = 0; m < 4; ++m) _Pragma("unroll") for (int k = 0; k < 2; ++k) dst[m][k] = *(const LAS bf16x8*)(lds + PG8_SA(b, h) + aoff + m * 2048 + k * 1024); } while (0)
#define PG8_LDB(dst, b, h) do { _Pragma("unroll") for (int n = 0; n < 2; ++n) _Pragma("unroll") for (int k = 0; k < 2; ++k) dst[n][k] = *(const LAS bf16x8*)(lds + PG8_SB(b, h) + boff + n * 2048 + k * 1024); } while (0)
#define PG8_MMA(ai, bj, At, Bt) do { __builtin_amdgcn_s_setprio(1); _Pragma("unroll") for (int m = 0; m < 4; ++m) _Pragma("unroll") for (int n = 0; n < 2; ++n) _Pragma("unroll") for (int k = 0; k < 2; ++k) \
        acc[ai][bj][m][n] = __builtin_amdgcn_mfma_f32_16x16x32_bf16(Bt[n][k], At[m][k], acc[ai][bj][m][n], 0, 0, 0); __builtin_amdgcn_s_setprio(0); } while (0)
#define PG8_STAGE_A(bufoff, gbase, half_, vo0, vo1) do { if constexpr (GATHER) { if ((half_) == 0) PG8_STAGE(bufoff, gbase, vo0); else PG8_STAGE(bufoff, gbase, vo1); } else { PG8_STAGE(bufoff, (gbase) + ((half_) ? hstep : 0), voffN); } } while (0)
#define PG8_WAIT_V(n) asm volatile("s_waitcnt vmcnt(" #n ")" ::: "memory")
#define PG8_WAIT_L(n) asm volatile("s_waitcnt lgkmcnt(" #n ")" ::: "memory")
#define PG8_BAR __builtin_amdgcn_s_barrier()
#define PG8_SCHED __builtin_amdgcn_sched_barrier(0)
#define PG8_AOFFS(u, o0, o1) do { _Pragma("unroll") for (int _i = 0; _i < 2; ++_i) { \
        if constexpr (GATHER) { const int r0 = Rr[_i], r1 = Rr[_i] + HALF; \
            const unsigned t0 = r0 < (u).nrows ? (u).rows[r0] : 0u, t1 = r1 < (u).nrows ? (u).rows[r1] : 0u; \
            o0[_i] = (t0 * (unsigned)K + (unsigned)Cc[_i]) * 2u; o1[_i] = (t1 * (unsigned)K + (unsigned)Cc[_i]) * 2u; } \
        else { o0[_i] = voffN[_i]; o1[_i] = voffN[_i] + (unsigned)hstep; } } } while (0)
    Unit cur, nxt; int ui = 0;
    if (!S.next(0, cur)) return;
    f32x4 acc[2][2][4][2];
#pragma unroll
    for (int a = 0; a < 2; ++a)
#pragma unroll
        for (int b = 0; b < 2; ++b)
#pragma unroll
            for (int m = 0; m < 4; ++m)
#pragma unroll
                for (int n = 0; n < 2; ++n) acc[a][b][m][n] = (f32x4){0.f, 0.f, 0.f, 0.f};
    bf16x8 At[4][2], B0[2][2], B1[2][2];
    const char* cA = cur.A; const char* cB = cur.B;
    if constexpr (GATHER) { PG8_AOFFS(cur, vA0, vA1); }
    PG8_STAGE(PG8_SB(0, 0), cB, voffB); PG8_STAGE(PG8_SB(0, 1), cB + hstep, voffB); PG8_STAGE_A(PG8_SA(0, 0), cA, 0, vA0, vA1); PG8_STAGE_A(PG8_SA(0, 1), cA, 1, vA0, vA1);
    if (wr == 1) PG8_BAR;
    PG8_WAIT_V(2); PG8_BAR;
    PG8_STAGE(PG8_SB(1, 0), cB + kstep, voffB); PG8_STAGE_A(PG8_SA(1, 0), cA + kstep, 0, vA0, vA1); PG8_STAGE(PG8_SB(1, 1), cB + hstep + kstep, voffB);
    PG8_WAIT_V(6); PG8_BAR;
    for (;;) {
        const bool has_next = S.next(ui + 1, nxt);
        const char* nA = has_next ? nxt.A : cA; const char* nB = has_next ? nxt.B : cB;
        if constexpr (GATHER) { if (has_next) { PG8_AOFFS(nxt, nA0, nA1); } else {
#pragma unroll
            for (int i = 0; i < 2; ++i) { nA0[i] = vA0[i]; nA1[i] = vA1[i]; } } }
        for (int t = 0; t < nt; t += 2) {
            const bool last = (t == nt - 2);
            const char* a1 = cA + (size_t)(t + 1) * kstep;
            const char* a2 = last ? nA : cA + (size_t)(t + 2) * kstep; const char* b2 = last ? nB : cB + (size_t)(t + 2) * kstep;
            const char* a3 = a2 + kstep; const char* b3 = b2 + kstep;
            unsigned u0[2], u1[2];
            if constexpr (GATHER) {
#pragma unroll
            for (int i = 0; i < 2; ++i) { u0[i] = last ? nA0[i] : vA0[i]; u1[i] = last ? nA1[i] : vA1[i]; } }
            PG8_LDB(B0, 0, 0); PG8_LDB(B1, 0, 1); PG8_SCHED; PG8_LDA(At, 0, 0); PG8_STAGE_A(PG8_SA(1, 1), a1, 1, vA0, vA1);
            PG8_WAIT_V(8); PG8_WAIT_L(0); PG8_BAR; PG8_MMA(0, 0, At, B0); PG8_MMA(0, 1, At, B1); PG8_BAR; PG8_SCHED;
            PG8_LDA(At, 0, 1); PG8_STAGE(PG8_SB(0, 0), b2, voffB); PG8_STAGE(PG8_SB(0, 1), b2 + hstep, voffB); PG8_STAGE_A(PG8_SA(0, 0), a2, 0, u0, u1);
            PG8_WAIT_V(8); PG8_WAIT_L(0); PG8_BAR; PG8_MMA(1, 0, At, B0); PG8_MMA(1, 1, At, B1); PG8_BAR; PG8_SCHED;
            PG8_LDB(B0, 1, 0); PG8_LDB(B1, 1, 1); PG8_SCHED; PG8_LDA(At, 1, 0); PG8_STAGE_A(PG8_SA(0, 1), a2, 1, u0, u1);
            PG8_WAIT_V(8); PG8_WAIT_L(0); PG8_BAR; PG8_MMA(0, 0, At, B0); PG8_MMA(0, 1, At, B1); PG8_BAR; PG8_SCHED;
            PG8_LDA(At, 1, 1); PG8_STAGE(PG8_SB(1, 0), b3, voffB); PG8_STAGE(PG8_SB(1, 1), b3 + hstep, voffB); PG8_STAGE_A(PG8_SA(1, 0), a3, 0, u0, u1);
            PG8_WAIT_V(8); PG8_WAIT_L(0); PG8_BAR; PG8_MMA(1, 0, At, B0); PG8_MMA(1, 1, At, B1); PG8_BAR; PG8_SCHED;
        }
        if (wr == 0) PG8_BAR;
        E(acc, cur, wr, wc, fr, fq, lds, lane);
        if (!has_next) break;
#pragma unroll
        for (int a = 0; a < 2; ++a)
#pragma unroll
            for (int b = 0; b < 2; ++b)
#pragma unroll
                for (int m = 0; m < 4; ++m)
#pragma unroll
                    for (int n = 0; n < 2; ++n) acc[a][b][m][n] = (f32x4){0.f, 0.f, 0.f, 0.f};
        cur = nxt; cA = nA; cB = nB; ++ui;
        if constexpr (GATHER) {
#pragma unroll
        for (int i = 0; i < 2; ++i) { vA0[i] = nA0[i]; vA1[i] = nA1[i]; } }
        if (wr == 1) PG8_BAR;
    }
    PG8_WAIT_V(0);
    PG8_BAR;
#undef PG8_SA
#undef PG8_SB
#undef PG8_STAGE
#undef PG8_STAGE_A
#undef PG8_LDA
#undef PG8_LDB
#undef PG8_MMA
#undef PG8_WAIT_V
#undef PG8_WAIT_L
#undef PG8_BAR
#undef PG8_SCHED
#undef PG8_AOFFS
}
}

constexpr int EPI_STG = 3 * 16384;
constexpr int EPI_STG2 = 131072 + 1024;
#define EPI_BAR() do { asm volatile("s_waitcnt lgkmcnt(0)" ::: "memory"); __builtin_amdgcn_s_barrier(); asm volatile("" ::: "memory"); } while (0)
DI void stg_rows_out(LAS unsigned char* R, unsigned char* grow0, size_t row_bytes, int wc, int lane) {
#pragma unroll
    for (int i = 0; i < 2; ++i) { const int row = 4 * wc + 2 * i + (lane >> 5), ch = lane & 31;
        const u32x4 v = *(const LAS u32x4*)(R + row * 512 + ((ch ^ (row & 7)) << 4));
        __builtin_nontemporal_store(v, (u32x4*)(grow0 + (size_t)row * row_bytes + ch * 16)); }
}
DI float h2f_lo(unsigned w) { return (float)__builtin_bit_cast(_Float16, (unsigned short)(w & 0xffffu)); }
DI float h2f_hi(unsigned w) { return (float)__builtin_bit_cast(_Float16, (unsigned short)(w >> 16)); }
DI unsigned pack_h2(float lo, float hi) { return (unsigned)__builtin_bit_cast(unsigned short, (_Float16)lo) | ((unsigned)__builtin_bit_cast(unsigned short, (_Float16)hi) << 16); }
struct EpiInProj {
    bf16_t* z; const unsigned* tabA; const unsigned* tabR; int dbg;
    DI void operator()(f32x4 (&acc)[2][2][4][2], const pg8::Unit& u, int wr, int wc, int fr, int fq, LAS unsigned char* lds, int lane) const {
        if (dbg == 2) {
#pragma unroll
            for (int a = 0; a < 2; ++a)
#pragma unroll
                for (int b = 0; b < 2; ++b)
#pragma unroll
                    for (int m = 0; m < 4; ++m)
#pragma unroll
                        for (int n = 0; n < 2; ++n) asm volatile("" :: "v"(acc[a][b][m][n]));
            return; }
        const int seg = (u.pn >> 2), colt = (u.pn & 3) * 256;
        bf16_t* zs = z + (size_t)seg * T * 1024;
        const float scale = (seg == 0) ? 0.08838834764831845f : (seg == 4 ? 0.0625f : 1.0f);
        const int row0 = u.pm * 256 + wr * 64 + fr;
        bf16_t* zp = zs + (size_t)row0 * 1024 + colt + wc * 32 + fq * 4;
        LAS unsigned char* R = lds + EPI_STG + wr * 8192;
#define EIP_STORE(ai_, m_, v00, v01, v10, v11) do { \
            { const f32x4 o = (v00) * scale; u32x2 w; w.x = pk2(o[0], o[1]); w.y = pk2(o[2], o[3]); *(LAS u32x2*)(R + fr * 512 + (((wc * 4 + (fq >> 1)) ^ (fr & 7)) << 4) + (fq & 1) * 8) = w; } \
            { const f32x4 o = (v01) * scale; u32x2 w; w.x = pk2(o[0], o[1]); w.y = pk2(o[2], o[3]); *(LAS u32x2*)(R + fr * 512 + (((wc * 4 + 2 + (fq >> 1)) ^ (fr & 7)) << 4) + (fq & 1) * 8) = w; } \
            { const f32x4 o = (v10) * scale; u32x2 w; w.x = pk2(o[0], o[1]); w.y = pk2(o[2], o[3]); *(LAS u32x2*)(R + fr * 512 + (((16 + wc * 4 + (fq >> 1)) ^ (fr & 7)) << 4) + (fq & 1) * 8) = w; } \
            { const f32x4 o = (v11) * scale; u32x2 w; w.x = pk2(o[0], o[1]); w.y = pk2(o[2], o[3]); *(LAS u32x2*)(R + fr * 512 + (((16 + wc * 4 + 2 + (fq >> 1)) ^ (fr & 7)) << 4) + (fq & 1) * 8) = w; } \
            EPI_BAR(); \
            stg_rows_out(R, (unsigned char*)(zs + (size_t)(u.pm * 256 + wr * 64 + (ai_) * 128 + (m_) * 16) * 1024 + colt), 2048, wc, lane); \
            EPI_BAR(); } while (0)
        if (seg == 3 || seg == 4) {
            const unsigned* tp = tabR + (size_t)row0 * 128 + wc * 32 + fq * 4;
            u32x4 tv[2][2];
            tv[0][0] = *(const u32x4*)(tp); tv[0][1] = *(const u32x4*)(tp + 16);
#pragma unroll
            for (int g = 0; g < 8; ++g) { const int ai = g >> 2, m = g & 3;
                if (g < 7) { const unsigned* tn = tp + (size_t)(((g + 1) >> 2) * 128 + ((g + 1) & 3) * 16) * 128; tv[(g + 1) & 1][0] = *(const u32x4*)(tn); tv[(g + 1) & 1][1] = *(const u32x4*)(tn + 16); }
                f32x4 r0[2], r1[2];
#pragma unroll
                for (int n = 0; n < 2; ++n) { const u32x4 tw = tv[g & 1][n];
                    const f32x4 cs = {h2f_lo(tw.x), h2f_lo(tw.y), h2f_lo(tw.z), h2f_lo(tw.w)}, sn = {h2f_hi(tw.x), h2f_hi(tw.y), h2f_hi(tw.z), h2f_hi(tw.w)};
                    const f32x4 x1 = acc[ai][0][m][n], x2 = acc[ai][1][m][n]; r0[n] = x1 * cs - x2 * sn; r1[n] = x2 * cs + x1 * sn; }
                if (dbg != 3) EIP_STORE(ai, m, r0[0], r0[1], r1[0], r1[1]);
            }
        } else if (seg <= 1 && wc == 0) {
            const unsigned* tp = tabA + (size_t)row0 * 16 + fq * 4;
            u32x4 tv[8];
#pragma unroll
            for (int g = 0; g < 8; ++g) tv[g] = *(const u32x4*)(tp + (size_t)((g >> 2) * 128 + (g & 3) * 16) * 16);
#pragma unroll
            for (int g = 0; g < 8; ++g) { const int ai = g >> 2, m = g & 3; const u32x4 tw = tv[g];
                const f32x4 cs = {h2f_lo(tw.x), h2f_lo(tw.y), h2f_lo(tw.z), h2f_lo(tw.w)}, sn = {h2f_hi(tw.x), h2f_hi(tw.y), h2f_hi(tw.z), h2f_hi(tw.w)};
                const f32x4 a1 = acc[ai][0][m][0], a2 = acc[ai][0][m][1], b1 = acc[ai][1][m][0], b2 = acc[ai][1][m][1];
                if (dbg != 3) EIP_STORE(ai, m, a1 * cs - a2 * sn, a2 * cs + a1 * sn, b1 * cs - b2 * sn, b2 * cs + b1 * sn);
            }
        } else {
#pragma unroll
            for (int g = 0; g < 8; ++g) { const int ai = g >> 2, m = g & 3;
                if (dbg != 3) EIP_STORE(ai, m, acc[ai][0][m][0], acc[ai][0][m][1], acc[ai][1][m][0], acc[ai][1][m][1]); }
        }
#undef EIP_STORE
    }
};

struct EpiOutProj {
    const float* x; const float* mu0; const float* rstd0; const float* g0; const float* b0; const float* mod; float* t; float* part;
    DI void operator()(f32x4 (&acc)[2][2][4][2], const pg8::Unit& u, int wr, int wc, int fr, int fq, LAS unsigned char* lds, int lane) const {
        const int col0 = u.pn * 256 + wc * 32 + fq * 8;
        const int b = (u.pm * 256) / SEQ;
        const float* g1 = mod + (size_t)b * 6 * D + 2 * D;
        const int row0 = u.pm * 256 + wr * 64 + fr;
        f32x4 pa[2][2];
#pragma unroll
        for (int bj = 0; bj < 2; ++bj)
#pragma unroll
            for (int n = 0; n < 2; ++n) { const int c = col0 + bj * 128 + n * 4;
                pa[bj][n] = DN_ALPHA * *(const f32x4*)(g0 + c); const f32x4 pb = DN_ALPHA * *(const f32x4*)(b0 + c); const f32x4 pc = 1.0f + *(const f32x4*)(g1 + c);
#pragma unroll
                for (int ai = 0; ai < 2; ++ai)
#pragma unroll
                    for (int m = 0; m < 4; ++m) acc[ai][bj][m][n] = acc[ai][bj][m][n] * pc + pb; }
        f32x4 xv[3][2]; float mu[2], rs[2], ss = 0.f, qq = 0.f;
#define EOP_LD(k_) do { const int gn = (k_) >> 1, bn = (k_) & 1; const int rn = row0 + (gn >> 2) * 128 + (gn & 3) * 16; const float* xp = (const float*)((const char*)x + (unsigned)(rn * D + col0 + bn * 128) * 4u); \
            if (bn == 0) { mu[gn & 1] = mu0[rn]; rs[gn & 1] = rstd0[rn]; } \
            xv[(k_) % 3][0] = *(const f32x4*)(xp); xv[(k_) % 3][1] = *(const f32x4*)(xp + 4); } while (0)
        EOP_LD(0); EOP_LD(1);
#pragma unroll
        for (int k = 0; k < 16; ++k) { const int g = k >> 1, bj = k & 1, ai = g >> 2, m = g & 3; const int row = row0 + ai * 128 + m * 16;
            if (k < 14) EOP_LD(k + 2);
            bf16_t* tp = (bf16_t*)((char*)t + (unsigned)(row * D + col0 + bj * 128) * 2u);
            u32x4 w;
#pragma unroll
            for (int n = 0; n < 2; ++n) {
                const f32x4 o = (xv[k % 3][n] - mu[g & 1]) * rs[g & 1] * pa[bj][n] + acc[ai][bj][m][n];
                if (n == 0) { w.x = pk2(o[0], o[1]); w.y = pk2(o[2], o[3]); } else { w.z = pk2(o[0], o[1]); w.w = pk2(o[2], o[3]); }
                ss += (o[0] + o[1]) + (o[2] + o[3]); qq += (o[0] * o[0] + o[1] * o[1]) + (o[2] * o[2] + o[3] * o[3]); }
            __builtin_nontemporal_store(w, (u32x4*)tp);
            if (bj == 1) {
                ss += __shfl_xor(ss, 16); ss += __shfl_xor(ss, 32); qq += __shfl_xor(qq, 16); qq += __shfl_xor(qq, 32);
                if (fq == 0) *(f32x2*)((char*)part + (unsigned)(row * 32 + u.pn * 4 + wc) * 8u) = (f32x2){ss, qq};
                ss = 0.f; qq = 0.f; }
        }
#undef EOP_LD
    }
};

struct EpiMoeUp {
    bf16_t* act;
    DI void operator()(f32x4 (&acc)[2][2][4][2], const pg8::Unit& u, int wr, int wc, int fr, int fq, LAS unsigned char* lds, int lane) const {
#pragma unroll
        for (int ai = 0; ai < 2; ++ai)
#pragma unroll
            for (int mh = 0; mh < 2; ++mh) {
                LAS unsigned char* R = lds + (mh ? EPI_STG2 : EPI_STG) + wr * 8192;
#pragma unroll
                for (int mm = 0; mm < 2; ++mm) { const int m = 2 * mh + mm, r = mm * 16 + fr;
                    f32x4 o[2];
#pragma unroll
                    for (int n = 0; n < 2; ++n) { const f32x4 g = acc[ai][0][m][n], up = acc[ai][1][m][n];
#pragma unroll
                        for (int j = 0; j < 4; ++j) o[n][j] = g[j] / (1.0f + __expf(-g[j])) * up[j]; }
                    u32x4 w; w.x = pk2(o[0][0], o[0][1]); w.y = pk2(o[0][2], o[0][3]); w.z = pk2(o[1][0], o[1][1]); w.w = pk2(o[1][2], o[1][3]);
                    *(LAS u32x4*)(R + r * 256 + (((wc * 4 + fq) ^ (r & 15)) << 4)) = w; }
                EPI_BAR();
#pragma unroll
                for (int i = 0; i < 2; ++i) { const int r = 8 * wc + 4 * i + (lane >> 4), ch = lane & 15;
                    const u32x4 v = *(const LAS u32x4*)(R + r * 256 + ((ch ^ (r & 15)) << 4));
                    const int grow = u.pm * 256 + wr * 64 + ai * 128 + mh * 32 + r;
                    __builtin_nontemporal_store(v, (u32x4*)(act + (size_t)grow * FF + u.pn * 128 + ch * 8)); }
            }
        EPI_BAR();
    }
};
struct EpiMoeDown {
    bf16_t* Y;
    DI void operator()(f32x4 (&acc)[2][2][4][2], const pg8::Unit& u, int wr, int wc, int fr, int fq, LAS unsigned char* lds, int lane) const {
#pragma unroll
        for (int ai = 0; ai < 2; ++ai)
#pragma unroll
            for (int m = 0; m < 4; ++m) {
                LAS unsigned char* R = lds + ((m & 1) ? EPI_STG2 : EPI_STG) + wr * 8192;
#pragma unroll
                for (int bj = 0; bj < 2; ++bj) { const f32x4 a = acc[ai][bj][m][0], b = acc[ai][bj][m][1];
                    u32x4 w; w.x = pk2(a[0], a[1]); w.y = pk2(a[2], a[3]); w.z = pk2(b[0], b[1]); w.w = pk2(b[2], b[3]);
                    *(LAS u32x4*)(R + fr * 512 + (((bj * 16 + wc * 4 + fq) ^ (fr & 7)) << 4)) = w; }
                EPI_BAR();
                stg_rows_out(R, (unsigned char*)(Y + (size_t)(u.pm * 256 + wr * 64 + ai * 128 + m * 16) * D + u.pn * 256), (size_t)D * 2, wc, lane);
            }
        EPI_BAR();
    }
};

struct MoeOrder {
    const LAS int* pre; int NT, G, c, total; const char* A; const char* Bw; size_t bstride_e, tstepB, tstepA; const unsigned* lists; const unsigned* cnt; bool gather;
    DI bool next(int i, pg8::Unit& u) const {
        const long L = (long)i * G + c; if (L >= total) return false;
        const int mt = (int)(L / NT), nt = (int)(L % NT);
        int e = 0;
#pragma unroll 1
        for (int k = 1; k < NE; ++k) e += (pre[k] <= mt) ? 1 : 0;
        const int lm = mt - pre[e];
        u.pm = mt; u.pn = nt; u.e = e;
        u.B = Bw + (size_t)e * bstride_e + (size_t)nt * tstepB;
        if (gather) { u.A = A; u.rows = lists + (size_t)e * 65536 + lm * 256; const int cn = (int)cnt[e * 64] - lm * 256; u.nrows = cn < 256 ? cn : 256; }
        else { u.A = A + (size_t)mt * tstepA; u.rows = nullptr; u.nrows = 0; }
        return true;
    }
};

DI void phase_mod(const Ctx& X) {
    float* mod = (float*)(X.ws + CTL_MOD);
    LAS float* ps = (LAS float*)X.lds;
    LAS float* cs = (LAS float*)(X.lds + 16384);
    const int lane = X.lane_f();
    for (int i = X.tid_f(); i < 4 * D; i += NTHREADS) { const float cv = X.c()[i]; cs[i] = cv / (1.0f + expf(-cv)); }
    __syncthreads();
    for (int cgp = X.vcu; cgp < 96; cgp += X.G) {
        const float* W = X.w_ada() + (size_t)(X.wave * 256) * (6 * D) + cgp * 128 + lane * 2;
        f32x2 acc[4];
#pragma unroll
        for (int b = 0; b < 4; ++b) acc[b] = (f32x2){0.f, 0.f};
#pragma unroll 1
        for (int k0 = 0; k0 < 256; k0 += 16) {
            f32x2 wv[16];
#pragma unroll
            for (int kk = 0; kk < 16; ++kk) wv[kk] = *(const f32x2*)(W + (size_t)(k0 + kk) * (6 * D));
#pragma unroll
            for (int kk = 0; kk < 16; ++kk)
#pragma unroll
                for (int b = 0; b < 4; ++b) acc[b] += cs[b * D + X.wave * 256 + k0 + kk] * wv[kk];
        }
#pragma unroll
        for (int b = 0; b < 4; ++b) *(LAS f32x2*)(ps + (X.wave * 4 + b) * 128 + lane * 2) = acc[b];
        __syncthreads();
        { const int o = X.tid_f();
          float sum = X.b_ada()[cgp * 128 + (o & 127)];
#pragma unroll
          for (int w8 = 0; w8 < 8; ++w8) sum += ps[(w8 * 4 + (o >> 7)) * 128 + (o & 127)];
          mod[(size_t)(o >> 7) * 6 * D + cgp * 128 + (o & 127)] = sum; }
        __syncthreads();
    }
}

constexpr int TR_SCR = 16896;
template <class RowMap>
DI void transpose_item(const float* W, int K, int N, bf16_t* WT, const RowMap& rm, LAS float* scr, int item, int lane) {
    const int nblk = N / 64, kb = item / nblk, nb = item % nblk, k0 = 64 * kb, n0 = 64 * nb;
    f32x4 v[16];
#pragma unroll
    for (int r = 0; r < 16; ++r) v[r] = *(const f32x4*)(W + (size_t)(k0 + 4 * r + (lane >> 4)) * N + n0 + 4 * (lane & 15));
#pragma unroll
    for (int r = 0; r < 16; ++r) { LAS float* d = scr + (4 * r + (lane >> 4)) * 65 + 4 * (lane & 15); d[0] = v[r][0]; d[1] = v[r][1]; d[2] = v[r][2]; d[3] = v[r][3]; }
    LDS_WAIT();
    const int c = lane & 7;
#pragma unroll
    for (int j = 0; j < 8; ++j) { const int n = (lane >> 3) + 8 * j; const LAS float* sp = scr + (8 * c) * 65 + n;
        u32x4 o; o.x = pk2(sp[0 * 65], sp[1 * 65]); o.y = pk2(sp[2 * 65], sp[3 * 65]); o.z = pk2(sp[4 * 65], sp[5 * 65]); o.w = pk2(sp[6 * 65], sp[7 * 65]);
        *(u32x4*)(WT + (size_t)rm(n0 + n) * K + k0 + 8 * c) = o; }
    LDS_WAIT();
}
struct RowId { DI int operator()(int n) const { return n; } };
struct RowPerm32 { DI int operator()(int n) const { return (n & ~31) + 16 * ((n >> 2) & 1) + 4 * ((n >> 3) & 3) + (n & 3); } };
struct RowGate { int up; DI int operator()(int n) const { return (n >> 7) * 256 + up * 128 + (n & 127); } };

DI void sincos_f(float a, float& c, float& s) {
    const float k = rintf(a * 0.636619772f);
    float r = fmaf(-k, 1.5707855225e+00f, a); r = fmaf(-k, 1.0804334124e-05f, r);
    const float r2 = r * r;
    const float sn = fmaf(r * r2, fmaf(r2, fmaf(r2, fmaf(r2, 2.7557319e-6f, -1.9841270e-4f), 8.3333333e-3f), -1.6666667e-1f), r);
    const float cn = fmaf(r2 * r2, fmaf(r2, fmaf(r2, 2.4801587e-5f, -1.3888889e-3f), 4.1666667e-2f), fmaf(r2, -0.5f, 1.0f));
    const int qq = ((int)k) & 3;
    float so, co;
    if (qq == 0) { so = sn; co = cn; } else if (qq == 1) { so = cn; co = -sn; } else if (qq == 2) { so = -sn; co = -cn; } else { so = -cn; co = sn; }
    c = co; s = so;
}
DI void sincos_d(float angf, float& c, float& s) {
    const double a = (double)angf;
    const double k = rint(a * 0.63661977236758134308);
    double r = a - k * 1.57079632673412561417e+00; r -= k * 6.07710050650619224932e-11;
    const double r2 = r * r;
    double sp = -1.0 / 6227020800.0; sp = sp * r2 + 1.0 / 39916800.0; sp = sp * r2 - 1.0 / 362880.0; sp = sp * r2 + 1.0 / 5040.0; sp = sp * r2 - 1.0 / 120.0; sp = sp * r2 + 1.0 / 6.0;
    const double sn = r - r * r2 * sp;
    double cp = -1.0 / 87178291200.0; cp = cp * r2 + 1.0 / 479001600.0; cp = cp * r2 - 1.0 / 3628800.0; cp = cp * r2 + 1.0 / 40320.0; cp = cp * r2 - 1.0 / 720.0; cp = cp * r2 + 1.0 / 24.0;
    const double cn = 1.0 - 0.5 * r2 + r2 * r2 * cp;
    const long long q = (long long)k; const int qq = (int)(q & 3);
    double so, co;
    if (qq == 0) { so = sn; co = cn; } else if (qq == 1) { so = cn; co = -sn; } else if (qq == 2) { so = -sn; co = -cn; } else { so = -cn; co = sn; }
    c = (float)co; s = (float)so;
}

DI void phase_pre(const Ctx& X, const int parts = 7) {
    LAS float* scr = (LAS float*)(X.lds + X.wave * TR_SCR);
    bf16_t* WinT = (bf16_t*)(X.ws + WS_WIN); bf16_t* WoutT = (bf16_t*)(X.ws + WS_WOUT);
    constexpr int I_IN = (D / 64) * (NIN / 64), I_OUT = (D / 64) * (D / 64);
    if (parts & 1) for (int it = X.gw; it < I_IN + I_OUT; it += X.NGW) {
        if (it < I_IN) transpose_item(X.w_in(), D, NIN, WinT, RowId{}, scr, it, X.lane_f());
        else transpose_item(X.w_out(), D, D, WoutT, RowPerm32{}, scr, it - I_IN, X.lane_f());
    }
    unsigned* tabA = (unsigned*)(X.ws + WS_TAB); unsigned* tabR = tabA + (size_t)T * 16;
    {
        const long gt = (long)X.gw * 64 + X.lane_f(), NGT = (long)X.NGW * 64;
        LAS float* invs = (LAS float*)(X.lds + 8 * TR_SCR);
        __syncthreads();
        if (X.tid_f() < 144) { const int f = X.tid_f(); float inv;
            if (f < 16) inv = (float)exp(-((double)(2 * f) / 32.0) * 13.122363377404328);
            else { const float tt = (float)(f - 16) / 127.0f; inv = (float)exp(-(double)tt * 9.210340371976184); }
            invs[f] = inv; }
        __syncthreads();
        if (parts & 2) for (int i = (int)gt; i < T * 144; i += (int)NGT) {
            const int tok = i / 144, f = i - tok * 144;
            const float pos = (float)X.positions()[tok];
            const float inv = invs[f];
            const float ang = pos * inv; float c, s; sincos_f(ang, c, s);
            if (f < 16) tabA[(size_t)tok * 16 + f] = pack_h2(c, s); else tabR[(size_t)tok * 128 + f - 16] = pack_h2(c, s);
        }
        bf16_t* WRh = (bf16_t*)(X.ws + WS_WR + 512 * 1024); bf16_t* WRl = (bf16_t*)(X.ws + WS_WR + 768 * 1024);
        for (long i = gt; i < 48L * D; i += NGT) {
            const int col = (int)(i / D), k = (int)(i % D);
            const float wv = col < 32 ? X.w_sub()[((size_t)(col >> 3) * D + k) * 8 + (col & 7)] : (col < 36 ? X.w_group()[(size_t)k * 4 + (col - 32)] : 0.f);
            const unsigned hi = f2bf(wv); WRh[i] = (bf16_t)hi; WRl[i] = (bf16_t)f2bf(wv - bf2f(hi));
        }
        float* PP = (float*)(X.ws + WS_WR + 1024 * 1024); const float* modp = (const float*)(X.ws + CTL_MOD);
        for (long i = gt; i < 4L * D; i += NGT) {
            const int bb_ = (int)(i / D), k = (int)(i % D);
            const float sc = modp[(size_t)bb_ * 6 * D + 4 * D + k], sh = modp[(size_t)bb_ * 6 * D + 3 * D + k];
            PP[((size_t)bb_ * 2) * D + k] = X.ln1_g()[k] * (1.0f + sc); PP[((size_t)bb_ * 2 + 1) * D + k] = X.ln1_b()[k] * (1.0f + sc) + sh;
        }
    }
    const float* mod = (const float*)(X.ws + CTL_MOD);
    float* mu0 = (float*)(X.ws + WS_STAT0); float* rstd0 = mu0 + T;
    bf16_t* h = (bf16_t*)(X.ws + WS_A);
    if (parts & 4) {
        const int lane = X.lane_f();
        const int rowb = X.gw * 16; const int b = rowb / SEQ;
        LAS float* prm = (LAS float*)X.lds;
        { const float* sh1p = mod + (size_t)b * 6 * D; const float* sc1p = sh1p + D;
          __syncthreads();
          for (int i = X.tid_f(); i < D; i += NTHREADS) { prm[i] = X.ln0_g()[i]; prm[D + i] = X.ln0_b()[i]; prm[2 * D + i] = 1.0f + sc1p[i]; prm[3 * D + i] = sh1p[i]; }
          __syncthreads(); }
        f32x4 v[2][8], vn[2][8];
#pragma unroll
        for (int rr = 0; rr < 2; ++rr) { const f32x4* xr = (const f32x4*)(X.x() + (size_t)(rowb + rr) * D) + lane;
#pragma unroll
            for (int j = 0; j < 8; ++j) vn[rr][j] = xr[64 * j]; }
#pragma unroll 1
        for (int k8 = 0; k8 < 8; ++k8) {
            const int rowa = rowb + 2 * k8;
#pragma unroll
            for (int rr = 0; rr < 2; ++rr)
#pragma unroll
                for (int j = 0; j < 8; ++j) v[rr][j] = vn[rr][j];
            float mean[2], rstd[2];
#pragma unroll
            for (int rr = 0; rr < 2; ++rr) { float s_ = 0.f;
#pragma unroll
                for (int j = 0; j < 8; ++j) s_ += (v[rr][j][0] + v[rr][j][1]) + (v[rr][j][2] + v[rr][j][3]);
                mean[rr] = wave_sum(s_) * (1.0f / D); float s2 = 0.f;
#pragma unroll
                for (int j = 0; j < 8; ++j) { v[rr][j] = v[rr][j] - mean[rr]; s2 += (v[rr][j][0] * v[rr][j][0] + v[rr][j][1] * v[rr][j][1]) + (v[rr][j][2] * v[rr][j][2] + v[rr][j][3] * v[rr][j][3]); }
                rstd[rr] = 1.0f / sqrtf(wave_sum(s2) * (1.0f / D) + LN_EPS); }
            if (k8 < 7) {
#pragma unroll
                for (int rr = 0; rr < 2; ++rr) { const f32x4* xr = (const f32x4*)(X.x() + (size_t)(rowa + 2 + rr) * D) + lane;
#pragma unroll
                    for (int j = 0; j < 8; ++j) vn[rr][j] = xr[64 * j]; } }
            asm volatile("" ::: "memory");
            if (lane == 0) { mu0[rowa] = mean[0]; rstd0[rowa] = rstd[0]; mu0[rowa + 1] = mean[1]; rstd0[rowa + 1] = rstd[1]; }
#pragma unroll
            for (int j = 0; j < 8; ++j) { const int c = 4 * lane + 256 * j;
                const f32x4 gg = *(const LAS f32x4*)(prm + c), bb = *(const LAS f32x4*)(prm + D + c), sc = *(const LAS f32x4*)(prm + 2 * D + c), sh = *(const LAS f32x4*)(prm + 3 * D + c);
#pragma unroll
                for (int rr = 0; rr < 2; ++rr) { const f32x4 xn = v[rr][j] * rstd[rr] * gg + bb; const f32x4 hv = xn * sc + sh;
                    u32x2 w; w.x = pk2(hv[0], hv[1]); w.y = pk2(hv[2], hv[3]); ((u32x2*)(h + (size_t)(rowa + rr) * D) + lane)[64 * j] = w; } }
        }
    }
}

DI void phase_attn_naive(const Ctx& X) {
    const bf16_t* aq = (const bf16_t*)(X.ws + WS_B); const bf16_t* ak = aq + (size_t)T * 1024; const bf16_t* av = ak + (size_t)T * 1024;
    bf16_t* mix = (bf16_t*)(X.ws + WS_A);
    LAS float* qs = (LAS float*)(X.lds + X.wave * 1024);
    for (int it = X.gw; it < T * AH; it += X.NGW) {
        const int row = it >> 3, hh = it & 7, s = row & (SEQ - 1);
        { const unsigned w = *(const unsigned*)(aq + (size_t)row * 1024 + hh * 128 + 2 * X.lane_f()); qs[2 * X.lane_f()] = bflo(w); qs[2 * X.lane_f() + 1] = bfhi(w); }
        LDS_WAIT();
        float sc[9]; bool vd[9];
#pragma unroll
        for (int p = 0; p < 3; ++p) {
            const int dil = p == 0 ? 1 : (p == 1 ? 4 : 16);
#pragma unroll
            for (int ps = 0; ps < 3; ++ps) {
                const int j = ps == 0 ? X.lane_f() - 64 : (ps == 1 ? X.lane_f() : 64);
                const int sp = s + dil * j;
                const bool valid = (ps < 2 || X.lane_f() == 0) && sp >= 0 && sp < SEQ;
                const int spc = valid ? sp : s;
                const u32x4* kr = (const u32x4*)(ak + ((size_t)(row - s + spc)) * 1024 + hh * 128);
                float dot = 0.f;
#pragma unroll 4
                for (int ch = 0; ch < 16; ++ch) {
                    const u32x4 kw = kr[ch]; const f32x4 q0 = *(const LAS f32x4*)(qs + 8 * ch), q1 = *(const LAS f32x4*)(qs + 8 * ch + 4);
                    dot += bflo(kw.x) * q0[0] + bfhi(kw.x) * q0[1] + bflo(kw.y) * q0[2] + bfhi(kw.y) * q0[3] + bflo(kw.z) * q1[0] + bfhi(kw.z) * q1[1] + bflo(kw.w) * q1[2] + bfhi(kw.w) * q1[3];
                }
                sc[p * 3 + ps] = valid ? dot : -1e30f; vd[p * 3 + ps] = valid;
            }
        }
        float m = sc[0];
#pragma unroll
        for (int i = 1; i < 9; ++i) m = fmaxf(m, sc[i]);
        m = wave_max(m);
        float l = 0.f;
#pragma unroll
        for (int i = 0; i < 9; ++i) { sc[i] = vd[i] ? expf(sc[i] - m) : 0.f; l += sc[i]; }
        l = wave_sum(l);
        float a0 = 0.f, a1 = 0.f;
#pragma unroll
        for (int p = 0; p < 3; ++p) {
            const int dil = p == 0 ? 1 : (p == 1 ? 4 : 16);
#pragma unroll
            for (int ps = 0; ps < 3; ++ps) {
                const int nk = ps < 2 ? 64 : 1;
                for (int k = 0; k < nk; ++k) {
                    const float pk = __shfl(sc[p * 3 + ps], k);
                    if (pk != 0.f) {
                        const int j = ps == 0 ? k - 64 : (ps == 1 ? k : 64);
                        const unsigned w = *(const unsigned*)(av + ((size_t)(row + dil * j)) * 1024 + hh * 128 + 2 * X.lane_f());
                        a0 += pk * bflo(w); a1 += pk * bfhi(w);
                    }
                }
            }
        }
        const float il = 1.0f / l;
        *(unsigned*)(mix + (size_t)row * D + hh * 128 + 2 * X.lane_f()) = pk2(a0 * il, a1 * il);
        LDS_WAIT();
    }
}


typedef float f32x16 __attribute__((ext_vector_type(16)));
typedef short s16x4 __attribute__((ext_vector_type(4)));
typedef short v4i16_t __attribute__((ext_vector_type(4)));
DI s16x4 vtr(const LAS unsigned char* p) { return __builtin_bit_cast(s16x4, __builtin_amdgcn_ds_read_tr16_b64_v4i16((LAS v4i16_t*)p)); }
#define MFMA32(a, b, c) __builtin_amdgcn_mfma_f32_32x32x16_bf16((a), (b), (c), 0, 0, 0)
DI bf16x8 cat8(s16x4 lo, s16x4 hi) { return (bf16x8){lo[0], lo[1], lo[2], lo[3], hi[0], hi[1], hi[2], hi[3]}; }

DI unsigned offb(unsigned row, unsigned ch) { return 256u * row + 16u * (ch ^ (((row & 3u) << 2) | ((row >> 2) & 3u))); }
DI void dma16(const void* gsrc, unsigned lds_dst) { unsigned keep; asm volatile("s_mov_b32 %0, m0\n\ts_mov_b32 m0, %2\n\ts_nop 0\n\tglobal_load_lds_dwordx4 %1, off\n\ts_mov_b32 m0, %0" : "=&s"(keep) : "v"(gsrc), "s"(lds_dst) : "memory"); }
template <int IMM> DI void dma16s(unsigned voff, const void* sbase, unsigned lds_base) { unsigned keep; asm volatile("s_mov_b32 %0, m0\n\ts_add_u32 m0, %3, %4\n\ts_nop 0\n\tglobal_load_lds_dwordx4 %1, %2\n\ts_mov_b32 m0, %0" : "=&s"(keep) : "v"(voff), "s"(sbase), "s"(lds_base), "i"(IMM) : "memory", "scc"); }
constexpr int ATT_XROW = 264, ATT_MOFF = 131072, ATT_LOFF = ATT_MOFF + 1024;
static_assert(256 * ATT_XROW <= 131072 && ATT_LOFF + 1024 <= LDS_BYTES - 16, "attention LDS map");
DI void phase_attn(const Ctx& X, const int dbg = 0, const int split = 0) {
    const bf16_t* aq = (const bf16_t*)(X.ws + WS_B); const bf16_t* ak = aq + (size_t)T * 1024; const bf16_t* av = ak + (size_t)T * 1024;
    bf16_t* mix = (dbg & 4) ? (bf16_t*)(X.ws + WS_WIN) : (bf16_t*)(X.ws + WS_A);
    const int w = X.wave;
    LAS unsigned char* vbase = X.lds + w * 16384;
    LAS unsigned char* xbuf = X.lds; LAS float* mS = (LAS float*)(X.lds + ATT_MOFF); LAS float* lS = (LAS float*)(X.lds + ATT_LOFF);
    const float LOG2E = 1.4426950408889634f;
    const int nit = split ? ((X.vcu & 1) ? 5 : 3) : (BATCH * AH * (SEQ / 256) - X.vcu + X.G - 1) / X.G;
    for (int iti = 0; iti < nit; ++iti) {
        int item;
        if (split) { const int k = ((X.vcu & 1) ? 0 : 5) + iti, xq = X.vcu >> 5, jq = (X.vcu & 31) >> 1; item = (4 * xq + (k >> 1)) * 32 + 16 * (k & 1) + jq; }
        else item = X.vcu + iti * X.G;
        int lane = X.lane_f(); asm volatile("" : "+v"(lane));
        const int c = lane & 31, hh = lane >> 5, trq = (lane & 15) >> 2, trp = lane & 3, trblk = (lane >> 4) & 1;
        const int qb = item & 31, head = (item >> 5) & 7, b = item >> 8;
        const int t0 = qb * 256; const size_t rowbase = (size_t)b * SEQ;
        const char* akh0 = (const char*)ak + (rowbase * 1024 + head * 128) * 2;
        const char* avh = (const char*)av + (rowbase * 1024 + head * 128) * 2;
        f32x16 o[4];
#pragma unroll
        for (int dt = 0; dt < 4; ++dt)
#pragma unroll
            for (int i = 0; i < 16; ++i) o[dt][i] = 0.f;
        float m = -1e30f, l = 0.f;
        int offq = 0;
#pragma unroll 1
        for (int p = 0; p < 3; ++p) {
            const int sh = 2 * p, dil = 1 << sh;
            offq = p == 0 ? 32 * w + c : (p == 1 ? 128 * (w >> 2) + 4 * c + (w & 3) : (c < 16 ? 16 * c + 2 * w : 16 * (c - 16) + 2 * w + 1));
            if (p > 0) {
#pragma unroll
                for (int dt = 0; dt < 4; ++dt)
#pragma unroll
                    for (int g = 0; g < 4; ++g) { const u32x2 wv = *(const LAS u32x2*)(xbuf + offq * ATT_XROW + (32 * dt + 8 * g + 4 * hh) * 2);
                        o[dt][4 * g] = bflo(wv.x); o[dt][4 * g + 1] = bfhi(wv.x); o[dt][4 * g + 2] = bflo(wv.y); o[dt][4 * g + 3] = bfhi(wv.y); }
                m = mS[offq]; l = lS[offq];
                __syncthreads();
            }
            const int pq = t0 + offq;
            bf16x8 qf[8];
            { const char* qp = (const char*)aq + ((rowbase + pq) * 1024 + head * 128) * 2 + hh * 16;
#pragma unroll
              for (int s = 0; s < 8; ++s) qf[s] = *(const bf16x8*)(qp + 32 * s); }
            asm volatile("s_waitcnt vmcnt(0)" ::: "memory");
#pragma unroll
            for (int s = 0; s < 8; ++s) asm volatile("" : "+v"(qf[s]));
            const int ntile = p == 2 ? 10 : 5;
#define ATT_KB(ti_) (p == 0 ? t0 + 32 * w - 64 + 32 * ((ti_) % 5) : (p == 1 ? t0 + 4 * (32 * (w >> 2) - 64 + 32 * ((ti_) % 5)) + (w & 3) : t0 + 16 * (-64 + 32 * ((ti_) % 5)) + 2 * w + (ti_) / 5))
#define ATT_DMA(ti_, gbase_, buf_, KSWZ_) do { const int kb_ = (dbg & 1) ? 4096 : ATT_KB(ti_); int lane = X.lane_f(); asm volatile("" : "+v"(lane)); \
                _Pragma("unroll") for (int i = 0; i < 8; ++i) { const int r_ = (KSWZ_) ? 4 * i + (lane >> 4) : 8 * (i >> 1) + ((lane >> 2) & 7); int pk_ = kb_ + (r_ << sh); pk_ = pk_ < 0 ? 0 : (pk_ > SEQ - 1 ? SEQ - 1 : pk_); \
                    const int ch_ = (KSWZ_) ? ((lane & 15) ^ (r_ & 15)) : (4 * (2 * (i & 1) + (lane >> 5)) + ((lane & 3) ^ ((2 * ((i >> 1) & 1) + ((lane >> 4) & 1)) & 3))); \
                    dma16((gbase_) + (size_t)pk_ * 2048 + ch_ * 16, (unsigned)__builtin_amdgcn_readfirstlane((int)(unsigned)(size_t)((buf_) + i * 1024))); } } while (0)
            LAS unsigned char* kbuf = vbase; LAS unsigned char* vbuf = vbase + 8192;
            const unsigned kbuf_u = (unsigned)__builtin_amdgcn_readfirstlane((int)(unsigned)(size_t)kbuf), vbuf_u = kbuf_u + 8192u;
            const unsigned offK0 = (unsigned)(((lane >> 4) << sh) * 2048) + (unsigned)(((lane & 15) ^ (lane >> 4)) << 4);
            const unsigned offV0 = (unsigned)((((lane >> 2) & 7) << sh) * 2048) + (unsigned)((4 * (lane >> 5) + ((lane & 3) ^ ((lane >> 4) & 1))) << 4);
#define ATT_OFFK(q_) (offK0 ^ (unsigned)(64 * (q_)))
#define ATT_OFFV(q_) ((offV0 + (unsigned)(128 * ((q_) & 1))) ^ (unsigned)(32 * ((q_) >> 1)))
#define ATT_INR(kb_) (((kb_) >= 0) && ((kb_) + (31 << sh) < SEQ))
#define ATT_DMA2(ti_, gbase_, bufu_, KSWZ_) do { const int kbn_ = ATT_KB(ti_); \
                if (ATT_INR(kbn_) && !(dbg & 1)) { const char* sb_ = (gbase_) + (size_t)kbn_ * 2048; const size_t st_ = (size_t)(4 << sh) * 2048; \
                    dma16s<0>((KSWZ_) ? ATT_OFFK(0) : ATT_OFFV(0), sb_, bufu_); dma16s<1024>((KSWZ_) ? ATT_OFFK(1) : ATT_OFFV(1), sb_ + st_ * ((KSWZ_) ? 1 : 0), bufu_); \
                    dma16s<2048>((KSWZ_) ? ATT_OFFK(2) : ATT_OFFV(2), sb_ + st_ * 2, bufu_); dma16s<3072>((KSWZ_) ? ATT_OFFK(3) : ATT_OFFV(3), sb_ + st_ * ((KSWZ_) ? 3 : 2), bufu_); \
                    dma16s<4096>((KSWZ_) ? ATT_OFFK(0) : ATT_OFFV(0), sb_ + st_ * 4, bufu_); dma16s<5120>((KSWZ_) ? ATT_OFFK(1) : ATT_OFFV(1), sb_ + st_ * ((KSWZ_) ? 5 : 4), bufu_); \
                    dma16s<6144>((KSWZ_) ? ATT_OFFK(2) : ATT_OFFV(2), sb_ + st_ * 6, bufu_); dma16s<7168>((KSWZ_) ? ATT_OFFK(3) : ATT_OFFV(3), sb_ + st_ * ((KSWZ_) ? 7 : 6), bufu_); } \
                else ATT_DMA(ti_, gbase_, (LAS unsigned char*)nullptr + (bufu_), KSWZ_); } while (0)
            ATT_DMA2(0, akh0, kbuf_u, 1); ATT_DMA2(0, avh, vbuf_u, 0);
            const LAS unsigned char* kfa = kbuf + c * 256;
            const LAS unsigned char* vt0 = vbuf + 64 * (4 * hh + trq) + 16 * ((2 * trblk + (trp >> 1)) ^ (hh & 3)) + 8 * (trp & 1);
            const LAS unsigned char* vt1 = vbuf + 2048 + 64 * (4 * hh + trq) + 16 * ((2 * trblk + (trp >> 1)) ^ ((2 + hh) & 3)) + 8 * (trp & 1);
#pragma unroll 1
            for (int ti = 0; ti < ntile; ++ti) {
                const int kb = ATT_KB(ti), tau = ti % 5;
                const bool more = ti + 1 < ntile;
                asm volatile("s_waitcnt vmcnt(8)" ::: "memory");
                bf16x8 kf[8];
#pragma unroll
                for (int s = 0; s < 8; ++s) kf[s] = *(const LAS bf16x8*)(kfa + (((2 * s + hh) ^ (c & 15)) << 4));
                f32x16 sa;
#pragma unroll
                for (int i = 0; i < 16; ++i) sa[i] = 0.f;
                if (dbg & 8) { sa[0] = __builtin_bit_cast(float, (int)kf[0][0]) * 1e-30f; } else
#pragma unroll
                for (int s = 0; s < 8; ++s) sa = MFMA32(kf[s], qf[s], sa);
                __builtin_amdgcn_sched_barrier(0);
                if (more) ATT_DMA2(ti + 1, akh0, kbuf_u, 1);
                __builtin_amdgcn_sched_barrier(0);
                const bool cm = ((kb - pq) & (dil - 1)) == 0;
                const bool fullt = (tau >= 1) && (tau <= 3) && ATT_INR(kb);
                bf16x8 pf[2];
                if (dbg & 8) { l += sa[0]; } else
                if (fullt) {
                    float tmax = fmaxf(fmaxf(sa[0], sa[1]), fmaxf(sa[2], sa[3]));
#pragma unroll
                    for (int r = 4; r < 16; r += 4) tmax = fmaxf(tmax, fmaxf(fmaxf(sa[r], sa[r + 1]), fmaxf(sa[r + 2], sa[r + 3])));
                    tmax *= LOG2E;
                    tmax = fmaxf(tmax, __shfl_xor(tmax, 32));
                    tmax = cm ? tmax : -1e30f;
                    const float mn = fmaxf(m, tmax);
                    if (__any(mn > m)) { const float alpha = __builtin_amdgcn_exp2f(m - mn); l *= alpha;
#pragma unroll
                        for (int dt = 0; dt < 4; ++dt) o[dt] = o[dt] * alpha; }
                    m = mn;
                    const float mneg = cm ? -mn : -1e30f;
                    float ps = 0.f;
#pragma unroll
                    for (int r = 0; r < 16; ++r) { sa[r] = __builtin_amdgcn_exp2f(__builtin_fmaf(sa[r], LOG2E, mneg)); ps += sa[r]; }
                    ps += __shfl_xor(ps, 32);
                    l += ps;
                } else {
                    float tmax = -1e30f;
#pragma unroll
                    for (int r = 0; r < 16; ++r) { const int kr = (r & 3) + 8 * (r >> 2) + 4 * hh; const int pk = kb + (kr << sh); const int df = pk - pq; const int ad = df < 0 ? -df : df;
                        const bool vdr = cm && (pk >= 0) && (pk < SEQ) && (ad <= (64 << sh));
                        sa[r] = vdr ? sa[r] * LOG2E : -1e30f; tmax = fmaxf(tmax, sa[r]); }
                    tmax = fmaxf(tmax, __shfl_xor(tmax, 32));
                    const float mn = fmaxf(m, tmax);
                    if (__any(mn > m)) { const float alpha = __builtin_amdgcn_exp2f(m - mn); l *= alpha;
#pragma unroll
                        for (int dt = 0; dt < 4; ++dt) o[dt] = o[dt] * alpha; }
                    m = mn;
                    float ps = 0.f;
#pragma unroll
                    for (int r = 0; r < 16; ++r) { sa[r] = sa[r] > -1e29f ? __builtin_amdgcn_exp2f(sa[r] - mn) : 0.f; ps += sa[r]; }
                    ps += __shfl_xor(ps, 32);
                    l += ps;
                }
#pragma unroll
                for (int s = 0; s < 2; ++s) { u32x4 pw; pw.x = cvtpk(sa[8 * s], sa[8 * s + 1]); pw.y = cvtpk(sa[8 * s + 2], sa[8 * s + 3]); pw.z = cvtpk(sa[8 * s + 4], sa[8 * s + 5]); pw.w = cvtpk(sa[8 * s + 6], sa[8 * s + 7]); pf[s] = __builtin_bit_cast(bf16x8, pw); }
                if (more) asm volatile("s_waitcnt vmcnt(8)" ::: "memory"); else asm volatile("s_waitcnt vmcnt(0)" ::: "memory");
#pragma unroll
                for (int dt = 0; dt < ((dbg & 8) ? 0 : 4); ++dt)
#pragma unroll
                    for (int s = 0; s < 2; ++s) { const s16x4 lo = vtr(vt0 + 4096 * s + 512 * dt), hi = vtr(vt1 + 4096 * s + 512 * dt);
                        o[dt] = MFMA32(cat8(lo, hi), pf[s], o[dt]); }
                asm volatile("s_waitcnt lgkmcnt(0)" ::: "memory");
                __builtin_amdgcn_sched_barrier(0);
                if (more) ATT_DMA2(ti + 1, avh, vbuf_u, 0);
                __builtin_amdgcn_sched_barrier(0);
            }
#undef ATT_DMA2
#undef ATT_INR
#undef ATT_OFFK
#undef ATT_OFFV
#undef ATT_KB
#undef ATT_DMA
            if (p < 2) {
                __syncthreads();
#pragma unroll
                for (int dt = 0; dt < 4; ++dt)
#pragma unroll
                    for (int g = 0; g < 4; ++g) { u32x2 wv; wv.x = cvtpk(o[dt][4 * g], o[dt][4 * g + 1]); wv.y = cvtpk(o[dt][4 * g + 2], o[dt][4 * g + 3]);
                        *(LAS u32x2*)(xbuf + offq * ATT_XROW + (32 * dt + 8 * g + 4 * hh) * 2) = wv; }
                if (hh == 0) { mS[offq] = m; lS[offq] = l; }
                __syncthreads();
            }
        }
        const float il = 1.0f / l;
        bf16_t* orow = mix + ((dbg & 4) ? ((rowbase + t0 + offq) & 4095) : (rowbase + t0 + offq)) * D + head * 128;
        if (!(dbg & 3))
#pragma unroll
        for (int dt = 0; dt < 4; ++dt)
#pragma unroll
            for (int g = 0; g < 4; ++g) { u32x2 wv; wv.x = cvtpk(o[dt][4 * g] * il, o[dt][4 * g + 1] * il); wv.y = cvtpk(o[dt][4 * g + 2] * il, o[dt][4 * g + 3] * il);
                *(u32x2*)(orow + 32 * dt + 8 * g + 4 * hh) = wv; }
    }
}

constexpr float LOG2E_F = 1.4426950408889634f;
constexpr size_t ST_CHUNK = 65536;

DI void phase_ret_states(const Ctx& X, const int dbg = 0) {
    const bf16_t* rk = (const bf16_t*)(X.ws + WS_B) + (size_t)4 * T * 1024; const bf16_t* rv = rk + (size_t)T * 1024;
    bf16_t* STf = (bf16_t*)(X.ws + WS_YF); bf16_t* STb = (bf16_t*)(X.ws + WS_YB);
    const int lane = X.lane_f(), c = lane & 31, hh = lane >> 5, w = X.wave, tid = X.tid_f();
    const int trq = (lane & 15) >> 2, trp = lane & 3, trblk = (lane >> 4) & 1;
    constexpr int BUF = 65536 + 8192;
    for (int item = X.vcu; item < 256; item += X.G) {
        const int es = item & 7, dir = (item >> 3) & 1, bh = item >> 4, b = bh >> 2, head = bh & 3;
        const float lg2 = (dir ? X.ldb()[head] : X.ldf()[head]) * LOG2E_F; const float gC = exp2f(128.0f * lg2);
        bf16_t* ST = (dir ? STb : STf) + (size_t)bh * 64 * ST_CHUNK;
        f32x16 acc;
#pragma unroll
        for (int i = 0; i < 16; ++i) acc[i] = 0.f;
        u32x4 kregA[8], kregB[8], vregA, vregB;
        const int vj = tid >> 2, vp = tid & 3;
        const float zeta = exp2f((float)(dir ? vj : 127 - vj) * lg2);
#define RS_LOADG(n_, kreg, vreg4) do { const size_t rowc = (size_t)b * SEQ + 128 * (n_); \
            _Pragma("unroll") for (int i = 0; i < 8; ++i) { const int idx = tid + 512 * i, j = idx >> 5, cc = idx & 31; kreg[i] = *(const u32x4*)(rk + (rowc + j) * 1024 + head * 256 + cc * 8); } \
            vreg4 = *(const u32x4*)(rv + (rowc + vj) * 1024 + head * 256 + 32 * es + 8 * vp); } while (0)
#define RS_STORE(buf_, kreg, vreg4) do { LAS unsigned char* kimg = X.lds + (buf_) * BUF; LAS unsigned char* vimg = kimg + 65536; \
            _Pragma("unroll") for (int i = 0; i < 8; ++i) { const int idx = tid + 512 * i, j = idx >> 5, cc = idx & 31; *(LAS u32x4*)(kimg + (cc >> 4) * 32768 + offb(j, cc & 15)) = kreg[i]; } \
            u32x4 sv; sv.x = cvtpk(bflo(vreg4.x) * zeta, bfhi(vreg4.x) * zeta); sv.y = cvtpk(bflo(vreg4.y) * zeta, bfhi(vreg4.y) * zeta); sv.z = cvtpk(bflo(vreg4.z) * zeta, bfhi(vreg4.z) * zeta); sv.w = cvtpk(bflo(vreg4.w) * zeta, bfhi(vreg4.w) * zeta); \
            *(LAS u32x4*)(vimg + vj * 64 + vp * 16) = sv; } while (0)
#define RS_CHUNK(step_) (dir ? 63 - (step_) : (step_))
        RS_LOADG(RS_CHUNK(0), kregA, vregA); RS_STORE(0, kregA, vregA);
        RS_LOADG(RS_CHUNK(1), kregB, vregB);
        __syncthreads();
#define RS_STEP(step_, kregNext, vregNext, kregLoad, vregLoad) do { const int step = (step_); const int n = RS_CHUNK(step), buf = step & 1; \
            if (step + 2 < 64) RS_LOADG(RS_CHUNK(step + 2), kregLoad, vregLoad); \
            if (!(dbg & 1)) {   \
              _Pragma("unroll") for (int gp = 0; gp < 2; ++gp) { const int ga = 2 * gp, gb = 2 * gp + 1; \
                const unsigned a0 = cvtpk(acc[4 * ga], acc[4 * ga + 1]), a1 = cvtpk(acc[4 * ga + 2], acc[4 * ga + 3]), b0 = cvtpk(acc[4 * gb], acc[4 * gb + 1]), b1 = cvtpk(acc[4 * gb + 2], acc[4 * gb + 3]); \
                const unsigned r0 = __shfl_xor(hh ? a0 : b0, 32), r1 = __shfl_xor(hh ? a1 : b1, 32); \
                u32x4 wv; if (hh == 0) { wv.x = a0; wv.y = a1; wv.z = r0; wv.w = r1; } else { wv.x = r0; wv.y = r1; wv.z = b0; wv.w = b1; } \
                *(u32x4*)(ST + (size_t)n * ST_CHUNK + ((size_t)(4 * w + (hh ? gb : ga)) * 256 + 32 * es + c) * 8) = wv; } } \
            acc = acc * gC; \
            const LAS unsigned char* kimg = X.lds + buf * BUF + (w >> 2) * 32768; const LAS unsigned char* vimg = X.lds + buf * BUF + 65536; \
            if (!(dbg & 2)) _Pragma("unroll") for (int ks = 0; ks < 8; ++ks) { \
                const unsigned r0 = 16 * ks + 8 * hh + trq, r1 = r0 + 4, ch = 4 * (w & 3) + 2 * trblk + (trp >> 1); \
                const s16x4 a0 = vtr(kimg + offb(r0, ch) + 8 * (trp & 1)), a1 = vtr(kimg + offb(r1, ch) + 8 * (trp & 1)); \
                const s16x4 b0 = vtr(vimg + r0 * 64 + 32 * trblk + 8 * trp), b1 = vtr(vimg + r1 * 64 + 32 * trblk + 8 * trp); \
                acc = MFMA32(cat8(a0, a1), cat8(b0, b1), acc); } \
            if (step + 1 < 64 && !(dbg & 4)) RS_STORE(buf ^ 1, kregNext, vregNext); \
            __syncthreads(); } while (0)
#pragma unroll 1
        for (int s2 = 0; s2 < 64; s2 += 2) {
            RS_STEP(s2, kregB, vregB, kregA, vregA);
            RS_STEP(s2 + 1, kregA, vregA, kregB, vregB);
        }
#undef RS_STEP
#undef RS_CHUNK
#undef RS_LOADG
#undef RS_STORE
    }
}

DI void phase_ret_states64(const Ctx& X, const int q) {
    const bf16_t* rk = (const bf16_t*)(X.ws + WS_B) + (size_t)4 * T * 1024; const bf16_t* rv = rk + (size_t)T * 1024;
    bf16_t* STf = (bf16_t*)(X.ws + WS_YF); bf16_t* STb = (bf16_t*)(X.ws + WS_YB);
    const int lane = X.lane_f(), c = lane & 31, hh = lane >> 5, w = X.wave, tid = X.tid_f();
    const int trq = (lane & 15) >> 2, trp = lane & 3, trblk = (lane >> 4) & 1;
    const int es4 = q & 3, dir = (q >> 2) & 1, bh = q >> 3, b = bh >> 2, head = bh & 3;
    const float lg2 = (dir ? X.ldb()[head] : X.ldf()[head]) * LOG2E_F; const float gC = exp2f(128.0f * lg2);
    bf16_t* ST = (dir ? STb : STf) + (size_t)bh * 64 * ST_CHUNK;
    f32x16 acc[2];
#pragma unroll
    for (int et = 0; et < 2; ++et)
#pragma unroll
        for (int i = 0; i < 16; ++i) acc[et][i] = 0.f;
    u32x4 kregA[8], vregA[2];
    const int vj0 = tid >> 3, vj1 = (tid + 512) >> 3, vp = tid & 7;
    const float zeta0 = exp2f((float)(dir ? vj0 : 127 - vj0) * lg2), zeta1 = exp2f((float)(dir ? vj1 : 127 - vj1) * lg2);
    LAS unsigned char* vimg = X.lds + 131072;
#define R6_LOADG(n_, kreg, vreg) do { const size_t rowc = (size_t)b * SEQ + 128 * (n_); \
        _Pragma("unroll") for (int i = 0; i < 8; ++i) { const int idx = tid + 512 * i, j = idx >> 5, cc = idx & 31; kreg[i] = *(const u32x4*)(rk + (rowc + j) * 1024 + head * 256 + cc * 8); } \
        vreg[0] = *(const u32x4*)(rv + (rowc + vj0) * 1024 + head * 256 + 64 * es4 + 8 * vp); vreg[1] = *(const u32x4*)(rv + (rowc + vj1) * 1024 + head * 256 + 64 * es4 + 8 * vp); } while (0)
#define R6_STOREK(buf_, kreg) do { LAS unsigned char* kimg = X.lds + (buf_) * 65536; \
        _Pragma("unroll") for (int i = 0; i < 8; ++i) { const int idx = tid + 512 * i, j = idx >> 5, cc = idx & 31; *(LAS u32x4*)(kimg + (cc >> 4) * 32768 + offb(j, cc & 15)) = kreg[i]; } } while (0)
#define R6_SCALE(v_, z_) ({ u32x4 sv_; sv_.x = cvtpk(bflo((v_).x) * (z_), bfhi((v_).x) * (z_)); sv_.y = cvtpk(bflo((v_).y) * (z_), bfhi((v_).y) * (z_)); sv_.z = cvtpk(bflo((v_).z) * (z_), bfhi((v_).z) * (z_)); sv_.w = cvtpk(bflo((v_).w) * (z_), bfhi((v_).w) * (z_)); sv_; })
#define R6_STOREV(vreg) do { *(LAS u32x4*)(vimg + vj0 * 128 + vp * 16) = R6_SCALE(vreg[0], zeta0); *(LAS u32x4*)(vimg + vj1 * 128 + vp * 16) = R6_SCALE(vreg[1], zeta1); } while (0)
#define R6_CHUNK(step_) (dir ? 63 - (step_) : (step_))
    R6_LOADG(R6_CHUNK(0), kregA, vregA); R6_STOREK(0, kregA); R6_STOREV(vregA);
    __syncthreads();
#define R6_STEP(step_, kregNext, vregNext, kregLoad, vregLoad) do { const int step = (step_); const int n = R6_CHUNK(step), buf = step & 1; \
        if (step + 1 < 64) R6_LOADG(R6_CHUNK(step + 1), kregLoad, vregLoad); \
        _Pragma("unroll") for (int et = 0; et < 2; ++et) _Pragma("unroll") for (int gp = 0; gp < 2; ++gp) { const int ga = 2 * gp, gb = 2 * gp + 1; \
            const unsigned a0 = cvtpk(acc[et][4 * ga], acc[et][4 * ga + 1]), a1 = cvtpk(acc[et][4 * ga + 2], acc[et][4 * ga + 3]), b0 = cvtpk(acc[et][4 * gb], acc[et][4 * gb + 1]), b1 = cvtpk(acc[et][4 * gb + 2], acc[et][4 * gb + 3]); \
            const unsigned r0 = __shfl_xor(hh ? a0 : b0, 32), r1 = __shfl_xor(hh ? a1 : b1, 32); \
            u32x4 wv; if (hh == 0) { wv.x = a0; wv.y = a1; wv.z = r0; wv.w = r1; } else { wv.x = r0; wv.y = r1; wv.z = b0; wv.w = b1; } \
            *(u32x4*)(ST + (size_t)n * ST_CHUNK + ((size_t)(4 * w + (hh ? gb : ga)) * 256 + 64 * es4 + 32 * et + c) * 8) = wv; } \
        acc[0] = acc[0] * gC; acc[1] = acc[1] * gC; \
        const LAS unsigned char* kimg = X.lds + buf * 65536 + (w >> 2) * 32768; \
        _Pragma("unroll") for (int ks = 0; ks < 8; ++ks) { \
            const unsigned r0 = 16 * ks + 8 * hh + trq, r1 = r0 + 4, ch = 4 * (w & 3) + 2 * trblk + (trp >> 1); \
            const bf16x8 a = cat8(vtr(kimg + offb(r0, ch) + 8 * (trp & 1)), vtr(kimg + offb(r1, ch) + 8 * (trp & 1))); \
            _Pragma("unroll") for (int et = 0; et < 2; ++et) { \
                const s16x4 b0 = vtr(vimg + r0 * 128 + 64 * et + 32 * trblk + 8 * trp), b1 = vtr(vimg + r1 * 128 + 64 * et + 32 * trblk + 8 * trp); \
                acc[et] = MFMA32(a, cat8(b0, b1), acc[et]); } } \
        if (step + 1 < 64) R6_STOREK(buf ^ 1, kregNext); \
        __syncthreads();                                     \
        if (step + 1 < 64) R6_STOREV(vregNext); \
        __syncthreads(); } while (0)
#pragma unroll 1
    for (int s2 = 0; s2 < 64; ++s2) {
        R6_STEP(s2, kregA, vregA, kregA, vregA);
    }
#undef R6_STEP
#undef R6_CHUNK
#undef R6_LOADG
#undef R6_STOREK
#undef R6_STOREV
#undef R6_SCALE
}

DI void phase_ret_out(const Ctx& X, const int dbg = 0) {
    const bf16_t* rq = (const bf16_t*)(X.ws + WS_B) + (size_t)3 * T * 1024; const bf16_t* rk = rq + (size_t)T * 1024; const bf16_t* rv = rk + (size_t)T * 1024; const bf16_t* rg = rv + (size_t)T * 1024;
    const bf16_t* STf = (const bf16_t*)(X.ws + WS_YF); const bf16_t* STb = (const bf16_t*)(X.ws + WS_YB);
    bf16_t* mix = dbg ? (bf16_t*)(X.ws + WS_Y) : (bf16_t*)(X.ws + WS_A);
    const int w = X.wave;
    LAS unsigned char* qimg = X.lds; LAS unsigned char* kimg = X.lds + 65536; LAS unsigned char* pimg = kimg; LAS unsigned char* vimg = X.lds;
    LAS float* part = (LAS float*)(X.lds + 131072);
    for (int item = X.vcu; item < 1024; item += X.G) {
        int lane_o = X.lane_f(); asm volatile("" : "+v"(lane_o));
        int tid = X.tid_f(); asm volatile("" : "+v"(tid));
        const int c = lane_o & 31, hh = lane_o >> 5, trq = (lane_o & 15) >> 2, trp = lane_o & 3, trblk = (lane_o >> 4) & 1;
        const int n = item & 63, bh = item >> 6, b = bh >> 2, head = bh & 3; const size_t rowc = (size_t)b * SEQ + 128 * n;
        const float lg2f = X.ldf()[head] * LOG2E_F, lg2b = X.ldb()[head] * LOG2E_F;
#pragma unroll
        for (int i = 0; i < 8; ++i) { const int idx = tid + 512 * i, j = idx >> 5, cc = idx & 31;
            const u32x4 qv = *(const u32x4*)(rq + (rowc + j) * 1024 + head * 256 + cc * 8), kv = *(const u32x4*)(rk + (rowc + j) * 1024 + head * 256 + cc * 8);
            *(LAS u32x4*)(qimg + j * 512 + ((cc ^ (j & 15)) << 4)) = qv; *(LAS u32x4*)(kimg + j * 512 + ((cc ^ (j & 15)) << 4)) = kv; }
        __syncthreads();
        f32x16 acc[4];
#pragma unroll
        for (int it = 0; it < 4; ++it)
#pragma unroll
            for (int i = 0; i < 16; ++i) acc[it][i] = 0.f;
        {
            const bf16_t* spf = STf + ((size_t)bh * 64 + n) * ST_CHUNK + ((size_t)hh * 256 + 32 * w + c) * 8;
            const bf16_t* spb = STb + ((size_t)bh * 64 + n) * ST_CHUNK + ((size_t)hh * 256 + 32 * w + c) * 8;
            bf16x8 afA[8], afB[8];
#define RO_LOAD(dst, sp_, sh_) do { _Pragma("unroll") for (int s = 0; s < 8; ++s) dst[s] = *(const bf16x8*)((sp_) + (size_t)(8 * (sh_) + s) * 2 * 256 * 8); } while (0)
#define RO_MMA(src, sh_) do { _Pragma("unroll") for (int it = 0; it < 4; ++it) { const int i = 32 * it + c; const LAS unsigned char* qrow = qimg + i * 512; \
                _Pragma("unroll") for (int s = 0; s < 8; ++s) acc[it] = MFMA32(src[s], *(const LAS bf16x8*)(qrow + (((2 * (8 * (sh_) + s) + hh) ^ (i & 15)) << 4)), acc[it]); \
                asm volatile("" ::: "memory"); } } while (0)
            if (!(dbg & 2)) {
            RO_LOAD(afA, spf, 0); RO_LOAD(afB, spf, 1);
            RO_MMA(afA, 0); RO_LOAD(afA, spb, 0);
            RO_MMA(afB, 1); RO_LOAD(afB, spb, 1);
#pragma unroll
            for (int it = 0; it < 4; ++it) { const int i = 32 * it + c; acc[it] = acc[it] * __builtin_amdgcn_exp2f((float)(i + 1) * lg2f - (float)(128 - i) * lg2b); }
            RO_MMA(afA, 0);
            RO_MMA(afB, 1);
            }
#pragma unroll
            for (int it = 0; it < 4; ++it) { const int i = 32 * it + c; acc[it] = acc[it] * __builtin_amdgcn_exp2f((float)(128 - i) * lg2b); }
#undef RO_LOAD
#undef RO_MMA
        }
        float pvv[2][16];
        {
            const int it = w & 3, i = 32 * it + c; const LAS unsigned char* qrow = qimg + i * 512;
#pragma unroll
            for (int jj = 0; jj < 2; ++jj) {
                const int jt = 2 * (w >> 2) + jj, j = 32 * jt + c; const LAS unsigned char* krow = kimg + j * 512;
                f32x16 sa;
#pragma unroll
                for (int r = 0; r < 16; ++r) sa[r] = 0.f;
#pragma unroll
                for (int s = 0; s < ((dbg & 4) ? 0 : 16); ++s) { sa = MFMA32(*(const LAS bf16x8*)(krow + (((2 * s + hh) ^ (j & 15)) << 4)), *(const LAS bf16x8*)(qrow + (((2 * s + hh) ^ (i & 15)) << 4)), sa);
                    if ((s & 3) == 3) asm volatile("" ::: "memory"); }
#pragma unroll
                for (int r = 0; r < 16; ++r) { const int jr = 32 * jt + (r & 3) + 8 * (r >> 2) + 4 * hh; const int df = i - jr;
                    const float dm = __builtin_amdgcn_exp2f(df >= 0 ? (float)df * lg2f : (float)(-df) * lg2b); pvv[jj][r] = sa[r] * dm; }
            }
        }
        __syncthreads();
        {
            const int it = w & 3, i = 32 * it + c;
#pragma unroll
            for (int jj = 0; jj < 2; ++jj) { const int jt = 2 * (w >> 2) + jj;
#pragma unroll
                for (int g = 0; g < 4; ++g) { u32x2 wv; wv.x = cvtpk(pvv[jj][4 * g], pvv[jj][4 * g + 1]); wv.y = cvtpk(pvv[jj][4 * g + 2], pvv[jj][4 * g + 3]);
                    *(LAS u32x2*)(pimg + i * 256 + (((4 * jt + g) ^ (i & 15)) << 4) + 8 * hh) = wv; } }
#pragma unroll
            for (int i2 = 0; i2 < 8; ++i2) { const int idx = tid + 512 * i2, j = idx >> 5, cc = idx & 31;
                const u32x4 vv = *(const u32x4*)(rv + (rowc + j) * 1024 + head * 256 + cc * 8);
                *(LAS u32x4*)(vimg + (cc >> 4) * 32768 + offb(j, cc & 15)) = vv; }
        }
        __syncthreads();
        {
            const LAS unsigned char* vh = vimg + (w >> 2) * 32768;
#pragma unroll
            for (int ks = 0; ks < ((dbg & 4) ? 0 : 8); ++ks) {
                const unsigned r0 = 16 * ks + 8 * hh + trq, r1 = r0 + 4, ch = 4 * (w & 3) + 2 * trblk + (trp >> 1);
                const bf16x8 a = cat8(vtr(vh + offb(r0, ch) + 8 * (trp & 1)), vtr(vh + offb(r1, ch) + 8 * (trp & 1)));
#pragma unroll
                for (int it = 0; it < 4; ++it) { const int i = 32 * it + c; acc[it] = MFMA32(a, *(const LAS bf16x8*)(pimg + i * 256 + (((2 * ks + hh) ^ (i & 15)) << 4)), acc[it]); }
                if (ks & 1) asm volatile("" ::: "memory");
            }
        }
        u32x4 gq[8];
#pragma unroll
        for (int i2 = 0; i2 < 8; ++i2) { const int idx = tid + 512 * i2, j = idx >> 5, cc = idx & 31; gq[i2] = *(const u32x4*)(rg + (rowc + j) * 1024 + head * 256 + cc * 8); }
#pragma unroll
        for (int it = 0; it < 4; ++it) { float s1 = 0.f, s2 = 0.f;
#pragma unroll
            for (int r = 0; r < 16; ++r) { s1 += acc[it][r]; s2 += acc[it][r] * acc[it][r]; }
            s1 += __shfl_xor(s1, 32); s2 += __shfl_xor(s2, 32);
            if (hh == 0) *(LAS f32x2*)(part + (w * 128 + 32 * it + c) * 2) = (f32x2){s1, s2}; }
        __syncthreads();
#pragma unroll
        for (int it = 0; it < 4; ++it) { const int i = 32 * it + c; float s1 = 0.f, s2 = 0.f;
#pragma unroll
            for (int ww = 0; ww < 8; ++ww) { const f32x2 pp = *(const LAS f32x2*)(part + (ww * 128 + i) * 2); s1 += pp[0]; s2 += pp[1]; }
            const float mean = s1 * (1.0f / 256.0f); const float var = fmaxf(s2 * (1.0f / 256.0f) - mean * mean, 0.f); const float rstd = 1.0f / sqrtf(var + LN_EPS);
#pragma unroll
            for (int g = 0; g < 4; ++g) { f32x4 y; y[0] = (acc[it][4 * g] - mean) * rstd; y[1] = (acc[it][4 * g + 1] - mean) * rstd; y[2] = (acc[it][4 * g + 2] - mean) * rstd; y[3] = (acc[it][4 * g + 3] - mean) * rstd;
                *(LAS f32x4*)(X.lds + i * 1024 + (((8 * w + hh + 2 * g) ^ (i & 15)) << 4)) = y; }
        }
        __syncthreads();
#pragma unroll
        for (int i2 = 0; i2 < 8; ++i2) { const int idx = tid + 512 * i2, j = idx >> 5, cc = idx & 31;
            const f32x4 y0 = *(const LAS f32x4*)(X.lds + j * 1024 + (((2 * cc) ^ (j & 15)) << 4)), y1 = *(const LAS f32x4*)(X.lds + j * 1024 + (((2 * cc + 1) ^ (j & 15)) << 4));
            const u32x4 gw = gq[i2]; u32x4 wv;
#define RO_G(gwc, ya, yb) ({ const float ga = bflo(gwc), gb = bfhi(gwc); cvtpk(ga / (1.f + __expf(-ga)) * (ya), gb / (1.f + __expf(-gb)) * (yb)); })
            wv.x = RO_G(gw.x, y0[0], y0[1]); wv.y = RO_G(gw.y, y0[2], y0[3]); wv.z = RO_G(gw.z, y1[0], y1[1]); wv.w = RO_G(gw.w, y1[2], y1[3]);
#undef RO_G
            *(u32x4*)(mix + (rowc + j) * D + 1024 + head * 256 + cc * 8) = wv; }
        __syncthreads();
    }
}

DI void phase_ret_naive(const Ctx& X) {
    const bf16_t* rq = (const bf16_t*)(X.ws + WS_B) + (size_t)3 * T * 1024; const bf16_t* rk = rq + (size_t)T * 1024; const bf16_t* rv = rk + (size_t)T * 1024;
    LAS float* qsm = (LAS float*)X.lds;
    LAS float* ksm = qsm + 16 * 256;
    LAS float* vsm = ksm + 16 * 256;
    LAS float* yp = vsm + 16 * 64;
    const int e = X.tid_f() & 63, dq = X.wave;
    for (int it = X.vcu; it < 16 * 2 * 4; it += X.G) {
        const int eq = it & 3, dir = (it >> 2) & 1, bh = it >> 3, b = bh >> 2, hh = bh & 3;
        const float gam = expf(dir ? X.ldb()[hh] : X.ldf()[hh]);
        float* ybuf = (float*)(X.ws + (dir ? WS_YB : WS_YF));
        float st[32];
#pragma unroll
        for (int i = 0; i < 32; ++i) st[i] = 0.f;
        for (int blk = 0; blk < SEQ / 16; ++blk) {
            const int t0 = dir ? (SEQ - 16 - 16 * blk) : 16 * blk;
            const size_t row0 = (size_t)b * SEQ + t0;
            {
                const int tt = X.tid_f() >> 5, c8 = (X.tid_f() & 31) * 8;
                const u32x4 qw = *(const u32x4*)(rq + (row0 + tt) * 1024 + hh * 256 + c8), kw = *(const u32x4*)(rk + (row0 + tt) * 1024 + hh * 256 + c8);
                LAS float* qd = qsm + tt * 256 + c8; LAS float* kd = ksm + tt * 256 + c8;
                qd[0] = bflo(qw.x); qd[1] = bfhi(qw.x); qd[2] = bflo(qw.y); qd[3] = bfhi(qw.y); qd[4] = bflo(qw.z); qd[5] = bfhi(qw.z); qd[6] = bflo(qw.w); qd[7] = bfhi(qw.w);
                kd[0] = bflo(kw.x); kd[1] = bfhi(kw.x); kd[2] = bflo(kw.y); kd[3] = bfhi(kw.y); kd[4] = bflo(kw.z); kd[5] = bfhi(kw.z); kd[6] = bflo(kw.w); kd[7] = bfhi(kw.w);
                if (X.tid_f() < 256) { const int t2 = X.tid_f() >> 4, c4 = (X.tid_f() & 15) * 4; const u32x2 vw = *(const u32x2*)(rv + (row0 + t2) * 1024 + hh * 256 + eq * 64 + c4);
                    LAS float* vd = vsm + t2 * 64 + c4; vd[0] = bflo(vw.x); vd[1] = bfhi(vw.x); vd[2] = bflo(vw.y); vd[3] = bfhi(vw.y); }
            }
            __syncthreads();
#pragma unroll 1
            for (int i = 0; i < 16; ++i) {
                const int tt = dir ? 15 - i : i;
                const float vv = vsm[tt * 64 + e];
                const LAS float* kq = ksm + tt * 256 + dq * 32; const LAS float* qq = qsm + tt * 256 + dq * 32;
                float y = 0.f;
                if (dir == 0) {
#pragma unroll
                    for (int d = 0; d < 32; ++d) { st[d] = gam * st[d] + kq[d] * vv; y += qq[d] * st[d]; }
                } else {
#pragma unroll
                    for (int d = 0; d < 32; ++d) { y += qq[d] * st[d]; st[d] = gam * st[d] + kq[d] * vv; }
                    y *= gam;
                }
                yp[(dq * 16 + tt) * 64 + e] = y;
            }
            __syncthreads();
            for (int o = X.tid_f(); o < 16 * 64; o += NTHREADS) {
                const int tt = o >> 6, ee = o & 63; float y = 0.f;
#pragma unroll
                for (int q = 0; q < 8; ++q) y += yp[(q * 16 + tt) * 64 + ee];
                ybuf[(row0 + tt) * 1024 + hh * 256 + eq * 64 + ee] = y;
            }
            __syncthreads();
        }
    }
}

DI void phase_ret_fin_naive(const Ctx& X) {
    const float* yf = (const float*)(X.ws + WS_YF); const float* yb = (const float*)(X.ws + WS_YB);
    const bf16_t* rg = (const bf16_t*)(X.ws + WS_B) + (size_t)6 * T * 1024;
    bf16_t* mix = (bf16_t*)(X.ws + WS_A);
    for (int it = X.gw; it < T * RH; it += X.NGW) {
        const int row = it >> 2, hh = it & 3; const size_t off = (size_t)row * 1024 + hh * 256 + 4 * X.lane_f();
        f32x4 y = *(const f32x4*)(yf + off) + *(const f32x4*)(yb + off);
        const float mean = wave_sum((y[0] + y[1]) + (y[2] + y[3])) * (1.0f / 256.0f);
        y = y - mean;
        const float var = wave_sum((y[0] * y[0] + y[1] * y[1]) + (y[2] * y[2] + y[3] * y[3])) * (1.0f / 256.0f);
        const float rstd = 1.0f / sqrtf(var + LN_EPS);
        const u32x2 gw = *(const u32x2*)(rg + off);
        const float g0 = bflo(gw.x), g1 = bfhi(gw.x), g2 = bflo(gw.y), g3 = bfhi(gw.y);
        f32x4 o; o[0] = g0 / (1.f + expf(-g0)) * y[0] * rstd; o[1] = g1 / (1.f + expf(-g1)) * y[1] * rstd; o[2] = g2 / (1.f + expf(-g2)) * y[2] * rstd; o[3] = g3 / (1.f + expf(-g3)) * y[3] * rstd;
        u32x2 w; w.x = pk2(o[0], o[1]); w.y = pk2(o[2], o[3]);
        *(u32x2*)(mix + (size_t)row * D + 1024 + hh * 256 + 4 * X.lane_f()) = w;
    }
}

DI void phase_w2_copy(const Ctx& X) {
    LAS float* scr = (LAS float*)(X.lds + X.wave * TR_SCR);
    bf16_t* W2 = (bf16_t*)(X.ws + WS_W2);
    unsigned* ctr = (unsigned*)(X.ws + CTL_WQ);
    constexpr int I_2 = (FF / 64) * (D / 64);
    for (;;) {
        unsigned it0 = 0;
        if (X.lane_f() == 0) it0 = __hip_atomic_fetch_add(ctr, 2u, __ATOMIC_RELAXED, __HIP_MEMORY_SCOPE_AGENT);
        it0 = (unsigned)__builtin_amdgcn_readfirstlane((int)it0);
        if (it0 >= (unsigned)(NE * I_2)) break;
        for (int j = 0; j < 2; ++j) {
            const int it = (int)it0 + j; const int e = it / I_2, r = it % I_2;
            transpose_item(X.w2() + (size_t)e * FF * D, FF, D, W2 + (size_t)e * D * FF, RowId{}, scr, r, X.lane_f());
        }
    }
}

DI void phase_route(const Ctx& X, const int parts) {
    if (parts & 1) {
        LAS float* scr = (LAS float*)(X.lds + X.wave * TR_SCR);
        bf16_t* W13 = (bf16_t*)(X.ws + WS_W13); bf16_t* W2 = (bf16_t*)(X.ws + WS_W2);
        constexpr int I_1 = (D / 64) * (FF / 64);
        for (int it = X.gw; it < NE * 2 * I_1; it += X.NGW) {
            const int e = it / (2 * I_1); const int r = it % (2 * I_1);
            if (r < I_1) transpose_item(X.w1() + (size_t)e * D * FF, D, FF, W13 + (size_t)e * 1024 * D, RowGate{0}, scr, r, X.lane_f());
            else transpose_item(X.w3() + (size_t)e * D * FF, D, FF, W13 + (size_t)e * 1024 * D, RowGate{1}, scr, r - I_1, X.lane_f());
        }
    }
    __syncthreads();
    const float* t = (const float*)(X.ws + WS_T); const float* part = (const float*)(X.ws + WS_STAT1);
    const float* mod = (const float*)(X.ws + CTL_MOD); const float* WRt = (const float*)(X.ws + WS_WR);
    bf16_t* h2 = (bf16_t*)(X.ws + WS_H2);
    unsigned* slot = (unsigned*)(X.ws + WS_SLOT); float* wt = (float*)(X.ws + WS_WT); unsigned* lists = (unsigned*)(X.ws + WS_LIST); unsigned* cnt = (unsigned*)(X.ws + CTL_CNT);
    const bf16_t* WRh = (const bf16_t*)(X.ws + WS_WR + 512 * 1024); const bf16_t* WRl = (const bf16_t*)(X.ws + WS_WR + 768 * 1024);
    const float* PP = (const float*)(X.ws + WS_WR + 1024 * 1024);
    LAS float* lgl = (LAS float*)(X.lds + X.wave * 4096);
    constexpr int RW_PP = 32768, RW_BUF = 49152, RW_CH = 49152, RW_LO = 24576;
    LAS float* PPl = (LAS float*)(X.lds + RW_PP);
    if (parts & 2) for (int g0 = X.vcu * NWAVES; g0 < T / 16; g0 += X.NGW) {
        int lane = X.lane_f(); asm volatile("" : "+v"(lane));
        int tid = X.tid_f(); asm volatile("" : "+v"(tid));
        const int grp = g0 + X.wave;
        const int row0 = grp * 16, b = row0 / SEQ, r = lane & 15, kq = lane >> 4, row = row0 + r;
        float ps = 0.f, pq = 0.f;
        { const f32x4* pp = (const f32x4*)(part + ((size_t)row * 32 + kq * 8) * 2);
#pragma unroll
          for (int i = 0; i < 4; ++i) { const f32x4 x = pp[i]; ps += x[0] + x[2]; pq += x[1] + x[3]; } }
        ps += __shfl_xor(ps, 16); ps += __shfl_xor(ps, 32); pq += __shfl_xor(pq, 16); pq += __shfl_xor(pq, 32);
        const float mean = ps * (1.0f / D); const float var = fmaxf(pq * (1.0f / D) - mean * mean, 0.f); const float rstd = 1.0f / sqrtf(var + LN_EPS);
        __syncthreads();
#pragma unroll
        for (int i = 0; i < 2; ++i) *(LAS f32x4*)(PPl + 4 * (tid + 512 * i)) = *(const f32x4*)(PP + (size_t)b * 2 * D + 4 * (tid + 512 * i));
#define RW_DMA(ch_, bi_) do { _Pragma("unroll") for (int i_ = 0; i_ < 3; ++i_) { const int kb_ = 3 * X.wave + i_, col_ = 2 * kb_ + (lane >> 5), sl_ = (lane & 31) ^ (col_ & 15); \
            const unsigned ld_ = (unsigned)__builtin_amdgcn_readfirstlane((int)(unsigned)(size_t)(X.lds + RW_BUF + (bi_) * RW_CH + kb_ * 1024)); \
            dma16(WRh + (size_t)col_ * D + 256 * (ch_) + 8 * sl_, ld_); dma16(WRl + (size_t)col_ * D + 256 * (ch_) + 8 * sl_, ld_ + RW_LO); } } while (0)
        RW_DMA(0, 0);
        const bf16_t* trow = (const bf16_t*)t + (size_t)row * D + 16 * kq; bf16_t* hrow = h2 + (size_t)row * D + 16 * kq;
        u32x4 tcur[8], tnext[8];
#pragma unroll
        for (int j = 0; j < 8; ++j) tcur[j] = *(const u32x4*)(trow + 64 * (j >> 1) + 8 * (j & 1));
        f32x4 acc[3];
#pragma unroll
        for (int ct = 0; ct < 3; ++ct) acc[ct] = (f32x4){0.f, 0.f, 0.f, 0.f};
        asm volatile("s_waitcnt vmcnt(0)" ::: "memory");
        __syncthreads();
#pragma unroll 1
        for (int c = 0; c < 8; ++c) {
            if (c < 7) { RW_DMA(c + 1, (c + 1) & 1);
#pragma unroll
                for (int j = 0; j < 8; ++j) tnext[j] = *(const u32x4*)(trow + 256 * (c + 1) + 64 * (j >> 1) + 8 * (j & 1)); }
            const LAS unsigned char* wb = X.lds + RW_BUF + (c & 1) * RW_CH + r * 512;
#pragma unroll
            for (int mm = 0; mm < 4; ++mm) {
                const int kl = 256 * c + 64 * mm;
                u32x4 hi[2], lo[2];
#pragma unroll
                for (int sub = 0; sub < 2; ++sub) {
                    const u32x4 tw = tcur[2 * mm + sub]; const f32x4 ta = {bflo(tw.x), bfhi(tw.x), bflo(tw.y), bfhi(tw.y)}, tb = {bflo(tw.z), bfhi(tw.z), bflo(tw.w), bfhi(tw.w)};
                    const LAS float* P1 = PPl + kl + 16 * kq + 8 * sub; const LAS float* P2 = P1 + D;
                    const f32x4 p1a = *(const LAS f32x4*)(P1), p1b = *(const LAS f32x4*)(P1 + 4), p2a = *(const LAS f32x4*)(P2), p2b = *(const LAS f32x4*)(P2 + 4);
                    const f32x4 ha = (ta - mean) * rstd * p1a + p2a, hb = (tb - mean) * rstd * p1b + p2b;
                    hi[sub].x = cvtpk(ha[0], ha[1]); hi[sub].y = cvtpk(ha[2], ha[3]); hi[sub].z = cvtpk(hb[0], hb[1]); hi[sub].w = cvtpk(hb[2], hb[3]);
                    lo[sub].x = cvtpk(ha[0] - bflo(hi[sub].x), ha[1] - bfhi(hi[sub].x)); lo[sub].y = cvtpk(ha[2] - bflo(hi[sub].y), ha[3] - bfhi(hi[sub].y));
                    lo[sub].z = cvtpk(hb[0] - bflo(hi[sub].z), hb[1] - bfhi(hi[sub].z)); lo[sub].w = cvtpk(hb[2] - bflo(hi[sub].w), hb[3] - bfhi(hi[sub].w));
                }
                *(u32x4*)(hrow + kl) = hi[0]; *(u32x4*)(hrow + kl + 8) = hi[1];
#pragma unroll
                for (int sub = 0; sub < 2; ++sub) {
                    const bf16x8 ahi = __builtin_bit_cast(bf16x8, hi[sub]), alo = __builtin_bit_cast(bf16x8, lo[sub]);
                    const int so = ((8 * mm + 2 * kq + sub) ^ r) << 4;
#pragma unroll
                    for (int ct = 0; ct < 3; ++ct) {
                        const bf16x8 bh = *(const LAS bf16x8*)(wb + ct * 8192 + so), bl = *(const LAS bf16x8*)(wb + ct * 8192 + so + RW_LO);
                        acc[ct] = __builtin_amdgcn_mfma_f32_16x16x32_bf16(ahi, bh, acc[ct], 0, 0, 0);
                        acc[ct] = __builtin_amdgcn_mfma_f32_16x16x32_bf16(ahi, bl, acc[ct], 0, 0, 0);
                        acc[ct] = __builtin_amdgcn_mfma_f32_16x16x32_bf16(alo, bh, acc[ct], 0, 0, 0);
                    }
                }
            }
            asm volatile("s_waitcnt vmcnt(0)" ::: "memory");
            __syncthreads();
#pragma unroll
            for (int j = 0; j < 8; ++j) tcur[j] = tnext[j];
        }
#undef RW_DMA
#pragma unroll
        for (int ct = 0; ct < 3; ++ct)
#pragma unroll
            for (int g = 0; g < 4; ++g) lgl[(4 * kq + g) * 48 + 16 * ct + r] = acc[ct][g];
        LDS_WAIT();
        if (X.lane_f() < 16) {
            const LAS float* lg = lgl + X.lane_f() * 48;
            float gl[4];
#pragma unroll
            for (int g = 0; g < 4; ++g) gl[g] = lg[32 + g] + X.b_group()[g];
            int gs = 0; float gm = gl[0];
#pragma unroll
            for (int g = 1; g < 4; ++g) if (gl[g] > gm) { gm = gl[g]; gs = g; }
            float den = 0.f;
#pragma unroll
            for (int g = 0; g < 4; ++g) den += expf(gl[g] - gm);
            const float pg = 1.0f / den;
            float sl[8];
#pragma unroll
            for (int e = 0; e < 8; ++e) sl[e] = lg[gs * 8 + e] + X.b_sub()[gs * 8 + e];
            int i0 = 0; float v0 = sl[0];
#pragma unroll
            for (int e = 1; e < 8; ++e) if (sl[e] > v0) { v0 = sl[e]; i0 = e; }
            int i1 = -1; float v1 = -3.0e38f;
#pragma unroll
            for (int e = 0; e < 8; ++e) if (e != i0 && sl[e] > v1) { v1 = sl[e]; i1 = e; }
            const float e1 = expf(v1 - v0); const float w0 = pg / (1.0f + e1), w1 = pg * e1 / (1.0f + e1);
            if (!(parts & 8)) {
                const int rw = row0 + X.lane_f(), ea = gs * 8 + i0, eb = gs * 8 + i1;
                const unsigned pa = atomicAdd(cnt + ea * 64, 1u), pb = atomicAdd(cnt + eb * 64, 1u);
                lists[(size_t)ea * 65536 + pa] = (unsigned)rw; lists[(size_t)eb * 65536 + pb] = (unsigned)rw;
                slot[rw * 2] = ((unsigned)ea << 20) | pa; slot[rw * 2 + 1] = ((unsigned)eb << 20) | pb;
                wt[rw * 2] = w0; wt[rw * 2 + 1] = w1;
            }
        }
        LDS_WAIT();
    }
}

DI int moe_prefix(const Ctx& X, LAS int* pre) {
    const unsigned* cnt = (const unsigned*)(X.ws + CTL_CNT);
    if (X.tid_f() == 0) { int s = 0; for (int e = 0; e < NE; ++e) { pre[e] = s; s += ((int)__hip_atomic_load(cnt + e * 64, __ATOMIC_RELAXED, __HIP_MEMORY_SCOPE_AGENT) + 255) >> 8; } pre[NE] = s; }
    __syncthreads();
    return pre[NE];
}

DI void phase_final(const Ctx& X) {
    LAS int* pre = (LAS int*)(X.lds + LDS_MISC);
    moe_prefix(X, pre);
    const float* t = (const float*)(X.ws + WS_T); const float* part = (const float*)(X.ws + WS_STAT1);
    const float* mod = (const float*)(X.ws + CTL_MOD);
    const bf16_t* Y = (const bf16_t*)(X.ws + WS_Y);
    const unsigned* slot = (const unsigned*)(X.ws + WS_SLOT); const float* wt = (const float*)(X.ws + WS_WT);
    LAS float* prm = (LAS float*)(X.lds + 1024);
    { __syncthreads();
      for (int i = X.tid_f(); i < D; i += NTHREADS) { prm[i] = X.ln1_g()[i]; prm[D + i] = X.ln1_b()[i]; prm[3 * D + i] = X.ln2_g()[i]; prm[4 * D + i] = X.ln2_b()[i];
#pragma unroll
          for (int bb = 0; bb < 4; ++bb) prm[(5 + bb) * D + i] = 1.0f + mod[(size_t)bb * 6 * D + 5 * D + i]; }
      __syncthreads(); }
    {
      u32x4 nsl = *(const u32x4*)(slot + (size_t)4 * X.gw); f32x4 nwt = *(const f32x4*)(wt + (size_t)4 * X.gw);
#pragma unroll 1
      for (int k8 = 0; k8 < 8; ++k8) {
        const int rowa = 2 * (X.gw + k8 * X.NGW);
        const int b = rowa / SEQ; const LAS float* g2l = prm + (5 + b) * D;
        f32x4 tv[2][8]; u32x2 ya[2][8], yb[2][8]; float w0[2], w1[2], mean[2], rstd[2];
        const u32x4 csl = nsl; const f32x4 cwt = nwt;
#pragma unroll
        for (int rr = 0; rr < 2; ++rr) {
            const int row = rowa + rr;
            const unsigned s0 = rr ? csl.z : csl.x, s1 = rr ? csl.w : csl.y; w0[rr] = rr ? cwt[2] : cwt[0]; w1[rr] = rr ? cwt[3] : cwt[1];
            const size_t r0 = (size_t)pre[s0 >> 20] * 256 + (s0 & 0xfffffu), r1 = (size_t)pre[s1 >> 20] * 256 + (s1 & 0xfffffu);
            const u32x2* tr = (const u32x2*)((const bf16_t*)t + (size_t)row * D) + X.lane_f();
            const u32x2* y0 = (const u32x2*)(Y + r0 * D) + X.lane_f(); const u32x2* y1 = (const u32x2*)(Y + r1 * D) + X.lane_f();
#pragma unroll
            for (int j = 0; j < 8; ++j) { const u32x2 tw = tr[64 * j]; tv[rr][j] = (f32x4){bflo(tw.x), bfhi(tw.x), bflo(tw.y), bfhi(tw.y)}; ya[rr][j] = y0[64 * j]; yb[rr][j] = y1[64 * j]; }
            float ps = 0.f, pq = 0.f; if (X.lane_f() < 32) { const f32x2 p = *(const f32x2*)(part + ((size_t)row * 32 + X.lane_f()) * 2); ps = p[0]; pq = p[1]; }
            ps = wave_sum(ps); pq = wave_sum(pq);
            mean[rr] = ps * (1.0f / D); const float var = fmaxf(pq * (1.0f / D) - mean[rr] * mean[rr], 0.f); rstd[rr] = 1.0f / sqrtf(var + LN_EPS);
        }
        if (k8 < 7) { const size_t nrow = (size_t)2 * (X.gw + (k8 + 1) * X.NGW); nsl = *(const u32x4*)(slot + nrow * 2); nwt = *(const f32x4*)(wt + nrow * 2); }
        float s[2] = {0.f, 0.f};
#pragma unroll
        for (int j = 0; j < 8; ++j) {
            const int c = 4 * X.lane_f() + 256 * j;
            const f32x4 gg = *(const LAS f32x4*)(prm + c), bb = *(const LAS f32x4*)(prm + D + c), g2v = *(const LAS f32x4*)(g2l + c);
#pragma unroll
            for (int rr = 0; rr < 2; ++rr) {
                const f32x4 x1 = (tv[rr][j] - mean[rr]) * rstd[rr] * gg + bb;
                const u32x2 a = ya[rr][j], bq = yb[rr][j];
                f32x4 f; f[0] = w0[rr] * bflo(a.x) + w1[rr] * bflo(bq.x); f[1] = w0[rr] * bfhi(a.x) + w1[rr] * bfhi(bq.x); f[2] = w0[rr] * bflo(a.y) + w1[rr] * bflo(bq.y); f[3] = w0[rr] * bfhi(a.y) + w1[rr] * bfhi(bq.y);
                const f32x4 uu = DN_ALPHA * x1 + g2v * f; tv[rr][j] = uu;
                s[rr] += (uu[0] + uu[1]) + (uu[2] + uu[3]);
            }
        }
#pragma unroll
        for (int rr = 0; rr < 2; ++rr) {
            const float m2 = wave_sum(s[rr]) * (1.0f / D); float q = 0.f;
#pragma unroll
            for (int j = 0; j < 8; ++j) { tv[rr][j] = tv[rr][j] - m2; q += (tv[rr][j][0] * tv[rr][j][0] + tv[rr][j][1] * tv[rr][j][1]) + (tv[rr][j][2] * tv[rr][j][2] + tv[rr][j][3] * tv[rr][j][3]); }
            const float rs2 = 1.0f / sqrtf(wave_sum(q) * (1.0f / D) + LN_EPS);
            f32x4* orow = (f32x4*)(X.out + (size_t)(rowa + rr) * D) + X.lane_f();
#pragma unroll
            for (int j = 0; j < 8; ++j) { const int c = 4 * X.lane_f() + 256 * j; __builtin_nontemporal_store(tv[rr][j] * rs2 * *(const LAS f32x4*)(prm + 3 * D + c) + *(const LAS f32x4*)(prm + 4 * D + c), orow + 64 * j); }
        }
      }
    }
}

#define XB_TMO      128
#define XB_XCNT(j)  (256  + 64 * (j))
#define XB_XSUB(j)  (1280 + 64 * (j))
#define XB_XGEN(j)  (2304 + 64 * (j))
#define XB_TOP      3328
#define XB_TOPGEN   3392
#define XCD_BAR_WORDS 3456
#define XB_SPIN_CAP (1u << 22)
DI unsigned xb_ld(unsigned* p)              { return __hip_atomic_load(p, __ATOMIC_RELAXED, __HIP_MEMORY_SCOPE_AGENT); }
DI unsigned xb_add(unsigned* p, unsigned v) { return __hip_atomic_fetch_add(p, v, __ATOMIC_RELAXED, __HIP_MEMORY_SCOPE_AGENT); }
DI unsigned xb_xcc_id() { return (unsigned)__builtin_amdgcn_s_getreg((3 << 11) | 20) & 0xFu; }
#define XB_SPIN(cond, bar) do { unsigned _sp = 0; while (cond) { __builtin_amdgcn_s_sleep(1); \
    if ((++_sp & 255u) == 0u) { if (xb_ld(&(bar)[XB_TMO])) break; if (_sp > XB_SPIN_CAP) { atomicAdd(&(bar)[XB_TMO], 1u); break; } } } } while (0)
struct XcdBarrier { unsigned* bar; unsigned x; volatile LAS unsigned* st; };
DI XcdBarrier xcd_barrier_post(unsigned* bar, volatile LAS unsigned* st, const bool t0) {
    XcdBarrier b; b.bar = bar; b.x = xb_xcc_id(); b.st = st;
    if (t0) (void)xb_add(&bar[XB_XCNT(b.x)], 1u);
    return b;
}
DI void xcd_barrier_complete(unsigned* bar, unsigned x, unsigned& nloc, unsigned& nx) {
    const unsigned G = gridDim.x * gridDim.y * gridDim.z;
    unsigned sum, cnt, mine, sp = 0u;
    for (;;) {
        sum = 0u; cnt = 0u; mine = 0u;
#pragma unroll
        for (unsigned j = 0; j < 16; ++j) { const unsigned c = xb_ld(&bar[XB_XCNT(j)]); sum += c; cnt += (c > 0u) ? 1u : 0u; mine = (j == x) ? c : mine; }
        if (sum == G) break;
        __builtin_amdgcn_s_sleep(1);
        if ((++sp & 255u) == 0u) { if (xb_ld(&bar[XB_TMO])) break; if (sp > XB_SPIN_CAP) { atomicAdd(&bar[XB_TMO], 1u); break; } }
    }
    nloc = mine > 0u ? mine : 1u; nx = cnt > 0u ? cnt : 1u;
}
DI void xcd_barrier(const XcdBarrier& b, const bool t0) {
    asm volatile("s_waitcnt vmcnt(0)" ::: "memory");
    __syncthreads();
    if (t0) {
        unsigned* bar = b.bar;
        __builtin_amdgcn_s_waitcnt(0);
        unsigned nloc = b.st[0], nx = b.st[1];
        if (nloc == 0u) { xcd_barrier_complete(bar, b.x, nloc, nx); b.st[0] = nloc; b.st[1] = nx; }
        const unsigned old = xb_add(&bar[XB_XSUB(b.x)], 1u);
        const unsigned gen = old / nloc;
        if (old + 1u == (gen + 1u) * nloc) {
            __builtin_amdgcn_fence(__ATOMIC_RELEASE, "agent");
            asm volatile("s_waitcnt vmcnt(0)" ::: "memory");
            const unsigned og = xb_add(&bar[XB_TOP], 1u);
            const unsigned tg = og / nx;
            if (og + 1u == (tg + 1u) * nx) xb_add(&bar[XB_TOPGEN], 1u);
            else XB_SPIN(xb_ld(&bar[XB_TOPGEN]) == tg, bar);
            __builtin_amdgcn_fence(__ATOMIC_ACQUIRE, "agent");
            xb_add(&bar[XB_XGEN(b.x)], 1u);
            asm volatile("s_waitcnt vmcnt(0)" ::: "memory");
        } else {
            XB_SPIN(xb_ld(&bar[XB_XGEN(b.x)]) == gen, bar);
            __builtin_amdgcn_fence(__ATOMIC_ACQUIRE, "agent");
            asm volatile("s_waitcnt vmcnt(0)" ::: "memory");
        }
    }
    __syncthreads();
}

__global__ void __launch_bounds__(NTHREADS, 2) fwd_kernel(Args args) {
    extern __shared__ __attribute__((aligned(16))) unsigned char lds_raw[];
    Ctx X;
    X.lds = (LAS unsigned char*)lds_raw;
    X.wave = __builtin_amdgcn_readfirstlane((int)(threadIdx.x >> 6));
    X.G = gridDim.x; { const int bx = blockIdx.x; X.vcu = (X.G % 8 == 0) ? (bx % 8) * (X.G / 8) + bx / 8 : bx; }
    X.gw = X.vcu * NWAVES + X.wave; X.NGW = X.G * NWAVES;
    X.kin = (const void* const*)__builtin_amdgcn_kernarg_segment_ptr();
    X.out = args.out; X.ws = args.ws;
    const int lo = args.ph_lo, hi = args.ph_hi;
    if (args.ph_hi > 1000) cg::this_grid().sync();
    volatile LAS unsigned* bst = (volatile LAS unsigned*)(X.lds + LDS_BYTES - 16);
    if (X.tid_f() < 4) bst[X.tid_f()] = 0u;
    __syncthreads();
    XcdBarrier gbar; gbar.bar = (unsigned*)(X.ws + CTL_BAR); gbar.x = 0; gbar.st = bst;
    if (hi - lo > 1) gbar = xcd_barrier_post((unsigned*)(X.ws + CTL_BAR), bst, X.tid_f() == 0);
#ifndef PH_MASK
#define PH_MASK 0x3ff
#endif
#define IN(k) (((PH_MASK >> (k)) & 1) && lo <= (k) && (k) < hi)
#ifndef DBL_MASK
#define DBL_MASK 0
#endif
#ifndef ATTN_NAIVE
#define ATTN_NAIVE 0
#endif
#ifndef RET_NAIVE
#define RET_NAIVE 0
#endif
#define DBL(k) ((DBL_MASK >> (k)) & 1)
#ifndef USE_CG_SYNC
#define USE_CG_SYNC 0
#endif
#define GSYNC() do { if (USE_CG_SYNC) cg::this_grid().sync(); else xcd_barrier(gbar, X.tid_f() == 0); } while (0)
#define SEAM(k) do { if (IN(k) && IN((k) + 1)) { GSYNC(); } } while (0)

    if (IN(0)) { phase_mod(X); } SEAM(0);
#ifndef P1_PARTS2
#define P1_PARTS2 7
#endif
#define PH1 { phase_pre(X); }
#define PH1B { phase_pre(X, P1_PARTS2); }
#ifndef P2_DBG2
#define P2_DBG2 0
#endif
#define PH2 { pg8::StaticOrder S; S.init(T, NIN, D, X.G, (int)blockIdx.x, X.ws + WS_A, X.ws + WS_WIN); \
        const unsigned* tabA = (const unsigned*)(X.ws + WS_TAB); const unsigned* tabR = tabA + (size_t)T * 16; \
        EpiInProj E{(bf16_t*)(X.ws + WS_B), tabA, tabR, P2DBG}; \
        pg8::gemm_phase<EpiInProj, pg8::StaticOrder, false>(X.lds, D, S, E, X.wave); }
#ifndef P3_ONLY
#define P3_ONLY 3
#endif
#define PH3 { if (!(X.vcu & 1)) { phase_ret_states64(X, X.vcu >> 1); __syncthreads(); } phase_attn(X, 0, 1); }
#ifndef P3_PARTS2
#define P3_PARTS2 3
#endif
#ifndef P3_DBG
#define P3_DBG 0
#endif
#define PH3B PH3
#ifndef P4_DBG
#define P4_DBG 1
#endif
#define PH4 { if (RET_NAIVE) phase_ret_fin_naive(X); else phase_ret_out(X); }
#define PH4B { phase_ret_out(X, P4_DBG); }
#define PH5 { pg8::StaticOrder S; S.init(T, D, D, X.G, (int)blockIdx.x, X.ws + WS_A, X.ws + WS_WOUT); \
        float* mu0 = (float*)(X.ws + WS_STAT0); \
        EpiOutProj E{X.x(), mu0, mu0 + T, X.ln0_g(), X.ln0_b(), (const float*)(X.ws + CTL_MOD), (float*)(X.ws + WS_T), (float*)(X.ws + WS_STAT1)}; \
        pg8::gemm_phase<EpiOutProj, pg8::StaticOrder, false>(X.lds, D, S, E, X.wave); }
#ifndef P6_PARTS2
#define P6_PARTS2 3
#endif
#define PH6 { phase_route(X, 3); }
#define PH6B { phase_route(X, P6_PARTS2); }
#define PH7 { LAS int* pre = (LAS int*)(X.lds + LDS_MISC); \
        const int nmt = moe_prefix(X, pre); \
        MoeOrder S{pre, 4, X.G, X.vcu, nmt * 4, (const char*)(X.ws + WS_H2), (const char*)(X.ws + WS_W13), (size_t)1024 * D * 2, (size_t)256 * D * 2, 0, (const unsigned*)(X.ws + WS_LIST), (const unsigned*)(X.ws + CTL_CNT), true}; \
        EpiMoeUp E{(bf16_t*)(X.ws + WS_A)}; \
        pg8::gemm_phase<EpiMoeUp, MoeOrder, true, true>(X.lds, D, S, E, X.wave); \
        __syncthreads(); phase_w2_copy(X); }
#define PH8 { LAS int* pre = (LAS int*)(X.lds + LDS_MISC); \
        const int nmt = moe_prefix(X, pre); \
        MoeOrder S{pre, 8, X.G, X.vcu, nmt * 8, (const char*)(X.ws + WS_A), (const char*)(X.ws + WS_W2), (size_t)D * FF * 2, (size_t)256 * FF * 2, (size_t)256 * FF * 2, nullptr, (const unsigned*)(X.ws + CTL_CNT), false}; \
        EpiMoeDown E{(bf16_t*)(X.ws + WS_Y)}; \
        pg8::gemm_phase<EpiMoeDown, MoeOrder, false, true>(X.lds, FF, S, E, X.wave); }
#define PH9 { phase_final(X); }
#define RUNPH(k, BODY) if (IN(k)) { BODY; if (DBL(k)) { GSYNC(); BODY; } } SEAM(k);
    if (IN(1)) { PH1; if (DBL(1)) { GSYNC(); PH1B; } } SEAM(1);
    { int P2DBG = 0; if (IN(2)) { PH2; if (DBL(2)) { GSYNC(); P2DBG = P2_DBG2; PH2; } } SEAM(2); }
    if (IN(3)) { PH3; if (DBL(3)) { GSYNC(); PH3B; } } SEAM(3);
    if (IN(4)) { PH4; if (DBL(4)) { GSYNC(); PH4B; } } SEAM(4);
    RUNPH(5, PH5)
    if (IN(6)) { PH6; if (DBL(6)) { GSYNC(); if ((P6_PARTS2 & 10) == 2) { if (X.vcu == 0 && X.tid_f() < NE) ((unsigned*)(X.ws + CTL_CNT))[X.tid_f() * 64] = 0u; GSYNC(); } PH6B; } } SEAM(6);
    RUNPH(7, PH7) RUNPH(8, PH8)
    if (IN(9)) { PH9; if (DBL(9)) { GSYNC(); PH9; } }
#undef IN
#undef SEAM
}

extern "C" void kernel_launch(void* const* d_in, const int* in_sizes, int n_in, void* d_out, int out_size, void* d_ws, size_t ws_size, hipStream_t stream) {
    static int grid = 0;
    if (grid == 0) {
        if (n_in != 22 || in_sizes[0] != T * D || out_size != T * D || ws_size < WS_END) { fprintf(stderr, "kernel_launch: unexpected shapes (n_in %d, in0 %d, out %d, ws %zu)\n", n_in, n_in > 0 ? in_sizes[0] : -1, out_size, ws_size); grid = -1; return; }
        int dev = 0, cus = 0, per_cu = 0;
        hipGetDevice(&dev); hipDeviceGetAttribute(&cus, hipDeviceAttributeMultiprocessorCount, dev);
        hipFuncSetAttribute((const void*)fwd_kernel, hipFuncAttributeMaxDynamicSharedMemorySize, LDS_BYTES);
        hipOccupancyMaxActiveBlocksPerMultiprocessor(&per_cu, (const void*)fwd_kernel, NTHREADS, LDS_BYTES);
        if (per_cu < 1) { fprintf(stderr, "kernel_launch: occupancy query says %d blocks per CU\n", per_cu); per_cu = 1; }
        (void)hipGetLastError();
        grid = cus;
        if (grid != 256) { fprintf(stderr, "kernel_launch: this build's phase 3 work split assumes 256 CUs (8 XCDs x 32); found %d\n", cus); grid = -1; return; }
    }
    if (grid < 0) return;
    hipMemsetAsync((char*)d_ws + WS_CTL, 0, CTL_ZERO_BYTES, stream);
    Args a{};
    for (int i = 0; i < 22; ++i) a.in[i] = d_in[i];
    a.out = (float*)d_out; a.ws = (unsigned char*)d_ws;
#if MK_PER_PHASE_LAUNCH
    for (int p = 0; p < NPHASE; ++p) {
        a.ph_lo = p; a.ph_hi = p + 1;
        hipLaunchKernelGGL(fwd_kernel, dim3(grid), dim3(NTHREADS), LDS_BYTES, stream, a);
    }
#else
    a.ph_lo = 0; a.ph_hi = NPHASE;
    void* kargs[] = {&a};
    hipError_t e = hipLaunchCooperativeKernel((const void*)fwd_kernel, dim3(grid), dim3(NTHREADS), kargs, LDS_BYTES, stream);
    if (e != hipSuccess) fprintf(stderr, "cooperative launch failed: %s (grid %d)\n", hipGetErrorString(e), grid);
#endif
}
```

```cpp
#include <hip/hip_runtime.h>
#include <hip/hip_cooperative_groups.h>
#include <cstdio>
#include <cstdint>
namespace cg = cooperative_groups;

#ifndef MK_PER_PHASE_LAUNCH
#define MK_PER_PHASE_LAUNCH 0
#endif

#define LAS __attribute__((address_space(3)))
#define GAS __attribute__((address_space(1)))
typedef unsigned short bf16_t;
typedef short bf16x8 __attribute__((ext_vector_type(8)));
typedef float f32x4 __attribute__((ext_vector_type(4)));
typedef float f32x2 __attribute__((ext_vector_type(2)));
typedef unsigned u32x4 __attribute__((ext_vector_type(4)));
typedef unsigned u32x2 __attribute__((ext_vector_type(2)));
#define DI __device__ __forceinline__

constexpr int D = 2048, BATCH = 4, SEQ = 8192, T = BATCH * SEQ;
constexpr int AW = 1024, NIN = 7168, AH = 8, RH = 4;
constexpr int NE = 32, FF = 512;
constexpr float LN_EPS = 1e-5f;
constexpr float DN_ALPHA = 1.189207115002721f;
constexpr int NWAVES = 8, NTHREADS = 512;
constexpr int NPHASE = 10;

constexpr size_t MiB = 1u << 20;
constexpr size_t WS_CTL = 0, CTL_ZERO_BYTES = 1 * MiB;
constexpr size_t CTL_BAR = 16 * 1024;
constexpr size_t CTL_MOD = 64 * 1024;
constexpr size_t CTL_CNT = 512 * 1024;
constexpr size_t CTL_WQ = 544 * 1024;
constexpr size_t WS_WIN = 2 * MiB;
constexpr size_t WS_WOUT = 30 * MiB;
constexpr size_t WS_W13 = 38 * MiB;
constexpr size_t WS_W2 = 166 * MiB;
constexpr size_t WS_TAB = 230 * MiB;
constexpr size_t WS_STAT0 = 266 * MiB;
constexpr size_t WS_STAT1 = 267 * MiB;
constexpr size_t WS_SLOT = 275 * MiB;
constexpr size_t WS_WT = WS_SLOT + 256 * 1024;
constexpr size_t WS_LIST = 276 * MiB;
constexpr size_t WS_WR = 284 * MiB;
constexpr size_t WS_A = 288 * MiB;
constexpr size_t WS_B = 416 * MiB;
constexpr size_t WS_T = WS_B, WS_H2 = WS_B + 256 * MiB;
constexpr size_t WS_Y = WS_H2;
constexpr size_t WS_YF = 864 * MiB;
constexpr size_t WS_YB = WS_W13;
constexpr size_t WS_END = 1024 * MiB;

constexpr int LDS_BYTES = 155648;
constexpr int LDS_MISC = 131072;

DI unsigned f2bf(float f) { unsigned u = __float_as_uint(f); return (u + 0x7fffu + ((u >> 16) & 1u)) >> 16; }
typedef __bf16 bf16x2_t __attribute__((ext_vector_type(2)));
DI unsigned cvtpk(float lo, float hi) { f32x2 v = {lo, hi}; bf16x2_t b = __builtin_convertvector(v, bf16x2_t); return __builtin_bit_cast(unsigned, b); }
DI unsigned pk2(float lo, float hi) { return cvtpk(lo, hi); }
DI float bf2f(unsigned h) { return __uint_as_float(h << 16); }
DI float bflo(unsigned w) { return __uint_as_float(w << 16); }
DI float bfhi(unsigned w) { return __uint_as_float(w & 0xffff0000u); }
#define dpp_f(v, ctrl) __int_as_float(__builtin_amdgcn_update_dpp(0, __float_as_int(v), (ctrl), 0xF, 0xF, true))
#define DPP_QP1 0xB1
#define DPP_QP2 0x4E
#define DPP_RHM 0x141
#define DPP_RM  0x140
DI float wave_sum(float v) {
    v += dpp_f(v, DPP_QP1); v += dpp_f(v, DPP_QP2); v += dpp_f(v, DPP_RHM); v += dpp_f(v, DPP_RM);
    const float a = __int_as_float(__builtin_amdgcn_readlane(__float_as_int(v), 0)), b = __int_as_float(__builtin_amdgcn_readlane(__float_as_int(v), 16));
    const float c = __int_as_float(__builtin_amdgcn_readlane(__float_as_int(v), 32)), d = __int_as_float(__builtin_amdgcn_readlane(__float_as_int(v), 48));
    return (a + b) + (c + d);
}
DI float wave_max(float v) {
    v = fmaxf(v, dpp_f(v, DPP_QP1)); v = fmaxf(v, dpp_f(v, DPP_QP2)); v = fmaxf(v, dpp_f(v, DPP_RHM)); v = fmaxf(v, dpp_f(v, DPP_RM));
    const float a = __int_as_float(__builtin_amdgcn_readlane(__float_as_int(v), 0)), b = __int_as_float(__builtin_amdgcn_readlane(__float_as_int(v), 16));
    const float c = __int_as_float(__builtin_amdgcn_readlane(__float_as_int(v), 32)), d = __int_as_float(__builtin_amdgcn_readlane(__float_as_int(v), 48));
    return fmaxf(fmaxf(a, b), fmaxf(c, d));
}
#define LDS_WAIT() asm volatile("s_waitcnt lgkmcnt(0)" ::: "memory")

struct Args { const void* in[22]; float* out; unsigned char* ws; int ph_lo, ph_hi; };

struct Ctx {
    LAS unsigned char* lds;
    int wave, G, vcu, gw, NGW;
    const void* const* kin;
    DI int lane_f() const { int l; asm volatile("v_mbcnt_lo_u32_b32 %0, -1, 0\n\tv_mbcnt_hi_u32_b32 %0, -1, %0" : "=v"(l)); return l; }
    DI int tid_f() const { return wave * 64 + lane_f(); }
    float* out; unsigned char* ws;
    DI const float* x() const { return (const float*)kin[0]; }
    DI const float* c() const { return (const float*)kin[1]; }
    DI const int* positions() const { return (const int*)kin[2]; }
    DI const float* ln0_g() const { return (const float*)kin[3]; }
    DI const float* ln0_b() const { return (const float*)kin[4]; }
    DI const float* w_ada() const { return (const float*)kin[5]; }
    DI const float* b_ada() const { return (const float*)kin[6]; }
    DI const float* w_in() const { return (const float*)kin[7]; }
    DI const float* w_out() const { return (const float*)kin[8]; }
    DI const float* ldf() const { return (const float*)kin[9]; }
    DI const float* ldb() const { return (const float*)kin[10]; }
    DI const float* ln1_g() const { return (const float*)kin[11]; }
    DI const float* ln1_b() const { return (const float*)kin[12]; }
    DI const float* w_group() const { return (const float*)kin[13]; }
    DI const float* b_group() const { return (const float*)kin[14]; }
    DI const float* w_sub() const { return (const float*)kin[15]; }
    DI const float* b_sub() const { return (const float*)kin[16]; }
    DI const float* w1() const { return (const float*)kin[17]; }
    DI const float* w3() const { return (const float*)kin[18]; }
    DI const float* w2() const { return (const float*)kin[19]; }
    DI const float* ln2_g() const { return (const float*)kin[20]; }
    DI const float* ln2_b() const { return (const float*)kin[21]; }
};

namespace pg8 {
constexpr int BM = 256, BK = 64, HALF = 128, HTB = HALF * BK * 2, STAGE_BYTES = 8 * HTB, NXCD = 8, WGM = 8;
__host__ __device__ __forceinline__ int lds_byte(int r, int c) { const int st = (r >> 4) * 2 + (c >> 5), rr = r & 15, cc = c & 31, ob = rr * 64 + cc * 2; return st * 1024 + (ob ^ (((ob >> 9) & 1) << 5)); }
__host__ __device__ __forceinline__ void stage_rc(int b, int& R, int& C) { const int st = b / 1024, sb = b % 1024, swz = sb ^ (((sb >> 9) & 1) << 5); R = (st >> 1) * 16 + swz / 64; C = (st & 1) * 32 + (swz % 64) / 2; }

struct Unit { const char* A; const char* B; const unsigned* rows; int nrows; int pm, pn, e; };

struct StaticOrder {
    int nM, nN, nwg, G, c; const char* A; const char* B; size_t tstepA, tstepB;
    DI void init(int M, int N, int K, int G_, int c_, const void* A_, const void* B_) { nM = M / BM; nN = N / BM; nwg = nM * nN; G = G_; c = c_; A = (const char*)A_; B = (const char*)B_; tstepA = (size_t)BM * K * 2; tstepB = (size_t)BM * K * 2; }
    DI bool next(int i, Unit& u) const {
        const long L = (long)i * G + c; if (L >= nwg) return false;
        int wgid = (int)L; { const int q = nwg / NXCD, r = nwg % NXCD, xcd = wgid % NXCD, off = wgid / NXCD; wgid = (xcd < r ? xcd * (q + 1) : r * (q + 1) + (xcd - r) * q) + off; }
        const int nig = WGM * nN, gid = wgid / nig, fm = gid * WGM, gsz = (nM - fm) < WGM ? (nM - fm) : WGM;
        u.pm = fm + ((wgid % nig) % gsz); u.pn = (wgid % nig) / gsz; u.e = 0; u.rows = nullptr; u.nrows = 0;
        u.A = A + (size_t)u.pm * tstepA; u.B = B + (size_t)u.pn * tstepB; return true;
    }
};

DI unsigned cvt_pk_bf16(float lo, float hi) { unsigned r; asm volatile("v_cvt_pk_bf16_f32 %0, %1, %2" : "=v"(r) : "v"(lo), "v"(hi)); return r; }

__host__ __device__ __forceinline__ int perm32(int rho) { const int n = rho >> 4, i = rho & 15; return 8 * (i >> 2) + 4 * n + (i & 3); }
template <class Epi, class Sched, bool GATHER, bool PERM = false>
DI void gemm_phase(LAS unsigned char* lds, const int K, const Sched& S, const Epi& E, const int wid) {
    int lane; asm volatile("v_mbcnt_lo_u32_b32 %0, -1, 0\n\tv_mbcnt_hi_u32_b32 %0, -1, %0" : "=v"(lane));
    const int tid = wid * 64 + lane, wr = wid >> 2, wc = wid & 3, fr = lane & 15, fq = lane >> 4;
    const int nt = K / BK;
    int Rr[2], Cc[2];
    unsigned voffB[2], voffN[2], vA0[2], vA1[2], nA0[2], nA1[2];
#pragma unroll
    for (int i = 0; i < 2; ++i) { stage_rc(tid * 16 + i * 8192, Rr[i], Cc[i]); voffN[i] = (unsigned)(Rr[i] * K + Cc[i]) * 2u; const int Rb = PERM ? ((Rr[i] & ~31) + perm32(Rr[i] & 31)) : Rr[i]; voffB[i] = (unsigned)(Rb * K + Cc[i]) * 2u; }
    const size_t kstep = (size_t)(BK * 2);
    const size_t hstep = (size_t)HALF * K * 2;
    const unsigned ldsw = (unsigned)wid * 1024u;
    const int aoff = lds_byte(wr * 64 + fr, fq * 8), boff = lds_byte(wc * 32 + fr, fq * 8);
#define PG8_SA(b, h) (((b) * 2 + (h)) * HTB)
#define PG8_SB(b, h) ((4 + (b) * 2 + (h)) * HTB)
#define PG8_STAGE(bufoff, gbase, voff) do { _Pragma("unroll") for (int _i = 0; _i < 2; ++_i) \
        __builtin_amdgcn_global_load_lds((const unsigned*)((const char*)(gbase) + (voff)[_i]), (LAS unsigned*)(lds + (bufoff) + ldsw + _i * 8192), 16, 0, 0); } while (0)
#define PG8_LDA(dst, b, h) do { _Pragma("unroll") for (int m = 0; m < 4; ++m) _Pragma("unroll") for (int k = 0; k < 2; ++k) dst[m][k] = *(const LAS bf16x8*)(lds + PG8_SA(b, h) + aoff + m * 2048 + k * 1024); } while (0)
#define PG8_LDB(dst, b, h) do { _Pragma("unroll") for (int n = 0; n < 2; ++n) _Pragma("unroll") for (int k = 0; k < 2; ++k) dst[n][k] = *(const LAS bf16x8*)(lds + PG8_SB(b, h) + boff + n * 2048 + k * 1024); } while (0)
#define PG8_MMA(ai, bj, At, Bt) do { __builtin_amdgcn_s_setprio(1); _Pragma("unroll") for (int m = 0; m < 4; ++m) _Pragma("unroll") for (int n = 0; n < 2; ++n) _Pragma("unroll") for (int k = 0; k < 2; ++k) \
        acc[ai][bj][m][n] = __builtin_amdgcn_mfma_f32_16x16x32_bf16(Bt[n][k], At[m][k], acc[ai][bj][m][n], 0, 0, 0); __builtin_amdgcn_s_setprio(0); } while (0)
#define PG8_STAGE_A(bufoff, gbase, half_, vo0, vo1) do { if constexpr (GATHER) { if ((half_) == 0) PG8_STAGE(bufoff, gbase, vo0); else PG8_STAGE(bufoff, gbase, vo1); } else { PG8_STAGE(bufoff, (gbase) + ((half_) ? hstep : 0), voffN); } } while (0)
#define PG8_WAIT_V(n) asm volatile("s_waitcnt vmcnt(" #n ")" ::: "memory")
#define PG8_WAIT_L(n) asm volatile("s_waitcnt lgkmcnt(" #n ")" ::: "memory")
#define PG8_BAR __builtin_amdgcn_s_barrier()
#define PG8_SCHED __builtin_amdgcn_sched_barrier(0)
#define PG8_AOFFS(u, o0, o1) do { _Pragma("unroll") for (int _i = 0; _i < 2; ++_i) { \
        if constexpr (GATHER) { const int r0 = Rr[_i], r1 = Rr[_i] + HALF; \
            const unsigned t0 = r0 < (u).nrows ? (u).rows[r0] : 0u, t1 = r1 < (u).nrows ? (u).rows[r1] : 0u; \
            o0[_i] = (t0 * (unsigned)K + (unsigned)Cc[_i]) * 2u; o1[_i] = (t1 * (unsigned)K + (unsigned)Cc[_i]) * 2u; } \
        else { o0[_i] = voffN[_i]; o1[_i] = voffN[_i] + (unsigned)hstep; } } } while (0)
    Unit cur, nxt; int ui = 0;
    if (!S.next(0, cur)) return;
    f32x4 acc[2][2][4][2];
#pragma unroll
    for (int a = 0; a < 2; ++a)
#pragma unroll
        for (int b = 0; b < 2; ++b)
#pragma unroll
            for (int m = 0; m < 4; ++m)
#pragma unroll
                for (int n = 0; n < 2; ++n) acc[a][b][m][n] = (f32x4){0.f, 0.f, 0.f, 0.f};
    bf16x8 At[4][2], B0[2][2], B1[2][2];
    const char* cA = cur.A; const char* cB = cur.B;
    if constexpr (GATHER) { PG8_AOFFS(cur, vA0, vA1); }
    PG8_STAGE(PG8_SB(0, 0), cB, voffB); PG8_STAGE(PG8_SB(0, 1), cB + hstep, voffB); PG8_STAGE_A(PG8_SA(0, 0), cA, 0, vA0, vA1); PG8_STAGE_A(PG8_SA(0, 1), cA, 1, vA0, vA1);
    if (wr == 1) PG8_BAR;
    PG8_WAIT_V(2); PG8_BAR;
    PG8_STAGE(PG8_SB(1, 0), cB + kstep, voffB); PG8_STAGE_A(PG8_SA(1, 0), cA + kstep, 0, vA0, vA1); PG8_STAGE(PG8_SB(1, 1), cB + hstep + kstep, voffB);
    PG8_WAIT_V(6); PG8_BAR;
    for (;;) {
        const bool has_next = S.next(ui + 1, nxt);
        const char* nA = has_next ? nxt.A : cA; const char* nB = has_next ? nxt.B : cB;
        if constexpr (GATHER) { if (has_next) { PG8_AOFFS(nxt, nA0, nA1); } else {
#pragma unroll
            for (int i = 0; i < 2; ++i) { nA0[i] = vA0[i]; nA1[i] = vA1[i]; } } }
        for (int t = 0; t < nt; t += 2) {
            const bool last = (t == nt - 2);
            const char* a1 = cA + (size_t)(t + 1) * kstep;
            const char* a2 = last ? nA : cA + (size_t)(t + 2) * kstep; const char* b2 = last ? nB : cB + (size_t)(t + 2) * kstep;
            const char* a3 = a2 + kstep; const char* b3 = b2 + kstep;
            unsigned u0[2], u1[2];
            if constexpr (GATHER) {
#pragma unroll
            for (int i = 0; i < 2; ++i) { u0[i] = last ? nA0[i] : vA0[i]; u1[i] = last ? nA1[i] : vA1[i]; } }
            PG8_LDB(B0, 0, 0); PG8_LDB(B1, 0, 1); PG8_SCHED; PG8_LDA(At, 0, 0); PG8_STAGE_A(PG8_SA(1, 1), a1, 1, vA0, vA1);
            PG8_WAIT_V(8); PG8_WAIT_L(0); PG8_BAR; PG8_MMA(0, 0, At, B0); PG8_MMA(0, 1, At, B1); PG8_BAR; PG8_SCHED;
            PG8_LDA(At, 0, 1); PG8_STAGE(PG8_SB(0, 0), b2, voffB); PG8_STAGE(PG8_SB(0, 1), b2 + hstep, voffB); PG8_STAGE_A(PG8_SA(0, 0), a2, 0, u0, u1);
            PG8_WAIT_V(8); PG8_WAIT_L(0); PG8_BAR; PG8_MMA(1, 0, At, B0); PG8_MMA(1, 1, At, B1); PG8_BAR; PG8_SCHED;
            PG8_LDB(B0, 1, 0); PG8_LDB(B1, 1, 1); PG8_SCHED; PG8_LDA(At, 1, 0); PG8_STAGE_A(PG8_SA(0, 1), a2, 1, u0, u1);
            PG8_WAIT_V(8); PG8_WAIT_L(0); PG8_BAR; PG8_MMA(0, 0, At, B0); PG8_MMA(0, 1, At, B1); PG8_BAR; PG8_SCHED;
            PG8_LDA(At, 1, 1); PG8_STAGE(PG8_SB(1, 0), b3, voffB); PG8_STAGE(PG8_SB(1, 1), b3 + hstep, voffB); PG8_STAGE_A(PG8_SA(1, 0), a3, 0, u0, u1);
            PG8_WAIT_V(8); PG8_WAIT_L(0); PG8_BAR; PG8_MMA(1, 0, At, B0); PG8_MMA(1, 1, At, B1); PG8_BAR; PG8_SCHED;
        }
        if (wr == 0) PG8_BAR;
        E(acc, cur, wr, wc, fr, fq, lds, lane);
        if (!has_next) break;
#pragma unroll
        for (int a = 0; a < 2; ++a)
#pragma unroll
            for (int b = 0; b < 2; ++b)
#pragma unroll
                for (int m = 0; m < 4; ++m)
#pragma unroll
                    for (int n = 0; n < 2; ++n) acc[a][b][m][n] = (f32x4){0.f, 0.f, 0.f, 0.f};
        cur = nxt; cA = nA; cB = nB; ++ui;
        if constexpr (GATHER) {
#pragma unroll
        for (int i = 0; i < 2; ++i) { vA0[i] = nA0[i]; vA1[i] = nA1[i]; } }
        if (wr == 1) PG8_BAR;
    }
    PG8_WAIT_V(0);
    PG8_BAR;
#undef PG8_SA
#undef PG8_SB
#undef PG8_STAGE
#undef PG8_STAGE_A
#undef PG8_LDA
#undef PG8_LDB
#undef PG8_MMA
#undef PG8_WAIT_V
#undef PG8_WAIT_L
#undef PG8_BAR
#undef PG8_SCHED
#undef PG8_AOFFS
}
}

constexpr int EPI_STG = 3 * 16384;
constexpr int EPI_STG2 = 131072 + 1024;
#define EPI_BAR() do { asm volatile("s_waitcnt lgkmcnt(0)" ::: "memory"); __builtin_amdgcn_s_barrier(); asm volatile("" ::: "memory"); } while (0)
DI void stg_rows_out(LAS unsigned char* R, unsigned char* grow0, size_t row_bytes, int wc, int lane) {
#pragma unroll
    for (int i = 0; i < 2; ++i) { const int row = 4 * wc + 2 * i + (lane >> 5), ch = lane & 31;
        const u32x4 v = *(const LAS u32x4*)(R + row * 512 + ((ch ^ (row & 7)) << 4));
        __builtin_nontemporal_store(v, (u32x4*)(grow0 + (size_t)row * row_bytes + ch * 16)); }
}
DI float h2f_lo(unsigned w) { return (float)__builtin_bit_cast(_Float16, (unsigned short)(w & 0xffffu)); }
DI float h2f_hi(unsigned w) { return (float)__builtin_bit_cast(_Float16, (unsigned short)(w >> 16)); }
DI unsigned pack_h2(float lo, float hi) { return (unsigned)__builtin_bit_cast(unsigned short, (_Float16)lo) | ((unsigned)__builtin_bit_cast(unsigned short, (_Float16)hi) << 16); }
struct EpiInProj {
    bf16_t* z; const unsigned* tabA; const unsigned* tabR; int dbg;
    DI void operator()(f32x4 (&acc)[2][2][4][2], const pg8::Unit& u, int wr, int wc, int fr, int fq, LAS unsigned char* lds, int lane) const {
        if (dbg == 2) {
#pragma unroll
            for (int a = 0; a < 2; ++a)
#pragma unroll
                for (int b = 0; b < 2; ++b)
#pragma unroll
                    for (int m = 0; m < 4; ++m)
#pragma unroll
                        for (int n = 0; n < 2; ++n) asm volatile("" :: "v"(acc[a][b][m][n]));
            return; }
        const int seg = (u.pn >> 2), colt = (u.pn & 3) * 256;
        bf16_t* zs = z + (size_t)seg * T * 1024;
        const float scale = (seg == 0) ? 0.08838834764831845f : (seg == 4 ? 0.0625f : 1.0f);
        const int row0 = u.pm * 256 + wr * 64 + fr;
        bf16_t* zp = zs + (size_t)row0 * 1024 + colt + wc * 32 + fq * 4;
        LAS unsigned char* R = lds + EPI_STG + wr * 8192;
#define EIP_STORE(ai_, m_, v00, v01, v10, v11) do { \
            { const f32x4 o = (v00) * scale; u32x2 w; w.x = pk2(o[0], o[1]); w.y = pk2(o[2], o[3]); *(LAS u32x2*)(R + fr * 512 + (((wc * 4 + (fq >> 1)) ^ (fr & 7)) << 4) + (fq & 1) * 8) = w; } \
            { const f32x4 o = (v01) * scale; u32x2 w; w.x = pk2(o[0], o[1]); w.y = pk2(o[2], o[3]); *(LAS u32x2*)(R + fr * 512 + (((wc * 4 + 2 + (fq >> 1)) ^ (fr & 7)) << 4) + (fq & 1) * 8) = w; } \
            { const f32x4 o = (v10) * scale; u32x2 w; w.x = pk2(o[0], o[1]); w.y = pk2(o[2], o[3]); *(LAS u32x2*)(R + fr * 512 + (((16 + wc * 4 + (fq >> 1)) ^ (fr & 7)) << 4) + (fq & 1) * 8) = w; } \
            { const f32x4 o = (v11) * scale; u32x2 w; w.x = pk2(o[0], o[1]); w.y = pk2(o[2], o[3]); *(LAS u32x2*)(R + fr * 512 + (((16 + wc * 4 + 2 + (fq >> 1)) ^ (fr & 7)) << 4) + (fq & 1) * 8) = w; } \
            EPI_BAR(); \
            stg_rows_out(R, (unsigned char*)(zs + (size_t)(u.pm * 256 + wr * 64 + (ai_) * 128 + (m_) * 16) * 1024 + colt), 2048, wc, lane); \
            EPI_BAR(); } while (0)
        if (seg == 3 || seg == 4) {
            const unsigned* tp = tabR + (size_t)row0 * 128 + wc * 32 + fq * 4;
            u32x4 tv[2][2];
            tv[0][0] = *(const u32x4*)(tp); tv[0][1] = *(const u32x4*)(tp + 16);
#pragma unroll
            for (int g = 0; g < 8; ++g) { const int ai = g >> 2, m = g & 3;
                if (g < 7) { const unsigned* tn = tp + (size_t)(((g + 1) >> 2) * 128 + ((g + 1) & 3) * 16) * 128; tv[(g + 1) & 1][0] = *(const u32x4*)(tn); tv[(g + 1) & 1][1] = *(const u32x4*)(tn + 16); }
                f32x4 r0[2], r1[2];
#pragma unroll
                for (int n = 0; n < 2; ++n) { const u32x4 tw = tv[g & 1][n];
                    const f32x4 cs = {h2f_lo(tw.x), h2f_lo(tw.y), h2f_lo(tw.z), h2f_lo(tw.w)}, sn = {h2f_hi(tw.x), h2f_hi(tw.y), h2f_hi(tw.z), h2f_hi(tw.w)};
                    const f32x4 x1 = acc[ai][0][m][n], x2 = acc[ai][1][m][n]; r0[n] = x1 * cs - x2 * sn; r1[n] = x2 * cs + x1 * sn; }
                if (dbg != 3) EIP_STORE(ai, m, r0[0], r0[1], r1[0], r1[1]);
            }
        } else if (seg <= 1 && wc == 0) {
            const unsigned* tp = tabA + (size_t)row0 * 16 + fq * 4;
            u32x4 tv[8];
#pragma unroll
            for (int g = 0; g < 8; ++g) tv[g] = *(const u32x4*)(tp + (size_t)((g >> 2) * 128 + (g & 3) * 16) * 16);
#pragma unroll
            for (int g = 0; g < 8; ++g) { const int ai = g >> 2, m = g & 3; const u32x4 tw = tv[g];
                const f32x4 cs = {h2f_lo(tw.x), h2f_lo(tw.y), h2f_lo(tw.z), h2f_lo(tw.w)}, sn = {h2f_hi(tw.x), h2f_hi(tw.y), h2f_hi(tw.z), h2f_hi(tw.w)};
                const f32x4 a1 = acc[ai][0][m][0], a2 = acc[ai][0][m][1], b1 = acc[ai][1][m][0], b2 = acc[ai][1][m][1];
                if (dbg != 3) EIP_STORE(ai, m, a1 * cs - a2 * sn, a2 * cs + a1 * sn, b1 * cs - b2 * sn, b2 * cs + b1 * sn);
            }
        } else {
#pragma unroll
            for (int g = 0; g < 8; ++g) { const int ai = g >> 2, m = g & 3;
                if (dbg != 3) EIP_STORE(ai, m, acc[ai][0][m][0], acc[ai][0][m][1], acc[ai][1][m][0], acc[ai][1][m][1]); }
        }
#undef EIP_STORE
    }
};

struct EpiOutProj {
    const float* x; const float* mu0; const float* rstd0; const float* g0; const float* b0; const float* mod; float* t; float* part;
    DI void operator()(f32x4 (&acc)[2][2][4][2], const pg8::Unit& u, int wr, int wc, int fr, int fq, LAS unsigned char* lds, int lane) const {
        const int col0 = u.pn * 256 + wc * 32 + fq * 8;
        const int b = (u.pm * 256) / SEQ;
        const float* g1 = mod + (size_t)b * 6 * D + 2 * D;
        const int row0 = u.pm * 256 + wr * 64 + fr;
        f32x4 pa[2][2];
#pragma unroll
        for (int bj = 0; bj < 2; ++bj)
#pragma unroll
            for (int n = 0; n < 2; ++n) { const int c = col0 + bj * 128 + n * 4;
                pa[bj][n] = DN_ALPHA * *(const f32x4*)(g0 + c); const f32x4 pb = DN_ALPHA * *(const f32x4*)(b0 + c); const f32x4 pc = 1.0f + *(const f32x4*)(g1 + c);
#pragma unroll
                for (int ai = 0; ai < 2; ++ai)
#pragma unroll
                    for (int m = 0; m < 4; ++m) acc[ai][bj][m][n] = acc[ai][bj][m][n] * pc + pb; }
        f32x4 xv[3][2]; float mu[2], rs[2], ss = 0.f, qq = 0.f;
#define EOP_LD(k_) do { const int gn = (k_) >> 1, bn = (k_) & 1; const int rn = row0 + (gn >> 2) * 128 + (gn & 3) * 16; const float* xp = (const float*)((const char*)x + (unsigned)(rn * D + col0 + bn * 128) * 4u); \
            if (bn == 0) { mu[gn & 1] = mu0[rn]; rs[gn & 1] = rstd0[rn]; } \
            xv[(k_) % 3][0] = *(const f32x4*)(xp); xv[(k_) % 3][1] = *(const f32x4*)(xp + 4); } while (0)
        EOP_LD(0); EOP_LD(1);
#pragma unroll
        for (int k = 0; k < 16; ++k) { const int g = k >> 1, bj = k & 1, ai = g >> 2, m = g & 3; const int row = row0 + ai * 128 + m * 16;
            if (k < 14) EOP_LD(k + 2);
            bf16_t* tp = (bf16_t*)((char*)t + (unsigned)(row * D + col0 + bj * 128) * 2u);
            u32x4 w;
#pragma unroll
            for (int n = 0; n < 2; ++n) {
                const f32x4 o = (xv[k % 3][n] - mu[g & 1]) * rs[g & 1] * pa[bj][n] + acc[ai][bj][m][n];
                if (n == 0) { w.x = pk2(o[0], o[1]); w.y = pk2(o[2], o[3]); } else { w.z = pk2(o[0], o[1]); w.w = pk2(o[2], o[3]); }
                ss += (o[0] + o[1]) + (o[2] + o[3]); qq += (o[0] * o[0] + o[1] * o[1]) + (o[2] * o[2] + o[3] * o[3]); }
            __builtin_nontemporal_store(w, (u32x4*)tp);
            if (bj == 1) {
                ss += __shfl_xor(ss, 16); ss += __shfl_xor(ss, 32); qq += __shfl_xor(qq, 16); qq += __shfl_xor(qq, 32);
                if (fq == 0) *(f32x2*)((char*)part + (unsigned)(row * 32 + u.pn * 4 + wc) * 8u) = (f32x2){ss, qq};
                ss = 0.f; qq = 0.f; }
        }
#undef EOP_LD
    }
};

struct EpiMoeUp {
    bf16_t* act;
    DI void operator()(f32x4 (&acc)[2][2][4][2], const pg8::Unit& u, int wr, int wc, int fr, int fq, LAS unsigned char* lds, int lane) const {
#pragma unroll
        for (int ai = 0; ai < 2; ++ai)
#pragma unroll
            for (int mh = 0; mh < 2; ++mh) {
                LAS unsigned char* R = lds + (mh ? EPI_STG2 : EPI_STG) + wr * 8192;
#pragma unroll
                for (int mm = 0; mm < 2; ++mm) { const int m = 2 * mh + mm, r = mm * 16 + fr;
                    f32x4 o[2];
#pragma unroll
                    for (int n = 0; n < 2; ++n) { const f32x4 g = acc[ai][0][m][n], up = acc[ai][1][m][n];
#pragma unroll
                        for (int j = 0; j < 4; ++j) o[n][j] = g[j] / (1.0f + __expf(-g[j])) * up[j]; }
                    u32x4 w; w.x = pk2(o[0][0], o[0][1]); w.y = pk2(o[0][2], o[0][3]); w.z = pk2(o[1][0], o[1][1]); w.w = pk2(o[1][2], o[1][3]);
                    *(LAS u32x4*)(R + r * 256 + (((wc * 4 + fq) ^ (r & 15)) << 4)) = w; }
                EPI_BAR();
#pragma unroll
                for (int i = 0; i < 2; ++i) { const int r = 8 * wc + 4 * i + (lane >> 4), ch = lane & 15;
                    const u32x4 v = *(const LAS u32x4*)(R + r * 256 + ((ch ^ (r & 15)) << 4));
                    const int grow = u.pm * 256 + wr * 64 + ai * 128 + mh * 32 + r;
                    __builtin_nontemporal_store(v, (u32x4*)(act + (size_t)grow * FF + u.pn * 128 + ch * 8)); }
            }
        EPI_BAR();
    }
};
struct EpiMoeDown {
    bf16_t* Y;
    DI void operator()(f32x4 (&acc)[2][2][4][2], const pg8::Unit& u, int wr, int wc, int fr, int fq, LAS unsigned char* lds, int lane) const {
#pragma unroll
        for (int ai = 0; ai < 2; ++ai)
#pragma unroll
            for (int m = 0; m < 4; ++m) {
                LAS unsigned char* R = lds + ((m & 1) ? EPI_STG2 : EPI_STG) + wr * 8192;
#pragma unroll
                for (int bj = 0; bj < 2; ++bj) { const f32x4 a = acc[ai][bj][m][0], b = acc[ai][bj][m][1];
                    u32x4 w; w.x = pk2(a[0], a[1]); w.y = pk2(a[2], a[3]); w.z = pk2(b[0], b[1]); w.w = pk2(b[2], b[3]);
                    *(LAS u32x4*)(R + fr * 512 + (((bj * 16 + wc * 4 + fq) ^ (fr & 7)) << 4)) = w; }
                EPI_BAR();
                stg_rows_out(R, (unsigned char*)(Y + (size_t)(u.pm * 256 + wr * 64 + ai * 128 + m * 16) * D + u.pn * 256), (size_t)D * 2, wc, lane);
            }
        EPI_BAR();
    }
};

struct MoeOrder {
    const LAS int* pre; int NT, G, c, total; const char* A; const char* Bw; size_t bstride_e, tstepB, tstepA; const unsigned* lists; const unsigned* cnt; bool gather;
    DI bool next(int i, pg8::Unit& u) const {
        const long L = (long)i * G + c; if (L >= total) return false;
        const int mt = (int)(L / NT), nt = (int)(L % NT);
        int e = 0;
#pragma unroll 1
        for (int k = 1; k < NE; ++k) e += (pre[k] <= mt) ? 1 : 0;
        const int lm = mt - pre[e];
        u.pm = mt; u.pn = nt; u.e = e;
        u.B = Bw + (size_t)e * bstride_e + (size_t)nt * tstepB;
        if (gather) { u.A = A; u.rows = lists + (size_t)e * 65536 + lm * 256; const int cn = (int)cnt[e * 64] - lm * 256; u.nrows = cn < 256 ? cn : 256; }
        else { u.A = A + (size_t)mt * tstepA; u.rows = nullptr; u.nrows = 0; }
        return true;
    }
};

DI void phase_mod(const Ctx& X) {
    float* mod = (float*)(X.ws + CTL_MOD);
    LAS float* ps = (LAS float*)X.lds;
    LAS float* cs = (LAS float*)(X.lds + 16384);
    const int lane = X.lane_f();
    for (int i = X.tid_f(); i < 4 * D; i += NTHREADS) { const float cv = X.c()[i]; cs[i] = cv / (1.0f + expf(-cv)); }
    __syncthreads();
    for (int cgp = X.vcu; cgp < 96; cgp += X.G) {
        const float* W = X.w_ada() + (size_t)(X.wave * 256) * (6 * D) + cgp * 128 + lane * 2;
        f32x2 acc[4];
#pragma unroll
        for (int b = 0; b < 4; ++b) acc[b] = (f32x2){0.f, 0.f};
#pragma unroll 1
        for (int k0 = 0; k0 < 256; k0 += 16) {
            f32x2 wv[16];
#pragma unroll
            for (int kk = 0; kk < 16; ++kk) wv[kk] = *(const f32x2*)(W + (size_t)(k0 + kk) * (6 * D));
#pragma unroll
            for (int kk = 0; kk < 16; ++kk)
#pragma unroll
                for (int b = 0; b < 4; ++b) acc[b] += cs[b * D + X.wave * 256 + k0 + kk] * wv[kk];
        }
#pragma unroll
        for (int b = 0; b < 4; ++b) *(LAS f32x2*)(ps + (X.wave * 4 + b) * 128 + lane * 2) = acc[b];
        __syncthreads();
        { const int o = X.tid_f();
          float sum = X.b_ada()[cgp * 128 + (o & 127)];
#pragma unroll
          for (int w8 = 0; w8 < 8; ++w8) sum += ps[(w8 * 4 + (o >> 7)) * 128 + (o & 127)];
          mod[(size_t)(o >> 7) * 6 * D + cgp * 128 + (o & 127)] = sum; }
        __syncthreads();
    }
}

constexpr int TR_SCR = 16896;
template <class RowMap>
DI void transpose_item(const float* W, int K, int N, bf16_t* WT, const RowMap& rm, LAS float* scr, int item, int lane) {
    const int nblk = N / 64, kb = item / nblk, nb = item % nblk, k0 = 64 * kb, n0 = 64 * nb;
    f32x4 v[16];
#pragma unroll
    for (int r = 0; r < 16; ++r) v[r] = *(const f32x4*)(W + (size_t)(k0 + 4 * r + (lane >> 4)) * N + n0 + 4 * (lane & 15));
#pragma unroll
    for (int r = 0; r < 16; ++r) { LAS float* d = scr + (4 * r + (lane >> 4)) * 65 + 4 * (lane & 15); d[0] = v[r][0]; d[1] = v[r][1]; d[2] = v[r][2]; d[3] = v[r][3]; }
    LDS_WAIT();
    const int c = lane & 7;
#pragma unroll
    for (int j = 0; j < 8; ++j) { const int n = (lane >> 3) + 8 * j; const LAS float* sp = scr + (8 * c) * 65 + n;
        u32x4 o; o.x = pk2(sp[0 * 65], sp[1 * 65]); o.y = pk2(sp[2 * 65], sp[3 * 65]); o.z = pk2(sp[4 * 65], sp[5 * 65]); o.w = pk2(sp[6 * 65], sp[7 * 65]);
        *(u32x4*)(WT + (size_t)rm(n0 + n) * K + k0 + 8 * c) = o; }
    LDS_WAIT();
}
struct RowId { DI int operator()(int n) const { return n; } };
struct RowPerm32 { DI int operator()(int n) const { return (n & ~31) + 16 * ((n >> 2) & 1) + 4 * ((n >> 3) & 3) + (n & 3); } };
struct RowGate { int up; DI int operator()(int n) const { return (n >> 7) * 256 + up * 128 + (n & 127); } };

DI void sincos_f(float a, float& c, float& s) {
    const float k = rintf(a * 0.636619772f);
    float r = fmaf(-k, 1.5707855225e+00f, a); r = fmaf(-k, 1.0804334124e-05f, r);
    const float r2 = r * r;
    const float sn = fmaf(r * r2, fmaf(r2, fmaf(r2, fmaf(r2, 2.7557319e-6f, -1.9841270e-4f), 8.3333333e-3f), -1.6666667e-1f), r);
    const float cn = fmaf(r2 * r2, fmaf(r2, fmaf(r2, 2.4801587e-5f, -1.3888889e-3f), 4.1666667e-2f), fmaf(r2, -0.5f, 1.0f));
    const int qq = ((int)k) & 3;
    float so, co;
    if (qq == 0) { so = sn; co = cn; } else if (qq == 1) { so = cn; co = -sn; } else if (qq == 2) { so = -sn; co = -cn; } else { so = -cn; co = sn; }
    c = co; s = so;
}
DI void sincos_d(float angf, float& c, float& s) {
    const double a = (double)angf;
    const double k = rint(a * 0.63661977236758134308);
    double r = a - k * 1.57079632673412561417e+00; r -= k * 6.07710050650619224932e-11;
    const double r2 = r * r;
    double sp = -1.0 / 6227020800.0; sp = sp * r2 + 1.0 / 39916800.0; sp = sp * r2 - 1.0 / 362880.0; sp = sp * r2 + 1.0 / 5040.0; sp = sp * r2 - 1.0 / 120.0; sp = sp * r2 + 1.0 / 6.0;
    const double sn = r - r * r2 * sp;
    double cp = -1.0 / 87178291200.0; cp = cp * r2 + 1.0 / 479001600.0; cp = cp * r2 - 1.0 / 3628800.0; cp = cp * r2 + 1.0 / 40320.0; cp = cp * r2 - 1.0 / 720.0; cp = cp * r2 + 1.0 / 24.0;
    const double cn = 1.0 - 0.5 * r2 + r2 * r2 * cp;
    const long long q = (long long)k; const int qq = (int)(q & 3);
    double so, co;
    if (qq == 0) { so = sn; co = cn; } else if (qq == 1) { so = cn; co = -sn; } else if (qq == 2) { so = -sn; co = -cn; } else { so = -cn; co = sn; }
    c = (float)co; s = (float)so;
}

DI void phase_pre(const Ctx& X, const int parts = 7) {
    LAS float* scr = (LAS float*)(X.lds + X.wave * TR_SCR);
    bf16_t* WinT = (bf16_t*)(X.ws + WS_WIN); bf16_t* WoutT = (bf16_t*)(X.ws + WS_WOUT);
    constexpr int I_IN = (D / 64) * (NIN / 64), I_OUT = (D / 64) * (D / 64);
    if (parts & 1) for (int it = X.gw; it < I_IN + I_OUT; it += X.NGW) {
        if (it < I_IN) transpose_item(X.w_in(), D, NIN, WinT, RowId{}, scr, it, X.lane_f());
        else transpose_item(X.w_out(), D, D, WoutT, RowPerm32{}, scr, it - I_IN, X.lane_f());
    }
    unsigned* tabA = (unsigned*)(X.ws + WS_TAB); unsigned* tabR = tabA + (size_t)T * 16;
    {
        const long gt = (long)X.gw * 64 + X.lane_f(), NGT = (long)X.NGW * 64;
        LAS float* invs = (LAS float*)(X.lds + 8 * TR_SCR);
        __syncthreads();
        if (X.tid_f() < 144) { const int f = X.tid_f(); float inv;
            if (f < 16) inv = (float)exp(-((double)(2 * f) / 32.0) * 13.122363377404328);
            else { const float tt = (float)(f - 16) / 127.0f; inv = (float)exp(-(double)tt * 9.210340371976184); }
            invs[f] = inv; }
        __syncthreads();
        if (parts & 2) for (int i = (int)gt; i < T * 144; i += (int)NGT) {
            const int tok = i / 144, f = i - tok * 144;
            const float pos = (float)X.positions()[tok];
            const float inv = invs[f];
            const float ang = pos * inv; float c, s; sincos_f(ang, c, s);
            if (f < 16) tabA[(size_t)tok * 16 + f] = pack_h2(c, s); else tabR[(size_t)tok * 128 + f - 16] = pack_h2(c, s);
        }
        bf16_t* WRh = (bf16_t*)(X.ws + WS_WR + 512 * 1024); bf16_t* WRl = (bf16_t*)(X.ws + WS_WR + 768 * 1024);
        for (long i = gt; i < 48L * D; i += NGT) {
            const int col = (int)(i / D), k = (int)(i % D);
            const float wv = col < 32 ? X.w_sub()[((size_t)(col >> 3) * D + k) * 8 + (col & 7)] : (col < 36 ? X.w_group()[(size_t)k * 4 + (col - 32)] : 0.f);
            const unsigned hi = f2bf(wv); WRh[i] = (bf16_t)hi; WRl[i] = (bf16_t)f2bf(wv - bf2f(hi));
        }
        float* PP = (float*)(X.ws + WS_WR + 1024 * 1024); const float* modp = (const float*)(X.ws + CTL_MOD);
        for (long i = gt; i < 4L * D; i += NGT) {
            const int bb_ = (int)(i / D), k = (int)(i % D);
            const float sc = modp[(size_t)bb_ * 6 * D + 4 * D + k], sh = modp[(size_t)bb_ * 6 * D + 3 * D + k];
            PP[((size_t)bb_ * 2) * D + k] = X.ln1_g()[k] * (1.0f + sc); PP[((size_t)bb_ * 2 + 1) * D + k] = X.ln1_b()[k] * (1.0f + sc) + sh;
        }
    }
    const float* mod = (const float*)(X.ws + CTL_MOD);
    float* mu0 = (float*)(X.ws + WS_STAT0); float* rstd0 = mu0 + T;
    bf16_t* h = (bf16_t*)(X.ws + WS_A);
    if (parts & 4) {
        const int lane = X.lane_f();
        const int rowb = X.gw * 16; const int b = rowb / SEQ;
        LAS float* prm = (LAS float*)X.lds;
        { const float* sh1p = mod + (size_t)b * 6 * D; const float* sc1p = sh1p + D;
          __syncthreads();
          for (int i = X.tid_f(); i < D; i += NTHREADS) { prm[i] = X.ln0_g()[i]; prm[D + i] = X.ln0_b()[i]; prm[2 * D + i] = 1.0f + sc1p[i]; prm[3 * D + i] = sh1p[i]; }
          __syncthreads(); }
        f32x4 v[2][8], vn[2][8];
#pragma unroll
        for (int rr = 0; rr < 2; ++rr) { const f32x4* xr = (const f32x4*)(X.x() + (size_t)(rowb + rr) * D) + lane;
#pragma unroll
            for (int j = 0; j < 8; ++j) vn[rr][j] = xr[64 * j]; }
#pragma unroll 1
        for (int k8 = 0; k8 < 8; ++k8) {
            const int rowa = rowb + 2 * k8;
#pragma unroll
            for (int rr = 0; rr < 2; ++rr)
#pragma unroll
                for (int j = 0; j < 8; ++j) v[rr][j] = vn[rr][j];
            float mean[2], rstd[2];
#pragma unroll
            for (int rr = 0; rr < 2; ++rr) { float s_ = 0.f;
#pragma unroll
                for (int j = 0; j < 8; ++j) s_ += (v[rr][j][0] + v[rr][j][1]) + (v[rr][j][2] + v[rr][j][3]);
                mean[rr] = wave_sum(s_) * (1.0f / D); float s2 = 0.f;
#pragma unroll
                for (int j = 0; j < 8; ++j) { v[rr][j] = v[rr][j] - mean[rr]; s2 += (v[rr][j][0] * v[rr][j][0] + v[rr][j][1] * v[rr][j][1]) + (v[rr][j][2] * v[rr][j][2] + v[rr][j][3] * v[rr][j][3]); }
                rstd[rr] = 1.0f / sqrtf(wave_sum(s2) * (1.0f / D) + LN_EPS); }
            if (k8 < 7) {
#pragma unroll
                for (int rr = 0; rr < 2; ++rr) { const f32x4* xr = (const f32x4*)(X.x() + (size_t)(rowa + 2 + rr) * D) + lane;
#pragma unroll
                    for (int j = 0; j < 8; ++j) vn[rr][j] = xr[64 * j]; } }
            asm volatile("" ::: "memory");
            if (lane == 0) { mu0[rowa] = mean[0]; rstd0[rowa] = rstd[0]; mu0[rowa + 1] = mean[1]; rstd0[rowa + 1] = rstd[1]; }
#pragma unroll
            for (int j = 0; j < 8; ++j) { const int c = 4 * lane + 256 * j;
                const f32x4 gg = *(const LAS f32x4*)(prm + c), bb = *(const LAS f32x4*)(prm + D + c), sc = *(const LAS f32x4*)(prm + 2 * D + c), sh = *(const LAS f32x4*)(prm + 3 * D + c);
#pragma unroll
                for (int rr = 0; rr < 2; ++rr) { const f32x4 xn = v[rr][j] * rstd[rr] * gg + bb; const f32x4 hv = xn * sc + sh;
                    u32x2 w; w.x = pk2(hv[0], hv[1]); w.y = pk2(hv[2], hv[3]); ((u32x2*)(h + (size_t)(rowa + rr) * D) + lane)[64 * j] = w; } }
        }
    }
}

DI void phase_attn_naive(const Ctx& X) {
    const bf16_t* aq = (const bf16_t*)(X.ws + WS_B); const bf16_t* ak = aq + (size_t)T * 1024; const bf16_t* av = ak + (size_t)T * 1024;
    bf16_t* mix = (bf16_t*)(X.ws + WS_A);
    LAS float* qs = (LAS float*)(X.lds + X.wave * 1024);
    for (int it = X.gw; it < T * AH; it += X.NGW) {
        const int row = it >> 3, hh = it & 7, s = row & (SEQ - 1);
        { const unsigned w = *(const unsigned*)(aq + (size_t)row * 1024 + hh * 128 + 2 * X.lane_f()); qs[2 * X.lane_f()] = bflo(w); qs[2 * X.lane_f() + 1] = bfhi(w); }
        LDS_WAIT();
        float sc[9]; bool vd[9];
#pragma unroll
        for (int p = 0; p < 3; ++p) {
            const int dil = p == 0 ? 1 : (p == 1 ? 4 : 16);
#pragma unroll
            for (int ps = 0; ps < 3; ++ps) {
                const int j = ps == 0 ? X.lane_f() - 64 : (ps == 1 ? X.lane_f() : 64);
                const int sp = s + dil * j;
                const bool valid = (ps < 2 || X.lane_f() == 0) && sp >= 0 && sp < SEQ;
                const int spc = valid ? sp : s;
                const u32x4* kr = (const u32x4*)(ak + ((size_t)(row - s + spc)) * 1024 + hh * 128);
                float dot = 0.f;
#pragma unroll 4
                for (int ch = 0; ch < 16; ++ch) {
                    const u32x4 kw = kr[ch]; const f32x4 q0 = *(const LAS f32x4*)(qs + 8 * ch), q1 = *(const LAS f32x4*)(qs + 8 * ch + 4);
                    dot += bflo(kw.x) * q0[0] + bfhi(kw.x) * q0[1] + bflo(kw.y) * q0[2] + bfhi(kw.y) * q0[3] + bflo(kw.z) * q1[0] + bfhi(kw.z) * q1[1] + bflo(kw.w) * q1[2] + bfhi(kw.w) * q1[3];
                }
                sc[p * 3 + ps] = valid ? dot : -1e30f; vd[p * 3 + ps] = valid;
            }
        }
        float m = sc[0];
#pragma unroll
        for (int i = 1; i < 9; ++i) m = fmaxf(m, sc[i]);
        m = wave_max(m);
        float l = 0.f;
#pragma unroll
        for (int i = 0; i < 9; ++i) { sc[i] = vd[i] ? expf(sc[i] - m) : 0.f; l += sc[i]; }
        l = wave_sum(l);
        float a0 = 0.f, a1 = 0.f;
#pragma unroll
        for (int p = 0; p < 3; ++p) {
            const int dil = p == 0 ? 1 : (p == 1 ? 4 : 16);
#pragma unroll
            for (int ps = 0; ps < 3; ++ps) {
                const int nk = ps < 2 ? 64 : 1;
                for (int k = 0; k < nk; ++k) {
                    const float pk = __shfl(sc[p * 3 + ps], k);
                    if (pk != 0.f) {
                        const int j = ps == 0 ? k - 64 : (ps == 1 ? k : 64);
                        const unsigned w = *(const unsigned*)(av + ((size_t)(row + dil * j)) * 1024 + hh * 128 + 2 * X.lane_f());
                        a0 += pk * bflo(w); a1 += pk * bfhi(w);
                    }
                }
            }
        }
        const float il = 1.0f / l;
        *(unsigned*)(mix + (size_t)row * D + hh * 128 + 2 * X.lane_f()) = pk2(a0 * il, a1 * il);
        LDS_WAIT();
    }
}


typedef float f32x16 __attribute__((ext_vector_type(16)));
typedef short s16x4 __attribute__((ext_vector_type(4)));
typedef short v4i16_t __attribute__((ext_vector_type(4)));
DI s16x4 vtr(const LAS unsigned char* p) { return __builtin_bit_cast(s16x4, __builtin_amdgcn_ds_read_tr16_b64_v4i16((LAS v4i16_t*)p)); }
#define MFMA32(a, b, c) __builtin_amdgcn_mfma_f32_32x32x16_bf16((a), (b), (c), 0, 0, 0)
DI bf16x8 cat8(s16x4 lo, s16x4 hi) { return (bf16x8){lo[0], lo[1], lo[2], lo[3], hi[0], hi[1], hi[2], hi[3]}; }

DI unsigned offb(unsigned row, unsigned ch) { return 256u * row + 16u * (ch ^ (((row & 3u) << 2) | ((row >> 2) & 3u))); }
DI void dma16(const void* gsrc, unsigned lds_dst) { unsigned keep; asm volatile("s_mov_b32 %0, m0\n\ts_mov_b32 m0, %2\n\ts_nop 0\n\tglobal_load_lds_dwordx4 %1, off\n\ts_mov_b32 m0, %0" : "=&s"(keep) : "v"(gsrc), "s"(lds_dst) : "memory"); }
template <int IMM> DI void dma16s(unsigned voff, const void* sbase, unsigned lds_base) { unsigned keep; asm volatile("s_mov_b32 %0, m0\n\ts_add_u32 m0, %3, %4\n\ts_nop 0\n\tglobal_load_lds_dwordx4 %1, %2\n\ts_mov_b32 m0, %0" : "=&s"(keep) : "v"(voff), "s"(sbase), "s"(lds_base), "i"(IMM) : "memory", "scc"); }
constexpr int ATT_XROW = 264, ATT_MOFF = 131072, ATT_LOFF = ATT_MOFF + 1024;
static_assert(256 * ATT_XROW <= 131072 && ATT_LOFF + 1024 <= LDS_BYTES - 16, "attention LDS map");
DI void phase_attn(const Ctx& X, const int dbg = 0, const int split = 0) {
    const bf16_t* aq = (const bf16_t*)(X.ws + WS_B); const bf16_t* ak = aq + (size_t)T * 1024; const bf16_t* av = ak + (size_t)T * 1024;
    bf16_t* mix = (dbg & 4) ? (bf16_t*)(X.ws + WS_WIN) : (bf16_t*)(X.ws + WS_A);
    const int w = X.wave;
    LAS unsigned char* vbase = X.lds + w * 16384;
    LAS unsigned char* xbuf = X.lds; LAS float* mS = (LAS float*)(X.lds + ATT_MOFF); LAS float* lS = (LAS float*)(X.lds + ATT_LOFF);
    const float LOG2E = 1.4426950408889634f;
    const int nit = split ? ((X.vcu & 1) ? 5 : 3) : (BATCH * AH * (SEQ / 256) - X.vcu + X.G - 1) / X.G;
    for (int iti = 0; iti < nit; ++iti) {
        int item;
        if (split) { const int k = ((X.vcu & 1) ? 0 : 5) + iti, xq = X.vcu >> 5, jq = (X.vcu & 31) >> 1; item = (4 * xq + (k >> 1)) * 32 + 16 * (k & 1) + jq; }
        else item = X.vcu + iti * X.G;
        int lane = X.lane_f(); asm volatile("" : "+v"(lane));
        const int c = lane & 31, hh = lane >> 5, trq = (lane & 15) >> 2, trp = lane & 3, trblk = (lane >> 4) & 1;
        const int qb = item & 31, head = (item >> 5) & 7, b = item >> 8;
        const int t0 = qb * 256; const size_t rowbase = (size_t)b * SEQ;
        const char* akh0 = (const char*)ak + (rowbase * 1024 + head * 128) * 2;
        const char* avh = (const char*)av + (rowbase * 1024 + head * 128) * 2;
        f32x16 o[4];
#pragma unroll
        for (int dt = 0; dt < 4; ++dt)
#pragma unroll
            for (int i = 0; i < 16; ++i) o[dt][i] = 0.f;
        float m = -1e30f, l = 0.f;
        int offq = 0;
#pragma unroll 1
        for (int p = 0; p < 3; ++p) {
            const int sh = 2 * p, dil = 1 << sh;
            offq = p == 0 ? 32 * w + c : (p == 1 ? 128 * (w >> 2) + 4 * c + (w & 3) : (c < 16 ? 16 * c + 2 * w : 16 * (c - 16) + 2 * w + 1));
            if (p > 0) {
#pragma unroll
                for (int dt = 0; dt < 4; ++dt)
#pragma unroll
                    for (int g = 0; g < 4; ++g) { const u32x2 wv = *(const LAS u32x2*)(xbuf + offq * ATT_XROW + (32 * dt + 8 * g + 4 * hh) * 2);
                        o[dt][4 * g] = bflo(wv.x); o[dt][4 * g + 1] = bfhi(wv.x); o[dt][4 * g + 2] = bflo(wv.y); o[dt][4 * g + 3] = bfhi(wv.y); }
                m = mS[offq]; l = lS[offq];
                __syncthreads();
            }
            const int pq = t0 + offq;
            bf16x8 qf[8];
            { const char* qp = (const char*)aq + ((rowbase + pq) * 1024 + head * 128) * 2 + hh * 16;
#pragma unroll
              for (int s = 0; s < 8; ++s) qf[s] = *(const bf16x8*)(qp + 32 * s); }
            asm volatile("s_waitcnt vmcnt(0)" ::: "memory");
#pragma unroll
            for (int s = 0; s < 8; ++s) asm volatile("" : "+v"(qf[s]));
            const int ntile = p == 2 ? 10 : 5;
#define ATT_KB(ti_) (p == 0 ? t0 + 32 * w - 64 + 32 * ((ti_) % 5) : (p == 1 ? t0 + 4 * (32 * (w >> 2) - 64 + 32 * ((ti_) % 5)) + (w & 3) : t0 + 16 * (-64 + 32 * ((ti_) % 5)) + 2 * w + (ti_) / 5))
#define ATT_DMA(ti_, gbase_, buf_, KSWZ_) do { const int kb_ = (dbg & 1) ? 4096 : ATT_KB(ti_); int lane = X.lane_f(); asm volatile("" : "+v"(lane)); \
                _Pragma("unroll") for (int i = 0; i < 8; ++i) { const int r_ = (KSWZ_) ? 4 * i + (lane >> 4) : 8 * (i >> 1) + ((lane >> 2) & 7); int pk_ = kb_ + (r_ << sh); pk_ = pk_ < 0 ? 0 : (pk_ > SEQ - 1 ? SEQ - 1 : pk_); \
                    const int ch_ = (KSWZ_) ? ((lane & 15) ^ (r_ & 15)) : (4 * (2 * (i & 1) + (lane >> 5)) + ((lane & 3) ^ ((2 * ((i >> 1) & 1) + ((lane >> 4) & 1)) & 3))); \
                    dma16((gbase_) + (size_t)pk_ * 2048 + ch_ * 16, (unsigned)__builtin_amdgcn_readfirstlane((int)(unsigned)(size_t)((buf_) + i * 1024))); } } while (0)
            LAS unsigned char* kbuf = vbase; LAS unsigned char* vbuf = vbase + 8192;
            const unsigned kbuf_u = (unsigned)__builtin_amdgcn_readfirstlane((int)(unsigned)(size_t)kbuf), vbuf_u = kbuf_u + 8192u;
            const unsigned offK0 = (unsigned)(((lane >> 4) << sh) * 2048) + (unsigned)(((lane & 15) ^ (lane >> 4)) << 4);
            const unsigned offV0 = (unsigned)((((lane >> 2) & 7) << sh) * 2048) + (unsigned)((4 * (lane >> 5) + ((lane & 3) ^ ((lane >> 4) & 1))) << 4);
#define ATT_OFFK(q_) (offK0 ^ (unsigned)(64 * (q_)))
#define ATT_OFFV(q_) ((offV0 + (unsigned)(128 * ((q_) & 1))) ^ (unsigned)(32 * ((q_) >> 1)))
#define ATT_INR(kb_) (((kb_) >= 0) && ((kb_) + (31 << sh) < SEQ))
#define ATT_DMA2(ti_, gbase_, bufu_, KSWZ_) do { const int kbn_ = ATT_KB(ti_); \
                if (ATT_INR(kbn_) && !(dbg & 1)) { const char* sb_ = (gbase_) + (size_t)kbn_ * 2048; const size_t st_ = (size_t)(4 << sh) * 2048; \
                    dma16s<0>((KSWZ_) ? ATT_OFFK(0) : ATT_OFFV(0), sb_, bufu_); dma16s<1024>((KSWZ_) ? ATT_OFFK(1) : ATT_OFFV(1), sb_ + st_ * ((KSWZ_) ? 1 : 0), bufu_); \
                    dma16s<2048>((KSWZ_) ? ATT_OFFK(2) : ATT_OFFV(2), sb_ + st_ * 2, bufu_); dma16s<3072>((KSWZ_) ? ATT_OFFK(3) : ATT_OFFV(3), sb_ + st_ * ((KSWZ_) ? 3 : 2), bufu_); \
                    dma16s<4096>((KSWZ_) ? ATT_OFFK(0) : ATT_OFFV(0), sb_ + st_ * 4, bufu_); dma16s<5120>((KSWZ_) ? ATT_OFFK(1) : ATT_OFFV(1), sb_ + st_ * ((KSWZ_) ? 5 : 4), bufu_); \
                    dma16s<6144>((KSWZ_) ? ATT_OFFK(2) : ATT_OFFV(2), sb_ + st_ * 6, bufu_); dma16s<7168>((KSWZ_) ? ATT_OFFK(3) : ATT_OFFV(3), sb_ + st_ * ((KSWZ_) ? 7 : 6), bufu_); } \
                else ATT_DMA(ti_, gbase_, (LAS unsigned char*)nullptr + (bufu_), KSWZ_); } while (0)
            ATT_DMA2(0, akh0, kbuf_u, 1); ATT_DMA2(0, avh, vbuf_u, 0);
            const LAS unsigned char* kfa = kbuf + c * 256;
            const LAS unsigned char* vt0 = vbuf + 64 * (4 * hh + trq) + 16 * ((2 * trblk + (trp >> 1)) ^ (hh & 3)) + 8 * (trp & 1);
            const LAS unsigned char* vt1 = vbuf + 2048 + 64 * (4 * hh + trq) + 16 * ((2 * trblk + (trp >> 1)) ^ ((2 + hh) & 3)) + 8 * (trp & 1);
#pragma unroll 1
            for (int ti = 0; ti < ntile; ++ti) {
                const int kb = ATT_KB(ti), tau = ti % 5;
                const bool more = ti + 1 < ntile;
                asm volatile("s_waitcnt vmcnt(8)" ::: "memory");
                bf16x8 kf[8];
#pragma unroll
                for (int s = 0; s < 8; ++s) kf[s] = *(const LAS bf16x8*)(kfa + (((2 * s + hh) ^ (c & 15)) << 4));
                f32x16 sa;
#pragma unroll
                for (int i = 0; i < 16; ++i) sa[i] = 0.f;
                if (dbg & 8) { sa[0] = __builtin_bit_cast(float, (int)kf[0][0]) * 1e-30f; } else
#pragma unroll
                for (int s = 0; s < 8; ++s) sa = MFMA32(kf[s], qf[s], sa);
                __builtin_amdgcn_sched_barrier(0);
                if (more) ATT_DMA2(ti + 1, akh0, kbuf_u, 1);
                __builtin_amdgcn_sched_barrier(0);
                const bool cm = ((kb - pq) & (dil - 1)) == 0;
                const bool fullt = (tau >= 1) && (tau <= 3) && ATT_INR(kb);
                bf16x8 pf[2];
                if (dbg & 8) { l += sa[0]; } else
                if (fullt) {
                    float tmax = fmaxf(fmaxf(sa[0], sa[1]), fmaxf(sa[2], sa[3]));
#pragma unroll
                    for (int r = 4; r < 16; r += 4) tmax = fmaxf(tmax, fmaxf(fmaxf(sa[r], sa[r + 1]), fmaxf(sa[r + 2], sa[r + 3])));
                    tmax *= LOG2E;
                    tmax = fmaxf(tmax, __shfl_xor(tmax, 32));
                    tmax = cm ? tmax : -1e30f;
                    const float mn = fmaxf(m, tmax);
                    if (__any(mn > m)) { const float alpha = __builtin_amdgcn_exp2f(m - mn); l *= alpha;
#pragma unroll
                        for (int dt = 0; dt < 4; ++dt) o[dt] = o[dt] * alpha; }
                    m = mn;
                    const float mneg = cm ? -mn : -1e30f;
                    float ps = 0.f;
#pragma unroll
                    for (int r = 0; r < 16; ++r) { sa[r] = __builtin_amdgcn_exp2f(__builtin_fmaf(sa[r], LOG2E, mneg)); ps += sa[r]; }
                    ps += __shfl_xor(ps, 32);
                    l += ps;
                } else {
                    float tmax = -1e30f;
#pragma unroll
                    for (int r = 0; r < 16; ++r) { const int kr = (r & 3) + 8 * (r >> 2) + 4 * hh; const int pk = kb + (kr << sh); const int df = pk - pq; const int ad = df < 0 ? -df : df;
                        const bool vdr = cm && (pk >= 0) && (pk < SEQ) && (ad <= (64 << sh));
                        sa[r] = vdr ? sa[r] * LOG2E : -1e30f; tmax = fmaxf(tmax, sa[r]); }
                    tmax = fmaxf(tmax, __shfl_xor(tmax, 32));
                    const float mn = fmaxf(m, tmax);
                    if (__any(mn > m)) { const float alpha = __builtin_amdgcn_exp2f(m - mn); l *= alpha;
#pragma unroll
                        for (int dt = 0; dt < 4; ++dt) o[dt] = o[dt] * alpha; }
                    m = mn;
                    float ps = 0.f;
#pragma unroll
                    for (int r = 0; r < 16; ++r) { sa[r] = sa[r] > -1e29f ? __builtin_amdgcn_exp2f(sa[r] - mn) : 0.f; ps += sa[r]; }
                    ps += __shfl_xor(ps, 32);
                    l += ps;
                }
#pragma unroll
                for (int s = 0; s < 2; ++s) { u32x4 pw; pw.x = cvtpk(sa[8 * s], sa[8 * s + 1]); pw.y = cvtpk(sa[8 * s + 2], sa[8 * s + 3]); pw.z = cvtpk(sa[8 * s + 4], sa[8 * s + 5]); pw.w = cvtpk(sa[8 * s + 6], sa[8 * s + 7]); pf[s] = __builtin_bit_cast(bf16x8, pw); }
                if (more) asm volatile("s_waitcnt vmcnt(8)" ::: "memory"); else asm volatile("s_waitcnt vmcnt(0)" ::: "memory");
#pragma unroll
                for (int dt = 0; dt < ((dbg & 8) ? 0 : 4); ++dt)
#pragma unroll
                    for (int s = 0; s < 2; ++s) { const s16x4 lo = vtr(vt0 + 4096 * s + 512 * dt), hi = vtr(vt1 + 4096 * s + 512 * dt);
                        o[dt] = MFMA32(cat8(lo, hi), pf[s], o[dt]); }
                asm volatile("s_waitcnt lgkmcnt(0)" ::: "memory");
                __builtin_amdgcn_sched_barrier(0);
                if (more) ATT_DMA2(ti + 1, avh, vbuf_u, 0);
                __builtin_amdgcn_sched_barrier(0);
            }
#undef ATT_DMA2
#undef ATT_INR
#undef ATT_OFFK
#undef ATT_OFFV
#undef ATT_KB
#undef ATT_DMA
            if (p < 2) {
                __syncthreads();
#pragma unroll
                for (int dt = 0; dt < 4; ++dt)
#pragma unroll
                    for (int g = 0; g < 4; ++g) { u32x2 wv; wv.x = cvtpk(o[dt][4 * g], o[dt][4 * g + 1]); wv.y = cvtpk(o[dt][4 * g + 2], o[dt][4 * g + 3]);
                        *(LAS u32x2*)(xbuf + offq * ATT_XROW + (32 * dt + 8 * g + 4 * hh) * 2) = wv; }
                if (hh == 0) { mS[offq] = m; lS[offq] = l; }
                __syncthreads();
            }
        }
        const float il = 1.0f / l;
        bf16_t* orow = mix + ((dbg & 4) ? ((rowbase + t0 + offq) & 4095) : (rowbase + t0 + offq)) * D + head * 128;
        if (!(dbg & 3))
#pragma unroll
        for (int dt = 0; dt < 4; ++dt)
#pragma unroll
            for (int g = 0; g < 4; ++g) { u32x2 wv; wv.x = cvtpk(o[dt][4 * g] * il, o[dt][4 * g + 1] * il); wv.y = cvtpk(o[dt][4 * g + 2] * il, o[dt][4 * g + 3] * il);
                *(u32x2*)(orow + 32 * dt + 8 * g + 4 * hh) = wv; }
    }
}

constexpr float LOG2E_F = 1.4426950408889634f;
constexpr size_t ST_CHUNK = 65536;

DI void phase_ret_states(const Ctx& X, const int dbg = 0) {
    const bf16_t* rk = (const bf16_t*)(X.ws + WS_B) + (size_t)4 * T * 1024; const bf16_t* rv = rk + (size_t)T * 1024;
    bf16_t* STf = (bf16_t*)(X.ws + WS_YF); bf16_t* STb = (bf16_t*)(X.ws + WS_YB);
    const int lane = X.lane_f(), c = lane & 31, hh = lane >> 5, w = X.wave, tid = X.tid_f();
    const int trq = (lane & 15) >> 2, trp = lane & 3, trblk = (lane >> 4) & 1;
    constexpr int BUF = 65536 + 8192;
    for (int item = X.vcu; item < 256; item += X.G) {
        const int es = item & 7, dir = (item >> 3) & 1, bh = item >> 4, b = bh >> 2, head = bh & 3;
        const float lg2 = (dir ? X.ldb()[head] : X.ldf()[head]) * LOG2E_F; const float gC = exp2f(128.0f * lg2);
        bf16_t* ST = (dir ? STb : STf) + (size_t)bh * 64 * ST_CHUNK;
        f32x16 acc;
#pragma unroll
        for (int i = 0; i < 16; ++i) acc[i] = 0.f;
        u32x4 kregA[8], kregB[8], vregA, vregB;
        const int vj = tid >> 2, vp = tid & 3;
        const float zeta = exp2f((float)(dir ? vj : 127 - vj) * lg2);
#define RS_LOADG(n_, kreg, vreg4) do { const size_t rowc = (size_t)b * SEQ + 128 * (n_); \
            _Pragma("unroll") for (int i = 0; i < 8; ++i) { const int idx = tid + 512 * i, j = idx >> 5, cc = idx & 31; kreg[i] = *(const u32x4*)(rk + (rowc + j) * 1024 + head * 256 + cc * 8); } \
            vreg4 = *(const u32x4*)(rv + (rowc + vj) * 1024 + head * 256 + 32 * es + 8 * vp); } while (0)
#define RS_STORE(buf_, kreg, vreg4) do { LAS unsigned char* kimg = X.lds + (buf_) * BUF; LAS unsigned char* vimg = kimg + 65536; \
            _Pragma("unroll") for (int i = 0; i < 8; ++i) { const int idx = tid + 512 * i, j = idx >> 5, cc = idx & 31; *(LAS u32x4*)(kimg + (cc >> 4) * 32768 + offb(j, cc & 15)) = kreg[i]; } \
            u32x4 sv; sv.x = cvtpk(bflo(vreg4.x) * zeta, bfhi(vreg4.x) * zeta); sv.y = cvtpk(bflo(vreg4.y) * zeta, bfhi(vreg4.y) * zeta); sv.z = cvtpk(bflo(vreg4.z) * zeta, bfhi(vreg4.z) * zeta); sv.w = cvtpk(bflo(vreg4.w) * zeta, bfhi(vreg4.w) * zeta); \
            *(LAS u32x4*)(vimg + vj * 64 + vp * 16) = sv; } while (0)
#define RS_CHUNK(step_) (dir ? 63 - (step_) : (step_))
        RS_LOADG(RS_CHUNK(0), kregA, vregA); RS_STORE(0, kregA, vregA);
        RS_LOADG(RS_CHUNK(1), kregB, vregB);
        __syncthreads();
#define RS_STEP(step_, kregNext, vregNext, kregLoad, vregLoad) do { const int step = (step_); const int n = RS_CHUNK(step), buf = step & 1; \
            if (step + 2 < 64) RS_LOADG(RS_CHUNK(step + 2), kregLoad, vregLoad); \
            if (!(dbg & 1)) {   \
              _Pragma("unroll") for (int gp = 0; gp < 2; ++gp) { const int ga = 2 * gp, gb = 2 * gp + 1; \
                const unsigned a0 = cvtpk(acc[4 * ga], acc[4 * ga + 1]), a1 = cvtpk(acc[4 * ga + 2], acc[4 * ga + 3]), b0 = cvtpk(acc[4 * gb], acc[4 * gb + 1]), b1 = cvtpk(acc[4 * gb + 2], acc[4 * gb + 3]); \
                const unsigned r0 = __shfl_xor(hh ? a0 : b0, 32), r1 = __shfl_xor(hh ? a1 : b1, 32); \
                u32x4 wv; if (hh == 0) { wv.x = a0; wv.y = a1; wv.z = r0; wv.w = r1; } else { wv.x = r0; wv.y = r1; wv.z = b0; wv.w = b1; } \
                *(u32x4*)(ST + (size_t)n * ST_CHUNK + ((size_t)(4 * w + (hh ? gb : ga)) * 256 + 32 * es + c) * 8) = wv; } } \
            acc = acc * gC; \
            const LAS unsigned char* kimg = X.lds + buf * BUF + (w >> 2) * 32768; const LAS unsigned char* vimg = X.lds + buf * BUF + 65536; \
            if (!(dbg & 2)) _Pragma("unroll") for (int ks = 0; ks < 8; ++ks) { \
                const unsigned r0 = 16 * ks + 8 * hh + trq, r1 = r0 + 4, ch = 4 * (w & 3) + 2 * trblk + (trp >> 1); \
                const s16x4 a0 = vtr(kimg + offb(r0, ch) + 8 * (trp & 1)), a1 = vtr(kimg + offb(r1, ch) + 8 * (trp & 1)); \
                const s16x4 b0 = vtr(vimg + r0 * 64 + 32 * trblk + 8 * trp), b1 = vtr(vimg + r1 * 64 + 32 * trblk + 8 * trp); \
                acc = MFMA32(cat8(a0, a1), cat8(b0, b1), acc); } \
            if (step + 1 < 64 && !(dbg & 4)) RS_STORE(buf ^ 1, kregNext, vregNext); \
            __syncthreads(); } while (0)
#pragma unroll 1
        for (int s2 = 0; s2 < 64; s2 += 2) {
            RS_STEP(s2, kregB, vregB, kregA, vregA);
            RS_STEP(s2 + 1, kregA, vregA, kregB, vregB);
        }
#undef RS_STEP
#undef RS_CHUNK
#undef RS_LOADG
#undef RS_STORE
    }
}

DI void phase_ret_states64(const Ctx& X, const int q) {
    const bf16_t* rk = (const bf16_t*)(X.ws + WS_B) + (size_t)4 * T * 1024; const bf16_t* rv = rk + (size_t)T * 1024;
    bf16_t* STf = (bf16_t*)(X.ws + WS_YF); bf16_t* STb = (bf16_t*)(X.ws + WS_YB);
    const int lane = X.lane_f(), c = lane & 31, hh = lane >> 5, w = X.wave, tid = X.tid_f();
    const int trq = (lane & 15) >> 2, trp = lane & 3, trblk = (lane >> 4) & 1;
    const int es4 = q & 3, dir = (q >> 2) & 1, bh = q >> 3, b = bh >> 2, head = bh & 3;
    const float lg2 = (dir ? X.ldb()[head] : X.ldf()[head]) * LOG2E_F; const float gC = exp2f(128.0f * lg2);
    bf16_t* ST = (dir ? STb : STf) + (size_t)bh * 64 * ST_CHUNK;
    f32x16 acc[2];
#pragma unroll
    for (int et = 0; et < 2; ++et)
#pragma unroll
        for (int i = 0; i < 16; ++i) acc[et][i] = 0.f;
    u32x4 kregA[8], vregA[2];
    const int vj0 = tid >> 3, vj1 = (tid + 512) >> 3, vp = tid & 7;
    const float zeta0 = exp2f((float)(dir ? vj0 : 127 - vj0) * lg2), zeta1 = exp2f((float)(dir ? vj1 : 127 - vj1) * lg2);
    LAS unsigned char* vimg = X.lds + 131072;
#define R6_LOADG(n_, kreg, vreg) do { const size_t rowc = (size_t)b * SEQ + 128 * (n_); \
        _Pragma("unroll") for (int i = 0; i < 8; ++i) { const int idx = tid + 512 * i, j = idx >> 5, cc = idx & 31; kreg[i] = *(const u32x4*)(rk + (rowc + j) * 1024 + head * 256 + cc * 8); } \
        vreg[0] = *(const u32x4*)(rv + (rowc + vj0) * 1024 + head * 256 + 64 * es4 + 8 * vp); vreg[1] = *(const u32x4*)(rv + (rowc + vj1) * 1024 + head * 256 + 64 * es4 + 8 * vp); } while (0)
#define R6_STOREK(buf_, kreg) do { LAS unsigned char* kimg = X.lds + (buf_) * 65536; \
        _Pragma("unroll") for (int i = 0; i < 8; ++i) { const int idx = tid + 512 * i, j = idx >> 5, cc = idx & 31; *(LAS u32x4*)(kimg + (cc >> 4) * 32768 + offb(j, cc & 15)) = kreg[i]; } } while (0)
#define R6_SCALE(v_, z_) ({ u32x4 sv_; sv_.x = cvtpk(bflo((v_).x) * (z_), bfhi((v_).x) * (z_)); sv_.y = cvtpk(bflo((v_).y) * (z_), bfhi((v_).y) * (z_)); sv_.z = cvtpk(bflo((v_).z) * (z_), bfhi((v_).z) * (z_)); sv_.w = cvtpk(bflo((v_).w) * (z_), bfhi((v_).w) * (z_)); sv_; })
#define R6_STOREV(vreg) do { *(LAS u32x4*)(vimg + vj0 * 128 + vp * 16) = R6_SCALE(vreg[0], zeta0); *(LAS u32x4*)(vimg + vj1 * 128 + vp * 16) = R6_SCALE(vreg[1], zeta1); } while (0)
#define R6_CHUNK(step_) (dir ? 63 - (step_) : (step_))
    R6_LOADG(R6_CHUNK(0), kregA, vregA); R6_STOREK(0, kregA); R6_STOREV(vregA);
    __syncthreads();
#define R6_STEP(step_, kregNext, vregNext, kregLoad, vregLoad) do { const int step = (step_); const int n = R6_CHUNK(step), buf = step & 1; \
        if (step + 1 < 64) R6_LOADG(R6_CHUNK(step + 1), kregLoad, vregLoad); \
        _Pragma("unroll") for (int et = 0; et < 2; ++et) _Pragma("unroll") for (int gp = 0; gp < 2; ++gp) { const int ga = 2 * gp, gb = 2 * gp + 1; \
            const unsigned a0 = cvtpk(acc[et][4 * ga], acc[et][4 * ga + 1]), a1 = cvtpk(acc[et][4 * ga + 2], acc[et][4 * ga + 3]), b0 = cvtpk(acc[et][4 * gb], acc[et][4 * gb + 1]), b1 = cvtpk(acc[et][4 * gb + 2], acc[et][4 * gb + 3]); \
            const unsigned r0 = __shfl_xor(hh ? a0 : b0, 32), r1 = __shfl_xor(hh ? a1 : b1, 32); \
            u32x4 wv; if (hh == 0) { wv.x = a0; wv.y = a1; wv.z = r0; wv.w = r1; } else { wv.x = r0; wv.y = r1; wv.z = b0; wv.w = b1; } \
            *(u32x4*)(ST + (size_t)n * ST_CHUNK + ((size_t)(4 * w + (hh ? gb : ga)) * 256 + 64 * es4 + 32 * et + c) * 8) = wv; } \
        acc[0] = acc[0] * gC; acc[1] = acc[1] * gC; \
        const LAS unsigned char* kimg = X.lds + buf * 65536 + (w >> 2) * 32768; \
        _Pragma("unroll") for (int ks = 0; ks < 8; ++ks) { \
            const unsigned r0 = 16 * ks + 8 * hh + trq, r1 = r0 + 4, ch = 4 * (w & 3) + 2 * trblk + (trp >> 1); \
            const bf16x8 a = cat8(vtr(kimg + offb(r0, ch) + 8 * (trp & 1)), vtr(kimg + offb(r1, ch) + 8 * (trp & 1))); \
            _Pragma("unroll") for (int et = 0; et < 2; ++et) { \
                const s16x4 b0 = vtr(vimg + r0 * 128 + 64 * et + 32 * trblk + 8 * trp), b1 = vtr(vimg + r1 * 128 + 64 * et + 32 * trblk + 8 * trp); \
                acc[et] = MFMA32(a, cat8(b0, b1), acc[et]); } } \
        if (step + 1 < 64) R6_STOREK(buf ^ 1, kregNext); \
        __syncthreads();                                     \
        if (step + 1 < 64) R6_STOREV(vregNext); \
        __syncthreads(); } while (0)
#pragma unroll 1
    for (int s2 = 0; s2 < 64; ++s2) {
        R6_STEP(s2, kregA, vregA, kregA, vregA);
    }
#undef R6_STEP
#undef R6_CHUNK
#undef R6_LOADG
#undef R6_STOREK
#undef R6_STOREV
#undef R6_SCALE
}

DI void phase_ret_out(const Ctx& X, const int dbg = 0) {
    const bf16_t* rq = (const bf16_t*)(X.ws + WS_B) + (size_t)3 * T * 1024; const bf16_t* rk = rq + (size_t)T * 1024; const bf16_t* rv = rk + (size_t)T * 1024; const bf16_t* rg = rv + (size_t)T * 1024;
    const bf16_t* STf = (const bf16_t*)(X.ws + WS_YF); const bf16_t* STb = (const bf16_t*)(X.ws + WS_YB);
    bf16_t* mix = dbg ? (bf16_t*)(X.ws + WS_Y) : (bf16_t*)(X.ws + WS_A);
    const int w = X.wave;
    LAS unsigned char* qimg = X.lds; LAS unsigned char* kimg = X.lds + 65536; LAS unsigned char* pimg = kimg; LAS unsigned char* vimg = X.lds;
    LAS float* part = (LAS float*)(X.lds + 131072);
    for (int item = X.vcu; item < 1024; item += X.G) {
        int lane_o = X.lane_f(); asm volatile("" : "+v"(lane_o));
        int tid = X.tid_f(); asm volatile("" : "+v"(tid));
        const int c = lane_o & 31, hh = lane_o >> 5, trq = (lane_o & 15) >> 2, trp = lane_o & 3, trblk = (lane_o >> 4) & 1;
        const int n = item & 63, bh = item >> 6, b = bh >> 2, head = bh & 3; const size_t rowc = (size_t)b * SEQ + 128 * n;
        const float lg2f = X.ldf()[head] * LOG2E_F, lg2b = X.ldb()[head] * LOG2E_F;
        const bf16_t* spf = STf + ((size_t)bh * 64 + n) * ST_CHUNK + ((size_t)hh * 256 + 32 * w + c) * 8;
        const bf16_t* spb = STb + ((size_t)bh * 64 + n) * ST_CHUNK + ((size_t)hh * 256 + 32 * w + c) * 8;
        bf16x8 afA[8], afB[8];
#define RO_LOAD(dst, sp_, sh_) do { _Pragma("unroll") for (int s = 0; s < 8; ++s) dst[s] = *(const bf16x8*)((sp_) + (size_t)(8 * (sh_) + s) * 2 * 256 * 8); } while (0)
        {
            u32x4 qv[8], kv[8];
#pragma unroll
            for (int i = 0; i < 8; ++i) { const int idx = tid + 512 * i, j = idx >> 5, cc = idx & 31;
                qv[i] = *(const u32x4*)(rq + (rowc + j) * 1024 + head * 256 + cc * 8); kv[i] = *(const u32x4*)(rk + (rowc + j) * 1024 + head * 256 + cc * 8); }
            if (!(dbg & 2)) { RO_LOAD(afA, spf, 0); RO_LOAD(afB, spf, 1); }
#pragma unroll
            for (int i = 0; i < 8; ++i) { const int idx = tid + 512 * i, j = idx >> 5, cc = idx & 31;
                *(LAS u32x4*)(qimg + j * 512 + ((cc ^ (j & 15)) << 4)) = qv[i]; *(LAS u32x4*)(kimg + j * 512 + ((cc ^ (j & 15)) << 4)) = kv[i]; }
        }
        __syncthreads();
        f32x16 acc[4];
#pragma unroll
        for (int it = 0; it < 4; ++it)
#pragma unroll
            for (int i = 0; i < 16; ++i) acc[it][i] = 0.f;
        {
#define RO_MMA(src, sh_) do { _Pragma("unroll") for (int it = 0; it < 4; ++it) { const int i = 32 * it + c; const LAS unsigned char* qrow = qimg + i * 512; \
                _Pragma("unroll") for (int s = 0; s < 8; ++s) acc[it] = MFMA32(src[s], *(const LAS bf16x8*)(qrow + (((2 * (8 * (sh_) + s) + hh) ^ (i & 15)) << 4)), acc[it]); \
                asm volatile("" ::: "memory"); } } while (0)
            if (!(dbg & 2)) {
            RO_MMA(afA, 0); RO_LOAD(afA, spb, 0);
            RO_MMA(afB, 1); RO_LOAD(afB, spb, 1);
#pragma unroll
            for (int it = 0; it < 4; ++it) { const int i = 32 * it + c; acc[it] = acc[it] * __builtin_amdgcn_exp2f((float)(i + 1) * lg2f - (float)(128 - i) * lg2b); }
            RO_MMA(afA, 0);
            RO_MMA(afB, 1);
            }
#pragma unroll
            for (int it = 0; it < 4; ++it) { const int i = 32 * it + c; acc[it] = acc[it] * __builtin_amdgcn_exp2f((float)(128 - i) * lg2b); }
#undef RO_LOAD
#undef RO_MMA
        }
        float pvv[2][16];
        {
            const int it = w & 3, i = 32 * it + c; const LAS unsigned char* qrow = qimg + i * 512;
#pragma unroll
            for (int jj = 0; jj < 2; ++jj) {
                const int jt = 2 * (w >> 2) + jj, j = 32 * jt + c; const LAS unsigned char* krow = kimg + j * 512;
                f32x16 sa;
#pragma unroll
                for (int r = 0; r < 16; ++r) sa[r] = 0.f;
#pragma unroll
                for (int s = 0; s < ((dbg & 4) ? 0 : 16); ++s) { sa = MFMA32(*(const LAS bf16x8*)(krow + (((2 * s + hh) ^ (j & 15)) << 4)), *(const LAS bf16x8*)(qrow + (((2 * s + hh) ^ (i & 15)) << 4)), sa);
                    if ((s & 3) == 3) asm volatile("" ::: "memory"); }
#pragma unroll
                for (int r = 0; r < 16; ++r) { const int jr = 32 * jt + (r & 3) + 8 * (r >> 2) + 4 * hh; const int df = i - jr;
                    const float dm = __builtin_amdgcn_exp2f(df >= 0 ? (float)df * lg2f : (float)(-df) * lg2b); pvv[jj][r] = sa[r] * dm; }
            }
        }
        __syncthreads();
        u32x4 gq[8];
        {
            const int it = w & 3, i = 32 * it + c;
#pragma unroll
            for (int jj = 0; jj < 2; ++jj) { const int jt = 2 * (w >> 2) + jj;
#pragma unroll
                for (int g = 0; g < 4; ++g) { u32x2 wv; wv.x = cvtpk(pvv[jj][4 * g], pvv[jj][4 * g + 1]); wv.y = cvtpk(pvv[jj][4 * g + 2], pvv[jj][4 * g + 3]);
                    *(LAS u32x2*)(pimg + i * 256 + (((4 * jt + g) ^ (i & 15)) << 4) + 8 * hh) = wv; } }
            u32x4 vv[8];
#pragma unroll
            for (int i2 = 0; i2 < 8; ++i2) { const int idx = tid + 512 * i2, j = idx >> 5, cc = idx & 31; vv[i2] = *(const u32x4*)(rv + (rowc + j) * 1024 + head * 256 + cc * 8); }
#pragma unroll
            for (int i2 = 0; i2 < 8; ++i2) { const int idx = tid + 512 * i2, j = idx >> 5, cc = idx & 31; gq[i2] = *(const u32x4*)(rg + (rowc + j) * 1024 + head * 256 + cc * 8); }
#pragma unroll
            for (int i2 = 0; i2 < 8; ++i2) { const int idx = tid + 512 * i2, j = idx >> 5, cc = idx & 31; *(LAS u32x4*)(vimg + (cc >> 4) * 32768 + offb(j, cc & 15)) = vv[i2]; }
        }
        __syncthreads();
        {
            const LAS unsigned char* vh = vimg + (w >> 2) * 32768;
#pragma unroll
            for (int ks = 0; ks < ((dbg & 4) ? 0 : 8); ++ks) {
                const unsigned r0 = 16 * ks + 8 * hh + trq, r1 = r0 + 4, ch = 4 * (w & 3) + 2 * trblk + (trp >> 1);
                const bf16x8 a = cat8(vtr(vh + offb(r0, ch) + 8 * (trp & 1)), vtr(vh + offb(r1, ch) + 8 * (trp & 1)));
#pragma unroll
                for (int it = 0; it < 4; ++it) { const int i = 32 * it + c; acc[it] = MFMA32(a, *(const LAS bf16x8*)(pimg + i * 256 + (((2 * ks + hh) ^ (i & 15)) << 4)), acc[it]); }
                if (ks & 1) asm volatile("" ::: "memory");
            }
        }
#pragma unroll
        for (int it = 0; it < 4; ++it) { float s1 = 0.f, s2 = 0.f;
#pragma unroll
            for (int r = 0; r < 16; ++r) { s1 += acc[it][r]; s2 += acc[it][r] * acc[it][r]; }
            s1 += __shfl_xor(s1, 32); s2 += __shfl_xor(s2, 32);
            if (hh == 0) *(LAS f32x2*)(part + (w * 128 + 32 * it + c) * 2) = (f32x2){s1, s2}; }
        __syncthreads();
#pragma unroll
        for (int it = 0; it < 4; ++it) { const int i = 32 * it + c; float s1 = 0.f, s2 = 0.f;
#pragma unroll
            for (int ww = 0; ww < 8; ++ww) { const f32x2 pp = *(const LAS f32x2*)(part + (ww * 128 + i) * 2); s1 += pp[0]; s2 += pp[1]; }
            const float mean = s1 * (1.0f / 256.0f); const float var = fmaxf(s2 * (1.0f / 256.0f) - mean * mean, 0.f); const float rstd = 1.0f / sqrtf(var + LN_EPS);
#pragma unroll
            for (int g = 0; g < 4; ++g) { f32x4 y; y[0] = (acc[it][4 * g] - mean) * rstd; y[1] = (acc[it][4 * g + 1] - mean) * rstd; y[2] = (acc[it][4 * g + 2] - mean) * rstd; y[3] = (acc[it][4 * g + 3] - mean) * rstd;
                *(LAS f32x4*)(X.lds + i * 1024 + (((8 * w + hh + 2 * g) ^ (i & 15)) << 4)) = y; }
        }
        __syncthreads();
#pragma unroll
        for (int i2 = 0; i2 < 8; ++i2) { const int idx = tid + 512 * i2, j = idx >> 5, cc = idx & 31;
            const f32x4 y0 = *(const LAS f32x4*)(X.lds + j * 1024 + (((2 * cc) ^ (j & 15)) << 4)), y1 = *(const LAS f32x4*)(X.lds + j * 1024 + (((2 * cc + 1) ^ (j & 15)) << 4));
            const u32x4 gw = gq[i2]; u32x4 wv;
#define RO_G(gwc, ya, yb) ({ const float ga = bflo(gwc), gb = bfhi(gwc); cvtpk(ga / (1.f + __expf(-ga)) * (ya), gb / (1.f + __expf(-gb)) * (yb)); })
            wv.x = RO_G(gw.x, y0[0], y0[1]); wv.y = RO_G(gw.y, y0[2], y0[3]); wv.z = RO_G(gw.z, y1[0], y1[1]); wv.w = RO_G(gw.w, y1[2], y1[3]);
#undef RO_G
            *(u32x4*)(mix + (rowc + j) * D + 1024 + head * 256 + cc * 8) = wv; }
        __syncthreads();
    }
}

DI void phase_ret_naive(const Ctx& X) {
    const bf16_t* rq = (const bf16_t*)(X.ws + WS_B) + (size_t)3 * T * 1024; const bf16_t* rk = rq + (size_t)T * 1024; const bf16_t* rv = rk + (size_t)T * 1024;
    LAS float* qsm = (LAS float*)X.lds;
    LAS float* ksm = qsm + 16 * 256;
    LAS float* vsm = ksm + 16 * 256;
    LAS float* yp = vsm + 16 * 64;
    const int e = X.tid_f() & 63, dq = X.wave;
    for (int it = X.vcu; it < 16 * 2 * 4; it += X.G) {
        const int eq = it & 3, dir = (it >> 2) & 1, bh = it >> 3, b = bh >> 2, hh = bh & 3;
        const float gam = expf(dir ? X.ldb()[hh] : X.ldf()[hh]);
        float* ybuf = (float*)(X.ws + (dir ? WS_YB : WS_YF));
        float st[32];
#pragma unroll
        for (int i = 0; i < 32; ++i) st[i] = 0.f;
        for (int blk = 0; blk < SEQ / 16; ++blk) {
            const int t0 = dir ? (SEQ - 16 - 16 * blk) : 16 * blk;
            const size_t row0 = (size_t)b * SEQ + t0;
            {
                const int tt = X.tid_f() >> 5, c8 = (X.tid_f() & 31) * 8;
                const u32x4 qw = *(const u32x4*)(rq + (row0 + tt) * 1024 + hh * 256 + c8), kw = *(const u32x4*)(rk + (row0 + tt) * 1024 + hh * 256 + c8);
                LAS float* qd = qsm + tt * 256 + c8; LAS float* kd = ksm + tt * 256 + c8;
                qd[0] = bflo(qw.x); qd[1] = bfhi(qw.x); qd[2] = bflo(qw.y); qd[3] = bfhi(qw.y); qd[4] = bflo(qw.z); qd[5] = bfhi(qw.z); qd[6] = bflo(qw.w); qd[7] = bfhi(qw.w);
                kd[0] = bflo(kw.x); kd[1] = bfhi(kw.x); kd[2] = bflo(kw.y); kd[3] = bfhi(kw.y); kd[4] = bflo(kw.z); kd[5] = bfhi(kw.z); kd[6] = bflo(kw.w); kd[7] = bfhi(kw.w);
                if (X.tid_f() < 256) { const int t2 = X.tid_f() >> 4, c4 = (X.tid_f() & 15) * 4; const u32x2 vw = *(const u32x2*)(rv + (row0 + t2) * 1024 + hh * 256 + eq * 64 + c4);
                    LAS float* vd = vsm + t2 * 64 + c4; vd[0] = bflo(vw.x); vd[1] = bfhi(vw.x); vd[2] = bflo(vw.y); vd[3] = bfhi(vw.y); }
            }
            __syncthreads();
#pragma unroll 1
            for (int i = 0; i < 16; ++i) {
                const int tt = dir ? 15 - i : i;
                const float vv = vsm[tt * 64 + e];
                const LAS float* kq = ksm + tt * 256 + dq * 32; const LAS float* qq = qsm + tt * 256 + dq * 32;
                float y = 0.f;
                if (dir == 0) {
#pragma unroll
                    for (int d = 0; d < 32; ++d) { st[d] = gam * st[d] + kq[d] * vv; y += qq[d] * st[d]; }
                } else {
#pragma unroll
                    for (int d = 0; d < 32; ++d) { y += qq[d] * st[d]; st[d] = gam * st[d] + kq[d] * vv; }
                    y *= gam;
                }
                yp[(dq * 16 + tt) * 64 + e] = y;
            }
            __syncthreads();
            for (int o = X.tid_f(); o < 16 * 64; o += NTHREADS) {
                const int tt = o >> 6, ee = o & 63; float y = 0.f;
#pragma unroll
                for (int q = 0; q < 8; ++q) y += yp[(q * 16 + tt) * 64 + ee];
                ybuf[(row0 + tt) * 1024 + hh * 256 + eq * 64 + ee] = y;
            }
            __syncthreads();
        }
    }
}

DI void phase_ret_fin_naive(const Ctx& X) {
    const float* yf = (const float*)(X.ws + WS_YF); const float* yb = (const float*)(X.ws + WS_YB);
    const bf16_t* rg = (const bf16_t*)(X.ws + WS_B) + (size_t)6 * T * 1024;
    bf16_t* mix = (bf16_t*)(X.ws + WS_A);
    for (int it = X.gw; it < T * RH; it += X.NGW) {
        const int row = it >> 2, hh = it & 3; const size_t off = (size_t)row * 1024 + hh * 256 + 4 * X.lane_f();
        f32x4 y = *(const f32x4*)(yf + off) + *(const f32x4*)(yb + off);
        const float mean = wave_sum((y[0] + y[1]) + (y[2] + y[3])) * (1.0f / 256.0f);
        y = y - mean;
        const float var = wave_sum((y[0] * y[0] + y[1] * y[1]) + (y[2] * y[2] + y[3] * y[3])) * (1.0f / 256.0f);
        const float rstd = 1.0f / sqrtf(var + LN_EPS);
        const u32x2 gw = *(const u32x2*)(rg + off);
        const float g0 = bflo(gw.x), g1 = bfhi(gw.x), g2 = bflo(gw.y), g3 = bfhi(gw.y);
        f32x4 o; o[0] = g0 / (1.f + expf(-g0)) * y[0] * rstd; o[1] = g1 / (1.f + expf(-g1)) * y[1] * rstd; o[2] = g2 / (1.f + expf(-g2)) * y[2] * rstd; o[3] = g3 / (1.f + expf(-g3)) * y[3] * rstd;
        u32x2 w; w.x = pk2(o[0], o[1]); w.y = pk2(o[2], o[3]);
        *(u32x2*)(mix + (size_t)row * D + 1024 + hh * 256 + 4 * X.lane_f()) = w;
    }
}

DI void phase_w2_copy(const Ctx& X) {
    LAS float* scr = (LAS float*)(X.lds + X.wave * TR_SCR);
    bf16_t* W2 = (bf16_t*)(X.ws + WS_W2);
    unsigned* ctr = (unsigned*)(X.ws + CTL_WQ);
    constexpr int I_2 = (FF / 64) * (D / 64);
    for (;;) {
        unsigned it0 = 0;
        if (X.lane_f() == 0) it0 = __hip_atomic_fetch_add(ctr, 2u, __ATOMIC_RELAXED, __HIP_MEMORY_SCOPE_AGENT);
        it0 = (unsigned)__builtin_amdgcn_readfirstlane((int)it0);
        if (it0 >= (unsigned)(NE * I_2)) break;
        for (int j = 0; j < 2; ++j) {
            const int it = (int)it0 + j; const int e = it / I_2, r = it % I_2;
            transpose_item(X.w2() + (size_t)e * FF * D, FF, D, W2 + (size_t)e * D * FF, RowId{}, scr, r, X.lane_f());
        }
    }
}

DI void phase_route(const Ctx& X, const int parts) {
    if (parts & 1) {
        LAS float* scr = (LAS float*)(X.lds + X.wave * TR_SCR);
        bf16_t* W13 = (bf16_t*)(X.ws + WS_W13); bf16_t* W2 = (bf16_t*)(X.ws + WS_W2);
        constexpr int I_1 = (D / 64) * (FF / 64);
        for (int it = X.gw; it < NE * 2 * I_1; it += X.NGW) {
            const int e = it / (2 * I_1); const int r = it % (2 * I_1);
            if (r < I_1) transpose_item(X.w1() + (size_t)e * D * FF, D, FF, W13 + (size_t)e * 1024 * D, RowGate{0}, scr, r, X.lane_f());
            else transpose_item(X.w3() + (size_t)e * D * FF, D, FF, W13 + (size_t)e * 1024 * D, RowGate{1}, scr, r - I_1, X.lane_f());
        }
    }
    __syncthreads();
    const float* t = (const float*)(X.ws + WS_T); const float* part = (const float*)(X.ws + WS_STAT1);
    const float* mod = (const float*)(X.ws + CTL_MOD); const float* WRt = (const float*)(X.ws + WS_WR);
    bf16_t* h2 = (bf16_t*)(X.ws + WS_H2);
    unsigned* slot = (unsigned*)(X.ws + WS_SLOT); float* wt = (float*)(X.ws + WS_WT); unsigned* lists = (unsigned*)(X.ws + WS_LIST); unsigned* cnt = (unsigned*)(X.ws + CTL_CNT);
    const bf16_t* WRh = (const bf16_t*)(X.ws + WS_WR + 512 * 1024); const bf16_t* WRl = (const bf16_t*)(X.ws + WS_WR + 768 * 1024);
    const float* PP = (const float*)(X.ws + WS_WR + 1024 * 1024);
    LAS float* lgl = (LAS float*)(X.lds + X.wave * 4096);
    constexpr int RW_PP = 32768, RW_BUF = 49152, RW_CH = 49152, RW_LO = 24576;
    LAS float* PPl = (LAS float*)(X.lds + RW_PP);
    if (parts & 2) for (int g0 = X.vcu * NWAVES; g0 < T / 16; g0 += X.NGW) {
        int lane = X.lane_f(); asm volatile("" : "+v"(lane));
        int tid = X.tid_f(); asm volatile("" : "+v"(tid));
        const int grp = g0 + X.wave;
        const int row0 = grp * 16, b = row0 / SEQ, r = lane & 15, kq = lane >> 4, row = row0 + r;
        float ps = 0.f, pq = 0.f;
        { const f32x4* pp = (const f32x4*)(part + ((size_t)row * 32 + kq * 8) * 2);
#pragma unroll
          for (int i = 0; i < 4; ++i) { const f32x4 x = pp[i]; ps += x[0] + x[2]; pq += x[1] + x[3]; } }
        ps += __shfl_xor(ps, 16); ps += __shfl_xor(ps, 32); pq += __shfl_xor(pq, 16); pq += __shfl_xor(pq, 32);
        const float mean = ps * (1.0f / D); const float var = fmaxf(pq * (1.0f / D) - mean * mean, 0.f); const float rstd = 1.0f / sqrtf(var + LN_EPS);
        __syncthreads();
#pragma unroll
        for (int i = 0; i < 2; ++i) *(LAS f32x4*)(PPl + 4 * (tid + 512 * i)) = *(const f32x4*)(PP + (size_t)b * 2 * D + 4 * (tid + 512 * i));
#define RW_DMA(ch_, bi_) do { _Pragma("unroll") for (int i_ = 0; i_ < 3; ++i_) { const int kb_ = 3 * X.wave + i_, col_ = 2 * kb_ + (lane >> 5), sl_ = (lane & 31) ^ (col_ & 15); \
            const unsigned ld_ = (unsigned)__builtin_amdgcn_readfirstlane((int)(unsigned)(size_t)(X.lds + RW_BUF + (bi_) * RW_CH + kb_ * 1024)); \
            dma16(WRh + (size_t)col_ * D + 256 * (ch_) + 8 * sl_, ld_); dma16(WRl + (size_t)col_ * D + 256 * (ch_) + 8 * sl_, ld_ + RW_LO); } } while (0)
        RW_DMA(0, 0);
        const bf16_t* trow = (const bf16_t*)t + (size_t)row * D + 16 * kq; bf16_t* hrow = h2 + (size_t)row * D + 16 * kq;
        u32x4 tcur[8], tnext[8];
#pragma unroll
        for (int j = 0; j < 8; ++j) tcur[j] = *(const u32x4*)(trow + 64 * (j >> 1) + 8 * (j & 1));
        f32x4 acc[3];
#pragma unroll
        for (int ct = 0; ct < 3; ++ct) acc[ct] = (f32x4){0.f, 0.f, 0.f, 0.f};
        asm volatile("s_waitcnt vmcnt(0)" ::: "memory");
        __syncthreads();
#pragma unroll 1
        for (int c = 0; c < 8; ++c) {
            if (c < 7) { RW_DMA(c + 1, (c + 1) & 1);
#pragma unroll
                for (int j = 0; j < 8; ++j) tnext[j] = *(const u32x4*)(trow + 256 * (c + 1) + 64 * (j >> 1) + 8 * (j & 1)); }
            const LAS unsigned char* wb = X.lds + RW_BUF + (c & 1) * RW_CH + r * 512;
#pragma unroll
            for (int mm = 0; mm < 4; ++mm) {
                const int kl = 256 * c + 64 * mm;
                u32x4 hi[2], lo[2];
#pragma unroll
                for (int sub = 0; sub < 2; ++sub) {
                    const u32x4 tw = tcur[2 * mm + sub]; const f32x4 ta = {bflo(tw.x), bfhi(tw.x), bflo(tw.y), bfhi(tw.y)}, tb = {bflo(tw.z), bfhi(tw.z), bflo(tw.w), bfhi(tw.w)};
                    const LAS float* P1 = PPl + kl + 16 * kq + 8 * sub; const LAS float* P2 = P1 + D;
                    const f32x4 p1a = *(const LAS f32x4*)(P1), p1b = *(const LAS f32x4*)(P1 + 4), p2a = *(const LAS f32x4*)(P2), p2b = *(const LAS f32x4*)(P2 + 4);
                    const f32x4 ha = (ta - mean) * rstd * p1a + p2a, hb = (tb - mean) * rstd * p1b + p2b;
                    hi[sub].x = cvtpk(ha[0], ha[1]); hi[sub].y = cvtpk(ha[2], ha[3]); hi[sub].z = cvtpk(hb[0], hb[1]); hi[sub].w = cvtpk(hb[2], hb[3]);
                    lo[sub].x = cvtpk(ha[0] - bflo(hi[sub].x), ha[1] - bfhi(hi[sub].x)); lo[sub].y = cvtpk(ha[2] - bflo(hi[sub].y), ha[3] - bfhi(hi[sub].y));
                    lo[sub].z = cvtpk(hb[0] - bflo(hi[sub].z), hb[1] - bfhi(hi[sub].z)); lo[sub].w = cvtpk(hb[2] - bflo(hi[sub].w), hb[3] - bfhi(hi[sub].w));
                }
                *(u32x4*)(hrow + kl) = hi[0]; *(u32x4*)(hrow + kl + 8) = hi[1];
#pragma unroll
                for (int sub = 0; sub < 2; ++sub) {
                    const bf16x8 ahi = __builtin_bit_cast(bf16x8, hi[sub]), alo = __builtin_bit_cast(bf16x8, lo[sub]);
                    const int so = ((8 * mm + 2 * kq + sub) ^ r) << 4;
#pragma unroll
                    for (int ct = 0; ct < 3; ++ct) {
                        const bf16x8 bh = *(const LAS bf16x8*)(wb + ct * 8192 + so), bl = *(const LAS bf16x8*)(wb + ct * 8192 + so + RW_LO);
                        acc[ct] = __builtin_amdgcn_mfma_f32_16x16x32_bf16(ahi, bh, acc[ct], 0, 0, 0);
                        acc[ct] = __builtin_amdgcn_mfma_f32_16x16x32_bf16(ahi, bl, acc[ct], 0, 0, 0);
                        acc[ct] = __builtin_amdgcn_mfma_f32_16x16x32_bf16(alo, bh, acc[ct], 0, 0, 0);
                    }
                }
            }
            asm volatile("s_waitcnt vmcnt(0)" ::: "memory");
            __syncthreads();
#pragma unroll
            for (int j = 0; j < 8; ++j) tcur[j] = tnext[j];
        }
#undef RW_DMA
#pragma unroll
        for (int ct = 0; ct < 3; ++ct)
#pragma unroll
            for (int g = 0; g < 4; ++g) lgl[(4 * kq + g) * 48 + 16 * ct + r] = acc[ct][g];
        LDS_WAIT();
        if (X.lane_f() < 16) {
            const LAS float* lg = lgl + X.lane_f() * 48;
            float gl[4];
#pragma unroll
            for (int g = 0; g < 4; ++g) gl[g] = lg[32 + g] + X.b_group()[g];
            int gs = 0; float gm = gl[0];
#pragma unroll
            for (int g = 1; g < 4; ++g) if (gl[g] > gm) { gm = gl[g]; gs = g; }
            float den = 0.f;
#pragma unroll
            for (int g = 0; g < 4; ++g) den += expf(gl[g] - gm);
            const float pg = 1.0f / den;
            float sl[8];
#pragma unroll
            for (int e = 0; e < 8; ++e) sl[e] = lg[gs * 8 + e] + X.b_sub()[gs * 8 + e];
            int i0 = 0; float v0 = sl[0];
#pragma unroll
            for (int e = 1; e < 8; ++e) if (sl[e] > v0) { v0 = sl[e]; i0 = e; }
            int i1 = -1; float v1 = -3.0e38f;
#pragma unroll
            for (int e = 0; e < 8; ++e) if (e != i0 && sl[e] > v1) { v1 = sl[e]; i1 = e; }
            const float e1 = expf(v1 - v0); const float w0 = pg / (1.0f + e1), w1 = pg * e1 / (1.0f + e1);
            if (!(parts & 8)) {
                const int rw = row0 + X.lane_f(), ea = gs * 8 + i0, eb = gs * 8 + i1;
                const unsigned pa = atomicAdd(cnt + ea * 64, 1u), pb = atomicAdd(cnt + eb * 64, 1u);
                lists[(size_t)ea * 65536 + pa] = (unsigned)rw; lists[(size_t)eb * 65536 + pb] = (unsigned)rw;
                slot[rw * 2] = ((unsigned)ea << 20) | pa; slot[rw * 2 + 1] = ((unsigned)eb << 20) | pb;
                wt[rw * 2] = w0; wt[rw * 2 + 1] = w1;
            }
        }
        LDS_WAIT();
    }
}

DI int moe_prefix(const Ctx& X, LAS int* pre) {
    const unsigned* cnt = (const unsigned*)(X.ws + CTL_CNT);
    if (X.tid_f() == 0) { int s = 0; for (int e = 0; e < NE; ++e) { pre[e] = s; s += ((int)__hip_atomic_load(cnt + e * 64, __ATOMIC_RELAXED, __HIP_MEMORY_SCOPE_AGENT) + 255) >> 8; } pre[NE] = s; }
    __syncthreads();
    return pre[NE];
}

DI void phase_final(const Ctx& X) {
    LAS int* pre = (LAS int*)(X.lds + LDS_MISC);
    moe_prefix(X, pre);
    const float* t = (const float*)(X.ws + WS_T); const float* part = (const float*)(X.ws + WS_STAT1);
    const float* mod = (const float*)(X.ws + CTL_MOD);
    const bf16_t* Y = (const bf16_t*)(X.ws + WS_Y);
    const unsigned* slot = (const unsigned*)(X.ws + WS_SLOT); const float* wt = (const float*)(X.ws + WS_WT);
    LAS float* prm = (LAS float*)(X.lds + 1024);
    { __syncthreads();
      for (int i = X.tid_f(); i < D; i += NTHREADS) { prm[i] = X.ln1_g()[i]; prm[D + i] = X.ln1_b()[i]; prm[3 * D + i] = X.ln2_g()[i]; prm[4 * D + i] = X.ln2_b()[i];
#pragma unroll
          for (int bb = 0; bb < 4; ++bb) prm[(5 + bb) * D + i] = 1.0f + mod[(size_t)bb * 6 * D + 5 * D + i]; }
      __syncthreads(); }
    {
      u32x4 nsl = *(const u32x4*)(slot + (size_t)4 * X.gw); f32x4 nwt = *(const f32x4*)(wt + (size_t)4 * X.gw);
#pragma unroll 1
      for (int k8 = 0; k8 < 8; ++k8) {
        const int rowa = 2 * (X.gw + k8 * X.NGW);
        const int b = rowa / SEQ; const LAS float* g2l = prm + (5 + b) * D;
        f32x4 tv[2][8]; u32x2 ya[2][8], yb[2][8]; float w0[2], w1[2], mean[2], rstd[2];
        const u32x4 csl = nsl; const f32x4 cwt = nwt;
#pragma unroll
        for (int rr = 0; rr < 2; ++rr) {
            const int row = rowa + rr;
            const unsigned s0 = rr ? csl.z : csl.x, s1 = rr ? csl.w : csl.y; w0[rr] = rr ? cwt[2] : cwt[0]; w1[rr] = rr ? cwt[3] : cwt[1];
            const size_t r0 = (size_t)pre[s0 >> 20] * 256 + (s0 & 0xfffffu), r1 = (size_t)pre[s1 >> 20] * 256 + (s1 & 0xfffffu);
            const u32x2* tr = (const u32x2*)((const bf16_t*)t + (size_t)row * D) + X.lane_f();
            const u32x2* y0 = (const u32x2*)(Y + r0 * D) + X.lane_f(); const u32x2* y1 = (const u32x2*)(Y + r1 * D) + X.lane_f();
#pragma unroll
            for (int j = 0; j < 8; ++j) { const u32x2 tw = tr[64 * j]; tv[rr][j] = (f32x4){bflo(tw.x), bfhi(tw.x), bflo(tw.y), bfhi(tw.y)}; ya[rr][j] = y0[64 * j]; yb[rr][j] = y1[64 * j]; }
            float ps = 0.f, pq = 0.f; if (X.lane_f() < 32) { const f32x2 p = *(const f32x2*)(part + ((size_t)row * 32 + X.lane_f()) * 2); ps = p[0]; pq = p[1]; }
            ps = wave_sum(ps); pq = wave_sum(pq);
            mean[rr] = ps * (1.0f / D); const float var = fmaxf(pq * (1.0f / D) - mean[rr] * mean[rr], 0.f); rstd[rr] = 1.0f / sqrtf(var + LN_EPS);
        }
        if (k8 < 7) { const size_t nrow = (size_t)2 * (X.gw + (k8 + 1) * X.NGW); nsl = *(const u32x4*)(slot + nrow * 2); nwt = *(const f32x4*)(wt + nrow * 2); }
        float s[2] = {0.f, 0.f};
#pragma unroll
        for (int j = 0; j < 8; ++j) {
            const int c = 4 * X.lane_f() + 256 * j;
            const f32x4 gg = *(const LAS f32x4*)(prm + c), bb = *(const LAS f32x4*)(prm + D + c), g2v = *(const LAS f32x4*)(g2l + c);
#pragma unroll
            for (int rr = 0; rr < 2; ++rr) {
                const f32x4 x1 = (tv[rr][j] - mean[rr]) * rstd[rr] * gg + bb;
                const u32x2 a = ya[rr][j], bq = yb[rr][j];
                f32x4 f; f[0] = w0[rr] * bflo(a.x) + w1[rr] * bflo(bq.x); f[1] = w0[rr] * bfhi(a.x) + w1[rr] * bfhi(bq.x); f[2] = w0[rr] * bflo(a.y) + w1[rr] * bflo(bq.y); f[3] = w0[rr] * bfhi(a.y) + w1[rr] * bfhi(bq.y);
                const f32x4 uu = DN_ALPHA * x1 + g2v * f; tv[rr][j] = uu;
                s[rr] += (uu[0] + uu[1]) + (uu[2] + uu[3]);
            }
        }
#pragma unroll
        for (int rr = 0; rr < 2; ++rr) {
            const float m2 = wave_sum(s[rr]) * (1.0f / D); float q = 0.f;
#pragma unroll
            for (int j = 0; j < 8; ++j) { tv[rr][j] = tv[rr][j] - m2; q += (tv[rr][j][0] * tv[rr][j][0] + tv[rr][j][1] * tv[rr][j][1]) + (tv[rr][j][2] * tv[rr][j][2] + tv[rr][j][3] * tv[rr][j][3]); }
            const float rs2 = 1.0f / sqrtf(wave_sum(q) * (1.0f / D) + LN_EPS);
            f32x4* orow = (f32x4*)(X.out + (size_t)(rowa + rr) * D) + X.lane_f();
#pragma unroll
            for (int j = 0; j < 8; ++j) { const int c = 4 * X.lane_f() + 256 * j; __builtin_nontemporal_store(tv[rr][j] * rs2 * *(const LAS f32x4*)(prm + 3 * D + c) + *(const LAS f32x4*)(prm + 4 * D + c), orow + 64 * j); }
        }
      }
    }
}

#define XB_TMO      128
#define XB_XCNT(j)  (256  + 64 * (j))
#define XB_XSUB(j)  (1280 + 64 * (j))
#define XB_XGEN(j)  (2304 + 64 * (j))
#define XB_TOP      3328
#define XB_TOPGEN   3392
#define XCD_BAR_WORDS 3456
#define XB_SPIN_CAP (1u << 22)
DI unsigned xb_ld(unsigned* p)              { return __hip_atomic_load(p, __ATOMIC_RELAXED, __HIP_MEMORY_SCOPE_AGENT); }
DI unsigned xb_add(unsigned* p, unsigned v) { return __hip_atomic_fetch_add(p, v, __ATOMIC_RELAXED, __HIP_MEMORY_SCOPE_AGENT); }
DI unsigned xb_xcc_id() { return (unsigned)__builtin_amdgcn_s_getreg((3 << 11) | 20) & 0xFu; }
#define XB_SPIN(cond, bar) do { unsigned _sp = 0; while (cond) { __builtin_amdgcn_s_sleep(1); \
    if ((++_sp & 255u) == 0u) { if (xb_ld(&(bar)[XB_TMO])) break; if (_sp > XB_SPIN_CAP) { atomicAdd(&(bar)[XB_TMO], 1u); break; } } } } while (0)
struct XcdBarrier { unsigned* bar; unsigned x; volatile LAS unsigned* st; };
DI XcdBarrier xcd_barrier_post(unsigned* bar, volatile LAS unsigned* st, const bool t0) {
    XcdBarrier b; b.bar = bar; b.x = xb_xcc_id(); b.st = st;
    if (t0) (void)xb_add(&bar[XB_XCNT(b.x)], 1u);
    return b;
}
DI void xcd_barrier_complete(unsigned* bar, unsigned x, unsigned& nloc, unsigned& nx) {
    const unsigned G = gridDim.x * gridDim.y * gridDim.z;
    unsigned sum, cnt, mine, sp = 0u;
    for (;;) {
        sum = 0u; cnt = 0u; mine = 0u;
#pragma unroll
        for (unsigned j = 0; j < 16; ++j) { const unsigned c = xb_ld(&bar[XB_XCNT(j)]); sum += c; cnt += (c > 0u) ? 1u : 0u; mine = (j == x) ? c : mine; }
        if (sum == G) break;
        __builtin_amdgcn_s_sleep(1);
        if ((++sp & 255u) == 0u) { if (xb_ld(&bar[XB_TMO])) break; if (sp > XB_SPIN_CAP) { atomicAdd(&bar[XB_TMO], 1u); break; } }
    }
    nloc = mine > 0u ? mine : 1u; nx = cnt > 0u ? cnt : 1u;
}
DI void xcd_barrier(const XcdBarrier& b, const bool t0) {
    asm volatile("s_waitcnt vmcnt(0)" ::: "memory");
    __syncthreads();
    if (t0) {
        unsigned* bar = b.bar;
        __builtin_amdgcn_s_waitcnt(0);
        unsigned nloc = b.st[0], nx = b.st[1];
        if (nloc == 0u) { xcd_barrier_complete(bar, b.x, nloc, nx); b.st[0] = nloc; b.st[1] = nx; }
        const unsigned old = xb_add(&bar[XB_XSUB(b.x)], 1u);
        const unsigned gen = old / nloc;
        if (old + 1u == (gen + 1u) * nloc) {
            __builtin_amdgcn_fence(__ATOMIC_RELEASE, "agent");
            asm volatile("s_waitcnt vmcnt(0)" ::: "memory");
            const unsigned og = xb_add(&bar[XB_TOP], 1u);
            const unsigned tg = og / nx;
            if (og + 1u == (tg + 1u) * nx) xb_add(&bar[XB_TOPGEN], 1u);
            else XB_SPIN(xb_ld(&bar[XB_TOPGEN]) == tg, bar);
            __builtin_amdgcn_fence(__ATOMIC_ACQUIRE, "agent");
            xb_add(&bar[XB_XGEN(b.x)], 1u);
            asm volatile("s_waitcnt vmcnt(0)" ::: "memory");
        } else {
            XB_SPIN(xb_ld(&bar[XB_XGEN(b.x)]) == gen, bar);
            __builtin_amdgcn_fence(__ATOMIC_ACQUIRE, "agent");
            asm volatile("s_waitcnt vmcnt(0)" ::: "memory");
        }
    }
    __syncthreads();
}

__global__ void __launch_bounds__(NTHREADS, 2) fwd_kernel(Args args) {
    extern __shared__ __attribute__((aligned(16))) unsigned char lds_raw[];
    Ctx X;
    X.lds = (LAS unsigned char*)lds_raw;
    X.wave = __builtin_amdgcn_readfirstlane((int)(threadIdx.x >> 6));
    X.G = gridDim.x; { const int bx = blockIdx.x; X.vcu = (X.G % 8 == 0) ? (bx % 8) * (X.G / 8) + bx / 8 : bx; }
    X.gw = X.vcu * NWAVES + X.wave; X.NGW = X.G * NWAVES;
    X.kin = (const void* const*)__builtin_amdgcn_kernarg_segment_ptr();
    X.out = args.out; X.ws = args.ws;
    const int lo = args.ph_lo, hi = args.ph_hi;
    if (args.ph_hi > 1000) cg::this_grid().sync();
    volatile LAS unsigned* bst = (volatile LAS unsigned*)(X.lds + LDS_BYTES - 16);
    if (X.tid_f() < 4) bst[X.tid_f()] = 0u;
    __syncthreads();
    XcdBarrier gbar; gbar.bar = (unsigned*)(X.ws + CTL_BAR); gbar.x = 0; gbar.st = bst;
    if (hi - lo > 1) gbar = xcd_barrier_post((unsigned*)(X.ws + CTL_BAR), bst, X.tid_f() == 0);
#ifndef PH_MASK
#define PH_MASK 0x3ff
#endif
#define IN(k) (((PH_MASK >> (k)) & 1) && lo <= (k) && (k) < hi)
#ifndef DBL_MASK
#define DBL_MASK 0
#endif
#ifndef ATTN_NAIVE
#define ATTN_NAIVE 0
#endif
#ifndef RET_NAIVE
#define RET_NAIVE 0
#endif
#define DBL(k) ((DBL_MASK >> (k)) & 1)
#ifndef USE_CG_SYNC
#define USE_CG_SYNC 0
#endif
#define GSYNC() do { if (USE_CG_SYNC) cg::this_grid().sync(); else xcd_barrier(gbar, X.tid_f() == 0); } while (0)
#define SEAM(k) do { if (IN(k) && IN((k) + 1)) { GSYNC(); } } while (0)

    if (IN(0)) { phase_mod(X); } SEAM(0);
#ifndef P1_PARTS2
#define P1_PARTS2 7
#endif
#define PH1 { phase_pre(X); }
#define PH1B { phase_pre(X, P1_PARTS2); }
#ifndef P2_DBG2
#define P2_DBG2 0
#endif
#define PH2 { pg8::StaticOrder S; S.init(T, NIN, D, X.G, (int)blockIdx.x, X.ws + WS_A, X.ws + WS_WIN); \
        const unsigned* tabA = (const unsigned*)(X.ws + WS_TAB); const unsigned* tabR = tabA + (size_t)T * 16; \
        EpiInProj E{(bf16_t*)(X.ws + WS_B), tabA, tabR, P2DBG}; \
        pg8::gemm_phase<EpiInProj, pg8::StaticOrder, false>(X.lds, D, S, E, X.wave); }
#ifndef P3_ONLY
#define P3_ONLY 3
#endif
#define PH3 { if (!(X.vcu & 1)) { phase_ret_states64(X, X.vcu >> 1); __syncthreads(); } phase_attn(X, 0, 1); }
#ifndef P3_PARTS2
#define P3_PARTS2 3
#endif
#ifndef P3_DBG
#define P3_DBG 0
#endif
#define PH3B PH3
#ifndef P4_DBG
#define P4_DBG 1
#endif
#define PH4 { if (RET_NAIVE) phase_ret_fin_naive(X); else phase_ret_out(X); }
#define PH4B { phase_ret_out(X, P4_DBG); }
#define PH5 { pg8::StaticOrder S; S.init(T, D, D, X.G, (int)blockIdx.x, X.ws + WS_A, X.ws + WS_WOUT); \
        float* mu0 = (float*)(X.ws + WS_STAT0); \
        EpiOutProj E{X.x(), mu0, mu0 + T, X.ln0_g(), X.ln0_b(), (const float*)(X.ws + CTL_MOD), (float*)(X.ws + WS_T), (float*)(X.ws + WS_STAT1)}; \
        pg8::gemm_phase<EpiOutProj, pg8::StaticOrder, false>(X.lds, D, S, E, X.wave); }
#ifndef P6_PARTS2
#define P6_PARTS2 3
#endif
#define PH6 { phase_route(X, 3); }
#define PH6B { phase_route(X, P6_PARTS2); }
#define PH7 { LAS int* pre = (LAS int*)(X.lds + LDS_MISC); \
        const int nmt = moe_prefix(X, pre); \
        MoeOrder S{pre, 4, X.G, X.vcu, nmt * 4, (const char*)(X.ws + WS_H2), (const char*)(X.ws + WS_W13), (size_t)1024 * D * 2, (size_t)256 * D * 2, 0, (const unsigned*)(X.ws + WS_LIST), (const unsigned*)(X.ws + CTL_CNT), true}; \
        EpiMoeUp E{(bf16_t*)(X.ws + WS_A)}; \
        pg8::gemm_phase<EpiMoeUp, MoeOrder, true, true>(X.lds, D, S, E, X.wave); \
        __syncthreads(); phase_w2_copy(X); }
#define PH8 { LAS int* pre = (LAS int*)(X.lds + LDS_MISC); \
        const int nmt = moe_prefix(X, pre); \
        MoeOrder S{pre, 8, X.G, X.vcu, nmt * 8, (const char*)(X.ws + WS_A), (const char*)(X.ws + WS_W2), (size_t)D * FF * 2, (size_t)256 * FF * 2, (size_t)256 * FF * 2, nullptr, (const unsigned*)(X.ws + CTL_CNT), false}; \
        EpiMoeDown E{(bf16_t*)(X.ws + WS_Y)}; \
        pg8::gemm_phase<EpiMoeDown, MoeOrder, false, true>(X.lds, FF, S, E, X.wave); }
#define PH9 { phase_final(X); }
#define RUNPH(k, BODY) if (IN(k)) { BODY; if (DBL(k)) { GSYNC(); BODY; } } SEAM(k);
    if (IN(1)) { PH1; if (DBL(1)) { GSYNC(); PH1B; } } SEAM(1);
    { int P2DBG = 0; if (IN(2)) { PH2; if (DBL(2)) { GSYNC(); P2DBG = P2_DBG2; PH2; } } SEAM(2); }
    if (IN(3)) { PH3; if (DBL(3)) { GSYNC(); PH3B; } } SEAM(3);
    if (IN(4)) { PH4; if (DBL(4)) { GSYNC(); PH4B; } } SEAM(4);
    RUNPH(5, PH5)
    if (IN(6)) { PH6; if (DBL(6)) { GSYNC(); if ((P6_PARTS2 & 10) == 2) { if (X.vcu == 0 && X.tid_f() < NE) ((unsigned*)(X.ws + CTL_CNT))[X.tid_f() * 64] = 0u; GSYNC(); } PH6B; } } SEAM(6);
    RUNPH(7, PH7) RUNPH(8, PH8)
    if (IN(9)) { PH9; if (DBL(9)) { GSYNC(); PH9; } }
#undef IN
#undef SEAM
}

extern "C" void kernel_launch(void* const* d_in, const int* in_sizes, int n_in, void* d_out, int out_size, void* d_ws, size_t ws_size, hipStream_t stream) {
    static int grid = 0;
    if (grid == 0) {
        if (n_in != 22 || in_sizes[0] != T * D || out_size != T * D || ws_size < WS_END) { fprintf(stderr, "kernel_launch: unexpected shapes (n_in %d, in0 %d, out %d, ws %zu)\n", n_in, n_in > 0 ? in_sizes[0] : -1, out_size, ws_size); grid = -1; return; }
        int dev = 0, cus = 0, per_cu = 0;
        hipGetDevice(&dev); hipDeviceGetAttribute(&cus, hipDeviceAttributeMultiprocessorCount, dev);
        hipFuncSetAttribute((const void*)fwd_kernel, hipFuncAttributeMaxDynamicSharedMemorySize, LDS_BYTES);
        hipOccupancyMaxActiveBlocksPerMultiprocessor(&per_cu, (const void*)fwd_kernel, NTHREADS, LDS_BYTES);
        if (per_cu < 1) { fprintf(stderr, "kernel_launch: occupancy query says %d blocks per CU\n", per_cu); per_cu = 1; }
        (void)hipGetLastError();
        grid = cus;
        if (grid != 256) { fprintf(stderr, "kernel_launch: this build's phase 3 work split assumes 256 CUs (8 XCDs x 32); found %d\n", cus); grid = -1; return; }
    }
    if (grid < 0) return;
    hipMemsetAsync((char*)d_ws + WS_CTL, 0, CTL_ZERO_BYTES, stream);
    Args a{};
    for (int i = 0; i < 22; ++i) a.in[i] = d_in[i];
    a.out = (float*)d_out; a.ws = (unsigned char*)d_ws;
#if MK_PER_PHASE_LAUNCH
    for (int p = 0; p < NPHASE; ++p) {
        a.ph_lo = p; a.ph_hi = p + 1;
        hipLaunchKernelGGL(fwd_kernel, dim3(grid), dim3(NTHREADS), LDS_BYTES, stream, a);
    }
#else
    a.ph_lo = 0; a.ph_hi = NPHASE;
    void* kargs[] = {&a};
    hipError_t e = hipLaunchCooperativeKernel((const void*)fwd_kernel, dim3(grid), dim3(NTHREADS), kargs, LDS_BYTES, stream);
    if (e != hipSuccess) fprintf(stderr, "cooperative launch failed: %s (grid %d)\n", hipGetErrorString(e), grid);
#endif
}
```
